# Optimizing an MI355X kernel written in HIP

```python
import math
import jax, jax.numpy as jnp
from jax import lax
import numpy as np

D_MODEL = 1024
BATCH = 2
SEQ = 16384
DEPTH = 2

N_A_LAYERS = DEPTH // 2
N_B_LAYERS = DEPTH - N_A_LAYERS
MEM_TOKENS = 256
D_FF = 2816
HEAD_DIM = 64
MEM_HEADS = 4
MEM_WIDTH = MEM_HEADS * HEAD_DIM
MLSTM_HEADS = 4
MLSTM_HEAD_DIM = 192
MLSTM_WIDTH = MLSTM_HEADS * MLSTM_HEAD_DIM
MLSTM_CHUNK = 128
CONV_WIDTH = 4
DILATED_GROUPS = ((128, 1), (512, 4), (2048, 16))
HEADS_PER_GROUP = 4
N_DIL_HEADS = HEADS_PER_GROUP * len(DILATED_GROUPS)
DIL_WIDTH = N_DIL_HEADS * HEAD_DIM
A_IN_WIDTH = 4 * MLSTM_WIDTH + 2 * MLSTM_HEADS + MEM_WIDTH
B_IN_WIDTH = DIL_WIDTH + MEM_WIDTH
NUM_BUCKETS = 32
MAX_DISTANCE = 2048
RMS_EPS = 1e-6
NEG_INF = -1e30
ATTN_SCALE = HEAD_DIM ** -0.5

kernel_name = 'yoco_mlstm_dilated_macaron_hybrid'


def rms_norm(x, gain):
    xf = x.astype(jnp.float32)
    y = xf * lax.rsqrt(jnp.mean(xf * xf, axis=-1, keepdims=True) + RMS_EPS)
    return (y * gain.astype(jnp.float32)).astype(x.dtype)


def swiglu(h, w_gate, w_up, w_down):
    return (jax.nn.silu(h @ w_gate) * (h @ w_up)) @ w_down


def causal_conv(x, w):
    C = x.shape[-1]
    return lax.conv_general_dilated(x, w[:, None, :].astype(x.dtype), window_strides=(1,),
                                    padding=[(w.shape[0] - 1, 0)],
                                    dimension_numbers=('NWC', 'WIO', 'NWC'),
                                    feature_group_count=C)


def t5_causal_bucket(dist):
    max_exact = NUM_BUCKETS // 2
    d_f = jnp.maximum(dist, 1).astype(jnp.float32)
    large = max_exact + (jnp.log(d_f / max_exact) / math.log(MAX_DISTANCE / max_exact)
                         * (NUM_BUCKETS - max_exact)).astype(jnp.int32)
    large = jnp.minimum(large, NUM_BUCKETS - 1)
    return jnp.where(dist < max_exact, dist, large)


def mlstm_chunkwise(q, k, v, i_pre, f_pre):
    B, S, H, DK = q.shape
    DV = v.shape[-1]
    L = MLSTM_CHUNK
    NC = S // L
    f32 = jnp.float32

    def chunks(t):
        t = t.astype(f32).reshape(B, NC, L, H, *t.shape[3:])
        return jnp.moveaxis(t, 3, 2)

    qc = chunks(q)
    kc = chunks(k) * (DK ** -0.5)
    vc = chunks(v)
    ic = chunks(i_pre)
    logf = jax.nn.log_sigmoid(chunks(f_pre))
    b = jnp.cumsum(logf, axis=-1)
    b_last = b[..., -1]
    a = b_last[..., None] - b + ic

    def step(carry, xs):
        C, n, m = carry
        k_j, v_j, a_j, bl_j = xs
        m_new = jnp.maximum(bl_j + m, jnp.max(a_j, axis=-1))
        w = jnp.exp(a_j - m_new[..., None])
        decay = jnp.exp(bl_j + m - m_new)
        C_new = decay[..., None, None] * C + jnp.einsum('bhl,bhlk,bhlv->bhkv', w, k_j, v_j)
        n_new = decay[..., None] * n + jnp.einsum('bhl,bhlk->bhk', w, k_j)
        return (C_new, n_new, m_new), (C, n, m)

    init = (jnp.zeros((B, H, DK, DV), f32), jnp.zeros((B, H, DK), f32), jnp.zeros((B, H), f32))
    xs = (jnp.moveaxis(kc, 1, 0), jnp.moveaxis(vc, 1, 0), jnp.moveaxis(a, 1, 0), jnp.moveaxis(b_last, 1, 0))
    _, (C0, n0, m0) = lax.scan(step, init, xs)
    C0 = jnp.moveaxis(C0, 0, 1)
    n0 = jnp.moveaxis(n0, 0, 1)
    m0 = jnp.moveaxis(m0, 0, 1)

    causal = jnp.tril(jnp.ones((L, L), dtype=bool))
    Dlog = jnp.where(causal, b[..., :, None] - b[..., None, :] + ic[..., None, :], NEG_INF)
    g = b + m0[..., None]
    m_t = jnp.maximum(g, jnp.max(Dlog, axis=-1))
    W = jnp.exp(Dlog - m_t[..., None]) * jnp.einsum('bchtk,bchsk->bchts', qc, kc)
    inter = jnp.exp(g - m_t)
    num = jnp.einsum('bchts,bchsv->bchtv', W, vc) + inter[..., None] * jnp.einsum('bchtk,bchkv->bchtv', qc, C0)
    den = jnp.sum(W, axis=-1) + inter * jnp.einsum('bchtk,bchk->bcht', qc, n0)
    h = num / jnp.maximum(jnp.abs(den), jnp.exp(-m_t))[..., None]
    return jnp.moveaxis(h, 2, 3).reshape(B, S, H, DV)


def dilated_group_attention(q, k, v, bias_table, window, dilation):
    B, S, H, E = q.shape
    blk = window // dilation
    span = window
    Lp = -(-S // span) * span
    nb = Lp // span
    pad = ((0, 0), (0, Lp - S), (0, 0), (0, 0))

    def to_blocks(t):
        t = jnp.pad(t.astype(jnp.float32), pad).reshape(B, Lp // dilation, dilation, H, E)
        return jnp.transpose(t, (0, 2, 1, 3, 4)).reshape(B, dilation, nb, blk, H, E)

    qb = to_blocks(q)
    kb = to_blocks(k)
    vb = to_blocks(v)
    prev = lambda t: jnp.pad(t, ((0, 0), (0, 0), (1, 0), (0, 0), (0, 0), (0, 0)))[:, :, :-1]
    kk = jnp.concatenate([prev(kb), kb], axis=3)
    vv = jnp.concatenate([prev(vb), vb], axis=3)

    qi = jnp.arange(blk)[:, None]
    kj = jnp.arange(2 * blk)[None, :]
    m_off = qi + blk - kj
    band = (m_off >= 0) & (m_off <= blk)
    bucket = t5_causal_bucket(jnp.clip(m_off, 0, blk) * dilation)
    bias = jnp.transpose(bias_table.astype(jnp.float32)[bucket], (2, 0, 1))
    n_idx = jnp.arange(nb)[:, None, None]
    allowed = band[None] & ~((n_idx == 0) & (kj[None] < blk))

    s = jnp.einsum('brnqhe,brnkhe->brnhqk', qb, kk) * ATTN_SCALE + bias
    s = jnp.where(allowed[:, None], s, NEG_INF)
    mx = jnp.max(s, axis=-1, keepdims=True)
    p = jnp.exp(s - mx)
    den = jnp.sum(p, axis=-1)
    out = jnp.einsum('brnhqk,brnkhe->brnqhe', p, vv) / jnp.moveaxis(den, 3, 4)[..., None]
    lse = mx[..., 0] + jnp.log(den)

    out = jnp.transpose(out.reshape(B, dilation, Lp // dilation, H, E), (0, 2, 1, 3, 4)).reshape(B, Lp, H, E)[:, :S]
    lse = jnp.moveaxis(lse, 3, 4).reshape(B, dilation, Lp // dilation, H)
    lse = jnp.transpose(lse, (0, 2, 1, 3)).reshape(B, Lp, H)[:, :S]
    return out, lse


def memory_cross_attention(q_mem, mem_n, w_mem_kv, q_gain, k_gain):
    B, S, _ = q_mem.shape
    M = mem_n.shape[1]
    q = rms_norm(q_mem.reshape(B, S, MEM_HEADS, HEAD_DIM), q_gain)
    kv = mem_n @ w_mem_kv
    k = rms_norm(kv[..., :MEM_WIDTH].reshape(B, M, MEM_HEADS, HEAD_DIM), k_gain)
    v = kv[..., MEM_WIDTH:].reshape(B, M, MEM_HEADS, HEAD_DIM)
    s = jnp.einsum('bshe,bmhe->bhsm', q.astype(jnp.float32), k.astype(jnp.float32)) * ATTN_SCALE
    p = jax.nn.softmax(s, axis=-1)
    out = jnp.einsum('bhsm,bmhe->bshe', p, v.astype(jnp.float32))
    return out.reshape(B, S, MEM_WIDTH).astype(q_mem.dtype)


def mlstm_mixer(h, mem_n, w_in, conv_w, gate_bias, h_gain, w_out, w_mem_kv, mq_gain, mk_gain):
    B, S, _ = h.shape
    W = MLSTM_WIDTH
    p = h @ w_in
    qk = jax.nn.silu(causal_conv(p[..., :2 * W], conv_w))
    v = p[..., 2 * W:3 * W]
    o = p[..., 3 * W:4 * W]
    gates = p[..., 4 * W:4 * W + 2 * MLSTM_HEADS].astype(jnp.float32) + gate_bias.astype(jnp.float32)
    q_mem = p[..., 4 * W + 2 * MLSTM_HEADS:]
    heads = lambda t: t.reshape(B, S, MLSTM_HEADS, MLSTM_HEAD_DIM)
    cell = mlstm_chunkwise(heads(qk[..., :W]), heads(qk[..., W:]), heads(v),
                           gates[..., :MLSTM_HEADS], gates[..., MLSTM_HEADS:])
    cell = rms_norm(cell, h_gain).reshape(B, S, W)
    h_a = (jax.nn.sigmoid(o.astype(jnp.float32)) * cell).astype(h.dtype)
    h_m = memory_cross_attention(q_mem, mem_n, w_mem_kv, mq_gain, mk_gain)
    return jnp.concatenate([h_a, h_m], axis=-1) @ w_out


def dilated_mixer(h, mem_n, k_sh, v_sh, w_q, q_gain, w_out, rel_bias, w_mem_kv, mq_gain, mk_gain):
    B, S, _ = h.shape
    p = h @ w_q
    q_d = rms_norm(p[..., :DIL_WIDTH].reshape(B, S, len(DILATED_GROUPS), HEADS_PER_GROUP, HEAD_DIM), q_gain)
    outs, lses = [], []
    for g, (window, dilation) in enumerate(DILATED_GROUPS):
        table = rel_bias[:, g * HEADS_PER_GROUP:(g + 1) * HEADS_PER_GROUP]
        o_g, l_g = dilated_group_attention(q_d[:, :, g], k_sh[:, :, g], v_sh[:, :, g], table, window, dilation)
        outs.append(o_g)
        lses.append(l_g)
    outs = jnp.stack(outs, axis=2)
    alpha = jax.nn.softmax(jnp.stack(lses, axis=2), axis=2)
    h_d = (outs * alpha[..., None]).reshape(B, S, DIL_WIDTH).astype(h.dtype)
    h_m = memory_cross_attention(p[..., DIL_WIDTH:], mem_n, w_mem_kv, mq_gain, mk_gain)
    return jnp.concatenate([h_d, h_m], axis=-1) @ w_out


def setup_inputs(seed: int = 0) -> dict:
    key = jax.random.key(seed)
    ks = iter(jax.random.split(key, 40))
    nrm = lambda shape, scale: jax.random.normal(next(ks), shape, jnp.float32) * scale
    gain = lambda shape: 1.0 + nrm(shape, 0.02)
    D, F = D_MODEL, D_FF
    return {
        'x': nrm((BATCH, SEQ, D), 1.0),
        'mem': nrm((BATCH, MEM_TOKENS, D), 1.0),
        'ffn1_norm': gain((DEPTH, D)),
        'ffn1_w_gate': nrm((DEPTH, D, F), D ** -0.5),
        'ffn1_w_up': nrm((DEPTH, D, F), D ** -0.5),
        'ffn1_w_down': nrm((DEPTH, F, D), F ** -0.5),
        'ffn2_norm': gain((DEPTH, D)),
        'ffn2_w_gate': nrm((DEPTH, D, F), D ** -0.5),
        'ffn2_w_up': nrm((DEPTH, D, F), D ** -0.5),
        'ffn2_w_down': nrm((DEPTH, F, D), F ** -0.5),
        'mix_norm': gain((DEPTH, D)),
        'mem_norm': gain((DEPTH, D)),
        'w_mem_kv': nrm((DEPTH, D, 2 * MEM_WIDTH), D ** -0.5),
        'mem_q_norm': gain((DEPTH, HEAD_DIM)),
        'mem_k_norm': gain((DEPTH, HEAD_DIM)),
        'a_w_in': nrm((N_A_LAYERS, D, A_IN_WIDTH), D ** -0.5),
        'a_conv': nrm((N_A_LAYERS, CONV_WIDTH, 2 * MLSTM_WIDTH), CONV_WIDTH ** -0.5),
        'a_gate_bias': jnp.concatenate([nrm((N_A_LAYERS, MLSTM_HEADS), 0.1),
                                        3.0 + nrm((N_A_LAYERS, MLSTM_HEADS), 0.5)], axis=-1),
        'a_h_norm': gain((N_A_LAYERS, MLSTM_HEADS, MLSTM_HEAD_DIM)),
        'a_w_out': nrm((N_A_LAYERS, MLSTM_WIDTH + MEM_WIDTH, D), (MLSTM_WIDTH + MEM_WIDTH) ** -0.5),
        'b_w_q': nrm((N_B_LAYERS, D, B_IN_WIDTH), D ** -0.5),
        'b_q_norm': gain((N_B_LAYERS, HEAD_DIM)),
        'b_w_out': nrm((N_B_LAYERS, DIL_WIDTH + MEM_WIDTH, D), (DIL_WIDTH + MEM_WIDTH) ** -0.5),
        'kv_norm': gain((D,)),
        'w_kv': nrm((D, 2 * DIL_WIDTH), D ** -0.5),
        'kv_k_norm': gain((HEAD_DIM,)),
        'rel_bias': nrm((NUM_BUCKETS, N_DIL_HEADS), 0.3),
    }


def reference(x, mem, ffn1_norm, ffn1_w_gate, ffn1_w_up, ffn1_w_down,
              ffn2_norm, ffn2_w_gate, ffn2_w_up, ffn2_w_down,
              mix_norm, mem_norm, w_mem_kv, mem_q_norm, mem_k_norm,
              a_w_in, a_conv, a_gate_bias, a_h_norm, a_w_out,
              b_w_q, b_q_norm, b_w_out, kv_norm, w_kv, kv_k_norm, rel_bias):
    B, S, _ = x.shape
    n_groups = len(DILATED_GROUPS)
    k_sh = None
    v_sh = None
    for layer in range(DEPTH):
        x = x + 0.5 * swiglu(rms_norm(x, ffn1_norm[layer]), ffn1_w_gate[layer], ffn1_w_up[layer], ffn1_w_down[layer])
        h = rms_norm(x, mix_norm[layer])
        mem_n = rms_norm(mem, mem_norm[layer])
        if layer < N_A_LAYERS:
            ia = layer
            mix = mlstm_mixer(h, mem_n, a_w_in[ia], a_conv[ia], a_gate_bias[ia], a_h_norm[ia], a_w_out[ia],
                              w_mem_kv[layer], mem_q_norm[layer], mem_k_norm[layer])
        else:
            ib = layer - N_A_LAYERS
            mix = dilated_mixer(h, mem_n, k_sh, v_sh, b_w_q[ib], b_q_norm[ib], b_w_out[ib], rel_bias,
                                w_mem_kv[layer], mem_q_norm[layer], mem_k_norm[layer])
        x = x + mix
        x = x + 0.5 * swiglu(rms_norm(x, ffn2_norm[layer]), ffn2_w_gate[layer], ffn2_w_up[layer], ffn2_w_down[layer])
        if layer == N_A_LAYERS - 1:
            kv = rms_norm(x, kv_norm) @ w_kv
            k_sh = rms_norm(kv[..., :DIL_WIDTH].reshape(B, S, N_DIL_HEADS, HEAD_DIM), kv_k_norm)
            k_sh = k_sh.reshape(B, S, n_groups, HEADS_PER_GROUP, HEAD_DIM)
            v_sh = kv[..., DIL_WIDTH:].reshape(B, S, n_groups, HEADS_PER_GROUP, HEAD_DIM)
    return x
```

```cpp
#include <hip/hip_runtime.h>
#include <hip/hip_cooperative_groups.h>
#include <stdint.h>
#include <stdio.h>
namespace cg = cooperative_groups;

typedef unsigned short bf16_t;
typedef __attribute__((ext_vector_type(8))) short bf16x8;
typedef __attribute__((ext_vector_type(4))) float f32x4;
#define LAS __attribute__((address_space(3)))
#define VMWAIT() asm volatile("s_waitcnt vmcnt(0)" ::: "memory")

constexpr int kT = 32768, kS = 16384;
constexpr int NTHR = 512, NWAVE = 8;
constexpr float EPS = 1e-6f;

constexpr size_t GU_SZ = 5632ull * 1024, DN_SZ = 1024ull * 2816, KV_SZ = 1536ull * 1024, IN_SZ = 3584ull * 1024,
                 SQ_SZ = 1024ull * 1024, MKV_SZ = 512ull * 1024;
constexpr size_t W_GU0 = 0, W_GU1 = GU_SZ, W_GU2 = 2 * GU_SZ, W_KV = 3 * GU_SZ, W_GU3 = W_KV + KV_SZ,
                 W_DN0 = W_GU3 + GU_SZ, W_DN1 = W_DN0 + DN_SZ, W_DN2 = W_DN1 + DN_SZ, W_DN3 = W_DN2 + DN_SZ,
                 W_IN = W_DN3 + DN_SZ, W_AOUT = W_IN + IN_SZ, W_BQ = W_AOUT + SQ_SZ, W_BOUT = W_BQ + SQ_SZ,
                 W_MKV0 = W_BOUT + SQ_SZ, W_MKV1 = W_MKV0 + MKV_SZ, W_END = W_MKV1 + MKV_SZ;
constexpr size_t PSZ = (size_t)kT * 768 * 2;
constexpr size_t OFF_W = 0;
constexpr size_t OFF_XB = (W_END * 2 + 255) / 256 * 256;
constexpr size_t OFF_R1 = OFF_XB + (size_t)kT * 1024 * 2;
constexpr size_t OFF_R2 = OFF_R1 + 4 * PSZ;
constexpr size_t OFF_CAT = OFF_R2 + 2 * PSZ;
constexpr size_t OFF_SSQ = OFF_CAT + (size_t)kT * 1024 * 2;
constexpr size_t OFF_G = OFF_SSQ + (size_t)kT * 16 * 4;
constexpr size_t OFF_MEMB = OFF_G + (size_t)kT * 8 * 4;
constexpr size_t OFF_SSQM = OFF_MEMB + 512ull * 1024 * 2;
constexpr size_t OFF_KMEM = OFF_SSQM + 512ull * 16 * 4;
constexpr size_t OFF_VMEM = OFF_KMEM + 2ull * 512 * 256 * 2;
constexpr size_t OFF_U = OFF_VMEM + 2ull * 512 * 256 * 2;
constexpr size_t OFF_BC = OFF_U + 1024ull * 128 * 4;
constexpr size_t OFF_EW = OFF_BC + 1024ull * 128 * 4;
constexpr size_t OFF_UMAX = OFF_EW + 1024ull * 128 * 2;
constexpr size_t OFF_BL = OFF_UMAX + 4096;
constexpr size_t OFF_M0 = OFF_BL + 4096;
constexpr size_t OFF_BAR = OFF_M0 + 4096;
constexpr size_t OFF_VTOK = OFF_BAR + 16384;
constexpr size_t OFF_DC = OFF_VTOK + 2ull * 512 * 256 * 2;
constexpr size_t OFF_CS = OFF_DC + 4096;
constexpr size_t OFF_END = OFF_CS + 8ull * 208 * 192 * 2;

struct Params {
  const float *x, *mem, *ffn1_norm, *ffn1_wg, *ffn1_wu, *ffn1_wd, *ffn2_norm, *ffn2_wg, *ffn2_wu, *ffn2_wd, *mix_norm,
      *mem_norm, *w_mem_kv, *mem_q_norm, *mem_k_norm, *a_w_in, *a_conv, *a_gate_bias, *a_h_norm, *a_w_out, *b_w_q,
      *b_q_norm, *b_w_out, *kv_norm, *w_kv, *kv_k_norm, *rel_bias;
  float* out;
  char* ws;
};

__shared__ __attribute__((aligned(16))) char smem[146432];

__device__ __forceinline__ bf16_t f2bf(float f) {
  uint32_t u = __float_as_uint(f);
  u += 0x7fffu + ((u >> 16) & 1u);
  return (bf16_t)(u >> 16);
}
__device__ __forceinline__ float bf2f(bf16_t h) { return __uint_as_float(((uint32_t)h) << 16); }
__device__ __forceinline__ float bflo(uint32_t u) { return __uint_as_float(u << 16); }
__device__ __forceinline__ float bfhi(uint32_t u) { return __uint_as_float(u & 0xffff0000u); }
__device__ __forceinline__ uint32_t pack2(float a, float b) { uint32_t r; asm("v_cvt_pk_bf16_f32 %0, %1, %2" : "=v"(r) : "v"(a), "v"(b)); return r; }
__device__ __forceinline__ float dot8(uint4 a, uint4 b) {
  return bflo(a.x) * bflo(b.x) + bfhi(a.x) * bfhi(b.x) + bflo(a.y) * bflo(b.y) + bfhi(a.y) * bfhi(b.y) +
         bflo(a.z) * bflo(b.z) + bfhi(a.z) * bfhi(b.z) + bflo(a.w) * bflo(b.w) + bfhi(a.w) * bfhi(b.w);
}
__device__ __forceinline__ float wave_sum(float v) {
  for (int o = 32; o > 0; o >>= 1) v += __shfl_xor(v, o);
  return v;
}
__device__ __forceinline__ float wave_max(float v) {
  for (int o = 32; o > 0; o >>= 1) v = fmaxf(v, __shfl_xor(v, o));
  return v;
}
__device__ __forceinline__ float dpp_ror_(float v, int) { return v; }
#define DPP_ROR_ADD(v, ctrl) v += __builtin_bit_cast(float, __builtin_amdgcn_update_dpp(0, __builtin_bit_cast(int, v), ctrl, 0xf, 0xf, false))
__device__ __forceinline__ float sum16(float v) {
  DPP_ROR_ADD(v, 0x128); DPP_ROR_ADD(v, 0x124); DPP_ROR_ADD(v, 0x122); DPP_ROR_ADD(v, 0x121);
  return v;
}
#define DPP_ROR_MAX(v, ctrl) v = fmaxf(v, __builtin_bit_cast(float, __builtin_amdgcn_update_dpp(0, __builtin_bit_cast(int, v), ctrl, 0xf, 0xf, false)))
__device__ __forceinline__ float max16(float v) {
  DPP_ROR_MAX(v, 0x128); DPP_ROR_MAX(v, 0x124); DPP_ROR_MAX(v, 0x122); DPP_ROR_MAX(v, 0x121);
  return v;
}
__device__ __forceinline__ float sigmoidf_(float x) { return __builtin_amdgcn_rcpf(1.f + __expf(-x)); }

struct WJob { size_t dst; int Nd, K; };
__device__ __forceinline__ WJob wjob(int j) {
  switch (j) {
    case 0: return {W_GU0, 5632, 1024};
    case 1: return {W_GU1, 5632, 1024};
    case 2: return {W_GU2, 5632, 1024};
    case 3: return {W_GU3, 5632, 1024};
    case 4: return {W_DN0, 1024, 2816};
    case 5: return {W_DN1, 1024, 2816};
    case 6: return {W_DN2, 1024, 2816};
    case 7: return {W_DN3, 1024, 2816};
    case 8: return {W_IN, 3584, 1024};
    case 9: return {W_AOUT, 1024, 1024};
    case 10: return {W_BQ, 1024, 1024};
    case 11: return {W_BOUT, 1024, 1024};
    case 12: return {W_KV, 1536, 1024};
    case 13: return {W_MKV0, 512, 1024};
    default: return {W_MKV1, 512, 1024};
  }
}
__device__ __forceinline__ int headmap(int r256) { const int bj = r256 >> 7, hh = (r256 & 127) >> 5, i = r256 & 31; return hh * 64 + bj * 32 + i; }
__device__ __forceinline__ void wsrc(const Params& P, int j, int n, const float*& p, int& ld, const float*& gain) {
  p = nullptr; ld = 0; gain = nullptr;
  if (j < 4) {
    int layer = j >> 1, which = j & 1;
    int pn = n >> 8, r = n & 255, bj = r >> 7, col = pn * 128 + (r & 127);
    const float* wg = which ? P.ffn2_wg : P.ffn1_wg;
    const float* wu = which ? P.ffn2_wu : P.ffn1_wu;
    p = (bj ? wu : wg) + (size_t)layer * 1024 * 2816 + col;
    ld = 2816;
    gain = (which ? P.ffn2_norm : P.ffn1_norm) + layer * 1024;
  } else if (j < 8) {
    int i = j - 4, layer = i >> 1, which = i & 1;
    p = (which ? P.ffn2_wd : P.ffn1_wd) + (size_t)layer * 2816 * 1024 + n;
    ld = 1024;
  } else if (j == 8) {
    int col = -1;
    if (n < 3072) col = n; else if (n < 3328) col = 3080 + headmap(n - 3072); else if (n < 3336) col = 3072 + (n - 3328);
    if (col >= 0) { p = P.a_w_in + col; ld = 3336; }
    gain = P.mix_norm;
  } else if (j == 9) { p = P.a_w_out + n; ld = 1024; }
  else if (j == 10) { p = P.b_w_q + (n & ~255) + headmap(n & 255); ld = 1024; gain = P.mix_norm + 1024; }
  else if (j == 11) { p = P.b_w_out + n; ld = 1024; }
  else if (j == 12) { int col = (n < 768) ? ((n & ~255) + headmap(n & 255)) : n; p = P.w_kv + col; ld = 1536; gain = P.kv_norm; }
  else { int l = j - 13; int col = (n < 256) ? headmap(n) : n; p = P.w_mem_kv + (size_t)l * 1024 * 512 + col; ld = 512; gain = P.mem_norm + l * 1024; }
}

__device__ __forceinline__ void wave_convert(const Params& P, int widx, int nwv, bool early) {
  bf16_t* W = (bf16_t*)(P.ws + OFF_W);
  const int lane = threadIdx.x & 63;
  int base = 0;
  for (int j = 0; j < 15; ++j) {
    const bool is_early = (j == 0 || j == 4 || j == 8 || j >= 13);
    if (is_early != early) continue;
    WJob wj = wjob(j);
    const int tk_cnt = wj.K >> 6, ntile = (wj.Nd >> 6) * tk_cnt;
    const int first = (widx + nwv - (base % nwv)) % nwv;
    for (int t = first; t < ntile; t += nwv) {
      const int tn = t / tk_cnt, tk = t - tn * tk_cnt, n = (tn << 6) + lane, k0 = tk << 6;
      const float* sp; int ld; const float* gain;
      wsrc(P, j, n, sp, ld, gain);
      float v[64];
#pragma unroll
      for (int k = 0; k < 64; ++k) v[k] = sp ? sp[(size_t)(k0 + k) * ld] : 0.f;
      if (gain) {
#pragma unroll
        for (int k4 = 0; k4 < 16; ++k4) {
          const float4 g4 = *(const float4*)(gain + k0 + k4 * 4);
          v[k4 * 4 + 0] *= g4.x; v[k4 * 4 + 1] *= g4.y; v[k4 * 4 + 2] *= g4.z; v[k4 * 4 + 3] *= g4.w;
        }
      }
      VMWAIT();
      bf16_t* dst = W + wj.dst + (size_t)n * wj.K + k0;
#pragma unroll
      for (int k8 = 0; k8 < 8; ++k8) {
        uint4 o;
        o.x = pack2(v[k8 * 8 + 0], v[k8 * 8 + 1]); o.y = pack2(v[k8 * 8 + 2], v[k8 * 8 + 3]);
        o.z = pack2(v[k8 * 8 + 4], v[k8 * 8 + 5]); o.w = pack2(v[k8 * 8 + 6], v[k8 * 8 + 7]);
        *(uint4*)(dst + k8 * 8) = o;
      }
    }
    base += ntile;
  }
}

__device__ __forceinline__ void phase_convert(const Params& P) {
  bf16_t* W = (bf16_t*)(P.ws + OFF_W);
  float* sT = (float*)smem;
  const int tid = threadIdx.x;
  wave_convert(P, (int)(blockIdx.x * NWAVE + (threadIdx.x >> 6)), (int)(gridDim.x * NWAVE), true);
  bf16_t* xb = (bf16_t*)(P.ws + OFF_XB);
  float* ssq = (float*)(P.ws + OFF_SSQ);
  bf16_t* memb = (bf16_t*)(P.ws + OFF_MEMB);
  float* ssqm = (float*)(P.ws + OFF_SSQM);
  const int lane = tid & 63, gw = blockIdx.x * NWAVE + (tid >> 6), nw = gridDim.x * NWAVE;
  for (int row = gw; row < kT + 512; row += nw) {
    const float* src = (row < kT) ? (P.x + (size_t)row * 1024) : (P.mem + (size_t)(row - kT) * 1024);
    bf16_t* dst = (row < kT) ? (xb + (size_t)row * 1024) : (memb + (size_t)(row - kT) * 1024);
    float* sq = (row < kT) ? (ssq + (size_t)row * 16) : (ssqm + (size_t)(row - kT) * 16);
    float ss = 0.f;
#pragma unroll
    for (int i = 0; i < 4; ++i) {
      float4 v = ((const float4*)src)[lane + 64 * i];
      ss += v.x * v.x + v.y * v.y + v.z * v.z + v.w * v.w;
      uint2 o; o.x = pack2(v.x, v.y); o.y = pack2(v.z, v.w);
      ((uint2*)dst)[lane + 64 * i] = o;
    }
    ss = wave_sum(ss);
    if (lane < 16) sq[lane] = (lane == 0) ? ss : 0.f;
  }
}

constexpr int G8_BM = 256, G8_BK = 64, G8_HALF = 128, G8_HTB = G8_HALF * G8_BK * 2, G8_NXCD = 8, G8_WGM = 8;
__device__ __forceinline__ int lds_byte(int r, int c) { const int st = (r >> 4) * 2 + (c >> 5), rr = r & 15, cc = c & 31, ob = rr * 64 + cc * 2; return st * 1024 + (ob ^ (((ob >> 9) & 1) << 5)); }
__device__ __forceinline__ void stage_rc(int b, int& R, int& C) { const int st = b / 1024, sb = b % 1024, swz = sb ^ (((sb >> 9) & 1) << 5); R = (st >> 1) * 16 + swz / 64; C = (st & 1) * 32 + (swz % 64) / 2; }
__device__ __forceinline__ int perm32(int rho) { const int n = rho >> 4, i = rho & 15; return 8 * (i >> 2) + 4 * n + (i & 3); }
struct Unit { int pm, pn; };
struct StaticOrder {
  int nM, nN, nwg, G, c;
  __device__ void init(int M, int N, int G_, int c_) { nM = M / G8_BM; nN = N / G8_BM; nwg = nM * nN; G = G_; c = c_; }
  __device__ bool next(int i, Unit& u) const {
    const long L = (long)i * G + c; if (L >= nwg) return false;
    int wgid = (int)L; { const int q = nwg / G8_NXCD, r = nwg % G8_NXCD, xcd = wgid % G8_NXCD, off = wgid / G8_NXCD; wgid = (xcd < r ? xcd * (q + 1) : r * (q + 1) + (xcd - r) * q) + off; }
    const int nig = G8_WGM * nN, gid = wgid / nig, fm = gid * G8_WGM, gsz = (nM - fm) < G8_WGM ? (nM - fm) : G8_WGM;
    u.pm = fm + ((wgid % nig) % gsz); u.pn = (wgid % nig) / gsz; return true;
  }
};

__device__ __forceinline__ float rstd_row(const float* ssq, size_t row) {
  const float4* q = (const float4*)(ssq + row * 16);
  float4 a = q[0], b = q[1], c = q[2], d = q[3];
  float s = ((a.x + a.y) + (a.z + a.w)) + ((b.x + b.y) + (b.z + b.w)) + ((c.x + c.y) + (c.z + c.w)) + ((d.x + d.y) + (d.z + d.w));
  return rsqrtf(s * (1.f / 1024.f) + EPS);
}
template <class Epi>
__device__ __forceinline__ void gemm8(const bf16_t* gA, const bf16_t* gBt, int M, int N, int K, const Epi& E, int coff = 0) {
  LAS unsigned char* lds = (LAS unsigned char*)smem;
  StaticOrder S; S.init(M, N, (int)gridDim.x, (int)((blockIdx.x + coff) % gridDim.x));
  const int tid = threadIdx.x, wid = __builtin_amdgcn_readfirstlane(tid >> 6), lane = tid & 63, wr = wid >> 2, wc = wid & 3, fr = lane & 15, fq = lane >> 4;
  const int nt = K / G8_BK;
  unsigned voffA[2], voffB[2];
#pragma unroll
  for (int i = 0; i < 2; ++i) { int R, C; stage_rc(tid * 16 + i * 8192, R, C); const int Rb = Epi::PERM ? ((R & ~31) + perm32(R & 31)) : R;
    voffA[i] = (unsigned)(R * K + C) * 2u; voffB[i] = (unsigned)(Rb * K + C) * 2u; }
  const size_t kstep = (size_t)(G8_BK * 2);
  const size_t hstep = (size_t)G8_HALF * K * 2;
  const size_t tstep = 2 * hstep;
  const unsigned ldsw = (unsigned)wid * 1024u;
  const int aoff = lds_byte(wr * 64 + fr, fq * 8), boff = lds_byte(wc * 32 + fr, fq * 8);
#define PG8_SA(b, h) (((b) * 2 + (h)) * G8_HTB)
#define PG8_SB(b, h) ((4 + (b) * 2 + (h)) * G8_HTB)
#define PG8_STAGE(bufoff, gbase, voff) do { _Pragma("unroll") for (int _i = 0; _i < 2; ++_i) \
    __builtin_amdgcn_global_load_lds((const unsigned*)((const char*)(gbase) + (voff)[_i]), (LAS unsigned*)(lds + (bufoff) + ldsw + _i * 8192), 16, 0, 0); } while (0)
#define PG8_LDA(dst, b, h) do { _Pragma("unroll") for (int m = 0; m < 4; ++m) _Pragma("unroll") for (int k = 0; k < 2; ++k) dst[m][k] = *(const LAS bf16x8*)(lds + PG8_SA(b, h) + aoff + m * 2048 + k * 1024); } while (0)
#define PG8_LDB(dst, b, h) do { _Pragma("unroll") for (int n = 0; n < 2; ++n) _Pragma("unroll") for (int k = 0; k < 2; ++k) dst[n][k] = *(const LAS bf16x8*)(lds + PG8_SB(b, h) + boff + n * 2048 + k * 1024); } while (0)
#define PG8_MMA(ai, bj, At, Bt) do { __builtin_amdgcn_s_setprio(1); _Pragma("unroll") for (int m = 0; m < 4; ++m) _Pragma("unroll") for (int n = 0; n < 2; ++n) _Pragma("unroll") for (int k = 0; k < 2; ++k) \
    acc[ai][bj][m][n] = __builtin_amdgcn_mfma_f32_16x16x32_bf16(Bt[n][k], At[m][k], acc[ai][bj][m][n], 0, 0, 0); __builtin_amdgcn_s_setprio(0); } while (0)
#define PG8_WAIT_V(n) asm volatile("s_waitcnt vmcnt(" #n ")" ::: "memory")
#define PG8_WAIT_L(n) asm volatile("s_waitcnt lgkmcnt(" #n ")" ::: "memory")
#define PG8_BAR __builtin_amdgcn_s_barrier()
#define PG8_SCHED __builtin_amdgcn_sched_barrier(0)
  Unit cur, nxt; int ui = 0;
  if (E.ssq != nullptr) {
    float* sRs = (float*)(smem + 132096);
    Unit uu;
    for (int i = 0; S.next(i, uu); ++i)
      if (tid < 256) sRs[i * 256 + tid] = rstd_row(E.ssq, (size_t)uu.pm * 256 + tid);
    __syncthreads();
  }
  if (!S.next(0, cur)) return;
  f32x4 acc[2][2][4][2];
#pragma unroll
  for (int a = 0; a < 2; ++a)
#pragma unroll
    for (int b = 0; b < 2; ++b)
#pragma unroll
      for (int m = 0; m < 4; ++m)
#pragma unroll
        for (int n = 0; n < 2; ++n) acc[a][b][m][n] = (f32x4){0.f, 0.f, 0.f, 0.f};
  bf16x8 At[4][2], B0[2][2], B1[2][2];
  const char* cA = (const char*)gA + (size_t)cur.pm * tstep; const char* cB = (const char*)gBt + (size_t)cur.pn * tstep;
  PG8_STAGE(PG8_SB(0, 0), cB, voffB); PG8_STAGE(PG8_SA(0, 0), cA, voffA); PG8_STAGE(PG8_SB(0, 1), cB + hstep, voffB); PG8_STAGE(PG8_SA(0, 1), cA + hstep, voffA);
  if (wr == 1) PG8_BAR;
  PG8_WAIT_V(4); PG8_BAR;
  PG8_STAGE(PG8_SB(1, 0), cB + kstep, voffB); PG8_STAGE(PG8_SA(1, 0), cA + kstep, voffA); PG8_STAGE(PG8_SB(1, 1), cB + hstep + kstep, voffB);
  PG8_WAIT_V(6); PG8_BAR;
  for (;;) {
    const bool has_next = S.next(ui + 1, nxt);
    const char* nA = has_next ? (const char*)gA + (size_t)nxt.pm * tstep : cA; const char* nB = has_next ? (const char*)gBt + (size_t)nxt.pn * tstep : cB;
    for (int t = 0; t < nt; t += 2) {
      const bool last = (t == nt - 2);
      const char* a1 = cA + (size_t)(t + 1) * kstep;
      const char* a2 = last ? nA : cA + (size_t)(t + 2) * kstep; const char* b2 = last ? nB : cB + (size_t)(t + 2) * kstep;
      const char* a3 = a2 + kstep; const char* b3 = b2 + kstep;
      PG8_LDB(B0, 0, 0); PG8_SCHED; PG8_LDA(At, 0, 0); PG8_STAGE(PG8_SA(1, 1), a1 + hstep, voffA);
      PG8_WAIT_L(8); PG8_BAR; PG8_WAIT_L(0); PG8_MMA(0, 0, At, B0); PG8_BAR; PG8_SCHED;
      PG8_LDB(B1, 0, 1); PG8_STAGE(PG8_SB(0, 0), b2, voffB);
      PG8_BAR; PG8_WAIT_L(0); PG8_MMA(0, 1, At, B1); PG8_BAR;
      PG8_LDA(At, 0, 1); PG8_STAGE(PG8_SA(0, 0), a2, voffA);
      PG8_BAR; PG8_WAIT_L(0); PG8_MMA(1, 0, At, B0); PG8_BAR; PG8_SCHED;
      PG8_STAGE(PG8_SB(0, 1), b2 + hstep, voffB);
      PG8_WAIT_V(6); PG8_BAR; PG8_MMA(1, 1, At, B1); PG8_BAR;
      PG8_LDB(B0, 1, 0); PG8_SCHED; PG8_LDA(At, 1, 0); PG8_STAGE(PG8_SA(0, 1), a2 + hstep, voffA);
      PG8_WAIT_L(8); PG8_BAR; PG8_WAIT_L(0); PG8_MMA(0, 0, At, B0); PG8_BAR; PG8_SCHED;
      PG8_LDB(B1, 1, 1); PG8_STAGE(PG8_SB(1, 0), b3, voffB);
      PG8_BAR; PG8_WAIT_L(0); PG8_MMA(0, 1, At, B1); PG8_BAR;
      PG8_LDA(At, 1, 1); PG8_STAGE(PG8_SA(1, 0), a3, voffA);
      PG8_BAR; PG8_WAIT_L(0); PG8_MMA(1, 0, At, B0); PG8_BAR; PG8_SCHED;
      PG8_STAGE(PG8_SB(1, 1), b3 + hstep, voffB);
      PG8_WAIT_V(6); PG8_BAR; PG8_MMA(1, 1, At, B1); PG8_BAR;
    }
    E(acc, cur, ui, wr, wc, fr, fq);
    if (!has_next) break;
#pragma unroll
    for (int a = 0; a < 2; ++a)
#pragma unroll
      for (int b = 0; b < 2; ++b)
#pragma unroll
        for (int m = 0; m < 4; ++m)
#pragma unroll
          for (int n = 0; n < 2; ++n) acc[a][b][m][n] = (f32x4){0.f, 0.f, 0.f, 0.f};
    cur = nxt; cA = nA; cB = nB; ++ui;
  }
  PG8_WAIT_V(0);
  if (wr == 0) PG8_BAR;
  PG8_BAR;
#undef PG8_SA
#undef PG8_SB
#undef PG8_STAGE
#undef PG8_LDA
#undef PG8_LDB
#undef PG8_MMA
#undef PG8_WAIT_V
#undef PG8_WAIT_L
#undef PG8_BAR
#undef PG8_SCHED
}

typedef f32x4 Acc8[2][2][4][2];
__device__ __forceinline__ float sumq4(float v) {
  v += __shfl_xor(v, 16); v += __shfl_xor(v, 32);
  return v;
}
__device__ __forceinline__ void rstd8(int ui, int wr, int fr, float (&rs)[2][4]) {
  const float* sRs = (const float*)(smem + 132096) + ui * 256 + wr * 64 + fr;
#pragma unroll
  for (int ai = 0; ai < 2; ++ai)
#pragma unroll
    for (int m = 0; m < 4; ++m) rs[ai][m] = sRs[ai * 128 + m * 16];
}
__device__ __forceinline__ uint4 pack8(f32x4 a, f32x4 b) {
  uint4 o; o.x = pack2(a[0], a[1]); o.y = pack2(a[2], a[3]); o.z = pack2(b[0], b[1]); o.w = pack2(b[2], b[3]); return o;
}
__device__ __forceinline__ void epi8_swiglu(const Acc8& acc, const Unit& u, int ui, int wr, int wc, int fr, int fq, const float* ssq, bf16_t* H) {
  float rs8[2][4];
  rstd8(ui, wr, fr, rs8);
#pragma unroll
  for (int ai = 0; ai < 2; ++ai)
#pragma unroll
    for (int m = 0; m < 4; ++m) {
      const size_t row = (size_t)u.pm * 256 + ai * 128 + wr * 64 + m * 16 + fr;
      const float rs = rs8[ai][m];
      f32x4 h0, h1;
#pragma unroll
      for (int jj = 0; jj < 4; ++jj) {
        float g0 = acc[ai][0][m][0][jj] * rs, u0 = acc[ai][1][m][0][jj] * rs, g1 = acc[ai][0][m][1][jj] * rs, u1 = acc[ai][1][m][1][jj] * rs;
        h0[jj] = g0 * __builtin_amdgcn_rcpf(1.f + __expf(-g0)) * u0;
        h1[jj] = g1 * __builtin_amdgcn_rcpf(1.f + __expf(-g1)) * u1;
      }
      *(uint4*)(H + row * 2816 + u.pn * 128 + wc * 32 + fq * 8) = pack8(h0, h1);
    }
}
__device__ __forceinline__ void epi8_plain(const Acc8& acc, const Unit& u, int ui, int wr, int wc, int fr, int fq, const float* ssq, bf16_t* dst, int ld, int col0) {
  float rs8[2][4];
  rstd8(ui, wr, fr, rs8);
#pragma unroll
  for (int ai = 0; ai < 2; ++ai)
#pragma unroll
    for (int m = 0; m < 4; ++m) {
      const size_t row = (size_t)u.pm * 256 + ai * 128 + wr * 64 + m * 16 + fr;
      const float rs = rs8[ai][m];
#pragma unroll
      for (int bj = 0; bj < 2; ++bj)
        *(uint4*)(dst + row * ld + col0 + bj * 128 + wc * 32 + fq * 8) = pack8(acc[ai][bj][m][0] * rs, acc[ai][bj][m][1] * rs);
    }
}
__device__ __forceinline__ void epi8_headnorm(const Acc8& acc, const Unit& u, int ui, int wr, int wc, int fr, int fq, const float* ssq, const float* gain,
                                              float scale, bf16_t* dst, int ld, int colbase) {
  f32x4 gn[2][2];
#pragma unroll
  for (int bj = 0; bj < 2; ++bj)
#pragma unroll
    for (int n = 0; n < 2; ++n) gn[bj][n] = *(const f32x4*)(gain + bj * 32 + fq * 8 + n * 4) * scale;
  VMWAIT();
  float rs8[2][4];
  rstd8(ui, wr, fr, rs8);
#pragma unroll
  for (int ai = 0; ai < 2; ++ai)
#pragma unroll
    for (int m = 0; m < 4; ++m) {
      const size_t row = (size_t)u.pm * 256 + ai * 128 + wr * 64 + m * 16 + fr;
      const float rs = rs8[ai][m];
      float ss = 0.f;
#pragma unroll
      for (int bj = 0; bj < 2; ++bj)
#pragma unroll
        for (int n = 0; n < 2; ++n) {
          const f32x4 a = acc[ai][bj][m][n];
          ss += a[0] * a[0] + a[1] * a[1] + a[2] * a[2] + a[3] * a[3];
        }
      ss = sumq4(ss) * rs * rs;
      const float r2 = rsqrtf(ss * (1.f / 64.f) + EPS) * rs;
#pragma unroll
      for (int bj = 0; bj < 2; ++bj)
        *(uint4*)(dst + row * ld + colbase + wc * 64 + bj * 32 + fq * 8) = pack8(acc[ai][bj][m][0] * r2 * gn[bj][0], acc[ai][bj][m][1] * r2 * gn[bj][1]);
    }
}

struct Epi8Swiglu {
  static constexpr bool PERM = true;
  const float* ssq; bf16_t* H;
  __device__ __forceinline__ void operator()(const Acc8& acc, const Unit& u, int ui, int wr, int wc, int fr, int fq) const { epi8_swiglu(acc, u, ui, wr, wc, fr, fq, ssq, H); }
};
struct Epi8Resid {
  static constexpr bool PERM = false;
  static constexpr const float* ssq = nullptr;
  const float* xin; float* xout; bf16_t* xb; float* ssqo; float scale;
  __device__ __forceinline__ void operator()(const Acc8& acc, const Unit& u, int ui, int wr, int wc, int fr, int fq) const {
#pragma unroll
    for (int ai = 0; ai < 2; ++ai)
#pragma unroll
      for (int mh = 0; mh < 2; ++mh) {
        f32x4 xv[2][2][2];
#pragma unroll
        for (int m2 = 0; m2 < 2; ++m2)
#pragma unroll
          for (int bj = 0; bj < 2; ++bj)
#pragma unroll
            for (int n = 0; n < 2; ++n)
              xv[m2][bj][n] = *(const f32x4*)(xin + ((size_t)u.pm * 256 + ai * 128 + wr * 64 + (mh * 2 + m2) * 16 + fr) * 1024 + u.pn * 256 + bj * 128 + wc * 32 + n * 16 + fq * 4);
        VMWAIT();
#pragma unroll
        for (int m2 = 0; m2 < 2; ++m2) {
          const int m = mh * 2 + m2;
          const size_t row = (size_t)u.pm * 256 + ai * 128 + wr * 64 + m * 16 + fr;
          float ss = 0.f;
#pragma unroll
          for (int bj = 0; bj < 2; ++bj)
#pragma unroll
            for (int n = 0; n < 2; ++n) {
              const size_t idx = row * 1024 + u.pn * 256 + bj * 128 + wc * 32 + n * 16 + fq * 4;
              f32x4 v = xv[m2][bj][n] + acc[ai][bj][m][n] * scale;
              *(f32x4*)(xout + idx) = v;
              if (xb != nullptr) { uint2 o; o.x = pack2(v[0], v[1]); o.y = pack2(v[2], v[3]); *(uint2*)(xb + idx) = o; }
              ss += v[0] * v[0] + v[1] * v[1] + v[2] * v[2] + v[3] * v[3];
            }
          ss = sumq4(ss);
          if (fq == 0 && xb != nullptr) ssqo[row * 16 + u.pn * 4 + wc] = ss;
        }
      }
  }
};
struct Epi8InProj {
  static constexpr bool PERM = true;
  const float* ssq; bf16_t* Pbase; bf16_t* Cat; float* G; const float* mq_gain; const float* gate_bias;
  __device__ __forceinline__ void operator()(const Acc8& acc, const Unit& u, int ui, int wr, int wc, int fr, int fq) const {
    if (u.pn < 12) {
      const int arr = u.pn / 3, c0 = (u.pn - arr * 3) * 256;
      epi8_plain(acc, u, ui, wr, wc, fr, fq, ssq, Pbase + (size_t)arr * kT * 768, 768, c0);
    } else if (u.pn == 12) {
      epi8_headnorm(acc, u, ui, wr, wc, fr, fq, ssq, mq_gain, 0.125f, Cat, 1024, 768);
    } else if (wc == 0) {
      float rs8[2][4];
      rstd8(ui, wr, fr, rs8);
      if (fq == 0) {
#pragma unroll
        for (int ai = 0; ai < 2; ++ai)
#pragma unroll
          for (int m = 0; m < 4; ++m) {
            const size_t row = (size_t)u.pm * 256 + ai * 128 + wr * 64 + m * 16 + fr;
            *(f32x4*)(G + row * 8) = acc[ai][0][m][0] * rs8[ai][m];
            *(f32x4*)(G + row * 8 + 4) = acc[ai][0][m][1] * rs8[ai][m];
          }
      }
    }
  }
};
struct Epi8KvFfn {
  static constexpr bool PERM = true;
  const float* ssq; bf16_t* H; bf16_t* Ksh; bf16_t* Vtmp; const float* kgain;
  __device__ __forceinline__ void operator()(const Acc8& acc, const Unit& u, int ui, int wr, int wc, int fr, int fq) const {
    if (u.pn < 22) epi8_swiglu(acc, u, ui, wr, wc, fr, fq, ssq, H);
    else if (u.pn < 25) epi8_headnorm(acc, u, ui, wr, wc, fr, fq, ssq, kgain, 1.f, Ksh, 768, (u.pn - 22) * 256);
    else epi8_plain(acc, u, ui, wr, wc, fr, fq, ssq, Vtmp, 768, (u.pn - 25) * 256);
  }
};
struct Epi8QProj {
  static constexpr bool PERM = true;
  const float* ssq; bf16_t* Cat; const float* qgain; const float* mqgain;
  __device__ __forceinline__ void operator()(const Acc8& acc, const Unit& u, int ui, int wr, int wc, int fr, int fq) const {
    epi8_headnorm(acc, u, ui, wr, wc, fr, fq, ssq, (u.pn < 3) ? qgain : mqgain, 0.125f, Cat, 1024, u.pn * 256);
  }
};
struct Epi8MemKv {
  static constexpr bool PERM = true;
  const float* ssq; bf16_t* Kmem; bf16_t* Vtok; const float* kgain;
  __device__ __forceinline__ void operator()(const Acc8& acc, const Unit& u, int ui, int wr, int wc, int fr, int fq) const {
    if (u.pn == 0) epi8_headnorm(acc, u, ui, wr, wc, fr, fq, ssq, kgain, 1.f, Kmem, 256, 0);
    else epi8_plain(acc, u, ui, wr, wc, fr, fq, ssq, Vtok, 256, 0);
  }
};
__device__ __forceinline__ void memv_transpose(const bf16_t* Vtok, bf16_t* VmT) {
  for (int i = blockIdx.x * NTHR + threadIdx.x; i < 2 * 512 * 256; i += gridDim.x * NTHR) {
    const int mm = i & 255, e = (i >> 8) & 255, lb = i >> 16;
    VmT[i] = Vtok[((size_t)lb * 256 + mm) * 256 + e];
  }
}

__device__ __forceinline__ void phase_vtranspose(const bf16_t* Vtmp, bf16_t* VshT) {
  bf16_t* sT = (bf16_t*)smem;
  const int tid = threadIdx.x;
  for (int item = blockIdx.x; item < 256 * 12; item += gridDim.x) {
    const int head = item % 12, tt = item / 12, tokbase = tt * 128, b = tokbase / kS, pos0 = tokbase - b * kS;
    const int g = head >> 2, d = 1 << (2 * g);
    __syncthreads();
    for (int it = tid; it < 128 * 8; it += NTHR) {
      const int t = it >> 3, e8 = (it & 7) * 8;
      uint4 v = *(const uint4*)(Vtmp + (size_t)(tokbase + t) * 768 + head * 64 + e8);
      sT[(e8 + 0) * 136 + t] = (bf16_t)(v.x & 0xffff); sT[(e8 + 1) * 136 + t] = (bf16_t)(v.x >> 16);
      sT[(e8 + 2) * 136 + t] = (bf16_t)(v.y & 0xffff); sT[(e8 + 3) * 136 + t] = (bf16_t)(v.y >> 16);
      sT[(e8 + 4) * 136 + t] = (bf16_t)(v.z & 0xffff); sT[(e8 + 5) * 136 + t] = (bf16_t)(v.z >> 16);
      sT[(e8 + 6) * 136 + t] = (bf16_t)(v.w & 0xffff); sT[(e8 + 7) * 136 + t] = (bf16_t)(v.w >> 16);
    }
    __syncthreads();
    for (int pc = tid; pc < 64 * 16; pc += NTHR) {
      const int e = pc >> 4, piece = pc & 15;
      const int rr = (g == 0) ? 0 : (g == 1) ? (piece >> 2) : piece;
      const int s8 = (g == 0) ? piece : (g == 1) ? (piece & 3) : 0;
      const bf16_t* src = sT + e * 136 + rr;
      uint4 o;
      o.x = (uint32_t)src[(s8 * 8 + 0) * d] | ((uint32_t)src[(s8 * 8 + 1) * d] << 16);
      o.y = (uint32_t)src[(s8 * 8 + 2) * d] | ((uint32_t)src[(s8 * 8 + 3) * d] << 16);
      o.z = (uint32_t)src[(s8 * 8 + 4) * d] | ((uint32_t)src[(s8 * 8 + 5) * d] << 16);
      o.w = (uint32_t)src[(s8 * 8 + 6) * d] | ((uint32_t)src[(s8 * 8 + 7) * d] << 16);
      *(uint4*)(VshT + ((size_t)(b * 12 + head) * 64 + e) * kS + rr * (kS / d) + pos0 / d + s8 * 8) = o;
    }
  }
}

__device__ __forceinline__ bf16x8 u4_to_frag(uint4 v) { return __builtin_bit_cast(bf16x8, v); }
__device__ __forceinline__ uint4 mul_bf16x8(uint4 a, uint4 b) {
  uint4 o;
  o.x = pack2(bflo(a.x) * bflo(b.x), bfhi(a.x) * bfhi(b.x));
  o.y = pack2(bflo(a.y) * bflo(b.y), bfhi(a.y) * bfhi(b.y));
  o.z = pack2(bflo(a.z) * bflo(b.z), bfhi(a.z) * bfhi(b.z));
  o.w = pack2(bflo(a.w) * bflo(b.w), bfhi(a.w) * bfhi(b.w));
  return o;
}

__device__ __forceinline__ void phase_prep(const Params& P) {
  const bf16_t* Pk = (const bf16_t*)(P.ws + OFF_R1) + (size_t)kT * 768;
  const bf16_t* Pv = Pk + (size_t)kT * 768;
  bf16_t* kc = (bf16_t*)(P.ws + OFF_XB);
  bf16_t* kTt = (bf16_t*)(P.ws + OFF_R2);
  bf16_t* VT = kTt + (size_t)kT * 768;
  const float* G = (const float*)(P.ws + OFF_G);
  float* uArr = (float*)(P.ws + OFF_U);
  float* bArr = (float*)(P.ws + OFF_BC);
  bf16_t* eW = (bf16_t*)(P.ws + OFF_EW);
  float* umaxA = (float*)(P.ws + OFF_UMAX);
  float* blA = (float*)(P.ws + OFF_BL);
  bf16_t* sX = (bf16_t*)smem;
  float* sF = (float*)(smem + 51200);
  const int tid = threadIdx.x;
  const float kscale = 0.07216878364870322f;
  for (int item = blockIdx.x; item < 1024; item += gridDim.x) {
    const int bh = item >> 7, c = item & 127, b = bh >> 2, h = bh & 3;
    const size_t tok0 = (size_t)b * kS + (size_t)c * 128;
    __syncthreads();
    float ig = 0.f;
    if (tid < 128) {
      ig = G[(tok0 + tid) * 8 + h] + P.a_gate_bias[h];
      float fg = G[(tok0 + tid) * 8 + 4 + h] + P.a_gate_bias[4 + h];
      sF[tid] = fminf(fg, 0.f) - log1pf(__expf(-fabsf(fg)));
    }
    __syncthreads();
    float bt = 0.f;
    if (tid < 128) for (int s2 = 0; s2 <= tid; ++s2) bt += sF[s2];
    const float ut = ig - bt;
    __syncthreads();
    if (tid < 128) sF[tid] = ut;
    __syncthreads();
    float um = -3.0e38f;
    for (int s2 = 0; s2 < 128; ++s2) um = fmaxf(um, sF[s2]);
    if (tid < 128) {
      uArr[(size_t)item * 128 + tid] = ut;
      bArr[(size_t)item * 128 + tid] = bt;
      eW[(size_t)item * 128 + tid] = f2bf(__expf(ut - um));
      if (tid == 127) blA[item] = bt;
      if (tid == 0) umaxA[item] = um;
    }
    for (int it = tid; it < 128 * 24; it += NTHR) {
      const int t = it / 24, ch = (it - t * 24) * 8;
      const int spos = c * 128 + t;
      const bf16_t* src = Pk + (tok0 + t) * 768 + h * 192 + ch;
      uint4 xv[4];
      float4 w0[4], w1[4];
#pragma unroll
      for (int j = 0; j < 4; ++j) {
        xv[j] = make_uint4(0u, 0u, 0u, 0u);
        if (spos - 3 + j >= 0) xv[j] = *(const uint4*)(src - (ptrdiff_t)(3 - j) * 768);
        const float4* wp = (const float4*)(P.a_conv + j * 1536 + 768 + h * 192 + ch);
        w0[j] = wp[0]; w1[j] = wp[1];
      }
      VMWAIT();
      float a[8] = {0.f, 0.f, 0.f, 0.f, 0.f, 0.f, 0.f, 0.f};
#pragma unroll
      for (int j = 0; j < 4; ++j) {
        a[0] += w0[j].x * bflo(xv[j].x); a[1] += w0[j].y * bfhi(xv[j].x); a[2] += w0[j].z * bflo(xv[j].y); a[3] += w0[j].w * bfhi(xv[j].y);
        a[4] += w1[j].x * bflo(xv[j].z); a[5] += w1[j].y * bfhi(xv[j].z); a[6] += w1[j].z * bflo(xv[j].w); a[7] += w1[j].w * bfhi(xv[j].w);
      }
#pragma unroll
      for (int e = 0; e < 8; ++e) a[e] = a[e] / (1.f + __expf(-a[e])) * kscale;
      uint4 o; o.x = pack2(a[0], a[1]); o.y = pack2(a[2], a[3]); o.z = pack2(a[4], a[5]); o.w = pack2(a[6], a[7]);
      *(uint4*)(kc + (tok0 + t) * 768 + h * 192 + ch) = o;
      *(uint4*)(sX + t * 200 + ch) = o;
    }
    __syncthreads();
    for (int it = tid; it < 192 * 16; it += NTHR) {
      const int k = it >> 4, lg = it & 15;
      uint4 o;
      o.x = (uint32_t)sX[(lg * 8 + 0) * 200 + k] | ((uint32_t)sX[(lg * 8 + 1) * 200 + k] << 16);
      o.y = (uint32_t)sX[(lg * 8 + 2) * 200 + k] | ((uint32_t)sX[(lg * 8 + 3) * 200 + k] << 16);
      o.z = (uint32_t)sX[(lg * 8 + 4) * 200 + k] | ((uint32_t)sX[(lg * 8 + 5) * 200 + k] << 16);
      o.w = (uint32_t)sX[(lg * 8 + 6) * 200 + k] | ((uint32_t)sX[(lg * 8 + 7) * 200 + k] << 16);
      *(uint4*)(kTt + ((size_t)item * 192 + k) * 128 + lg * 8) = o;
    }
    __syncthreads();
    for (int it = tid; it < 128 * 24; it += NTHR) {
      const int t = it / 24, ch = (it - t * 24) * 8;
      uint4 v = *(const uint4*)(Pv + (tok0 + t) * 768 + h * 192 + ch);
      *(uint4*)(sX + t * 200 + ch) = v;
    }
    __syncthreads();
    for (int it = tid; it < 192 * 16; it += NTHR) {
      const int k = it >> 4, lg = it & 15;
      uint4 o;
      o.x = (uint32_t)sX[(lg * 8 + 0) * 200 + k] | ((uint32_t)sX[(lg * 8 + 1) * 200 + k] << 16);
      o.y = (uint32_t)sX[(lg * 8 + 2) * 200 + k] | ((uint32_t)sX[(lg * 8 + 3) * 200 + k] << 16);
      o.z = (uint32_t)sX[(lg * 8 + 4) * 200 + k] | ((uint32_t)sX[(lg * 8 + 5) * 200 + k] << 16);
      o.w = (uint32_t)sX[(lg * 8 + 6) * 200 + k] | ((uint32_t)sX[(lg * 8 + 7) * 200 + k] << 16);
      *(uint4*)(VT + ((size_t)item * 192 + k) * 128 + lg * 8) = o;
    }
  }
}

__device__ __forceinline__ void phase_scan(const Params& P) {
  const bf16_t* kTt = (const bf16_t*)(P.ws + OFF_R2);
  const bf16_t* VT = kTt + (size_t)kT * 768;
  const bf16_t* eW = (const bf16_t*)(P.ws + OFF_EW);
  const float* umaxA = (const float*)(P.ws + OFF_UMAX);
  const float* blA = (const float*)(P.ws + OFF_BL);
  float* m0A = (float*)(P.ws + OFF_M0);
  float* DcA = (float*)(P.ws + OFF_DC);
  bf16_t* CS = (bf16_t*)(P.ws + OFF_CS);
  bf16_t* C0T = (bf16_t*)(P.ws + OFF_R1) + (size_t)kT * 768;
  const int lane = threadIdx.x & 63, wid = threadIdx.x >> 6, nw = gridDim.x * NWAVE;
  const int r = lane & 15, q = lane >> 4;
  for (int unit = wid * gridDim.x + blockIdx.x; unit < 832; unit += nw) {
    const int sc2 = unit / 416, u2 = unit - sc2 * 416, ca = sc2 * 64;
    const int bh = u2 / 52, rem = u2 - bh * 52, mv = rem >> 2, nk = rem & 3;
    const bf16_t* vt_base = VT + ((size_t)bh * 128 * 192 + (mv < 12 ? mv : 0) * 16 + r) * 128 + q * 8;
    const bf16_t* kt_base = kTt + ((size_t)bh * 128 * 192 + nk * 48 + r) * 128 + q * 8;
    const bf16_t* ew_base = eW + (size_t)bh * 128 * 128 + q * 8;
    bf16_t* c0_base = C0T + ((size_t)bh * 128 * 208 + mv * 16 + q * 4) * 192 + nk * 48 + r;
    f32x4 acc[3];
#pragma unroll
    for (int n = 0; n < 3; ++n) acc[n] = (f32x4){0.f, 0.f, 0.f, 0.f};
    float m = 0.f;
    for (int i = 0; i < ca; ++i) { const float bli = blA[bh * 128 + i], umi = umaxA[bh * 128 + i]; m = fmaxf(bli + m, bli + umi); }
    const float m_a = m;
    float dsum = 0.f;
    uint4 A[4], B[3][4], E[4];
    float bl, um;
#define SCAN_LOAD(A_, B_, E_, bl_, um_, cc)                                                            \
  do {                                                                                                 \
    _Pragma("unroll") for (int ks = 0; ks < 4; ++ks) {                                                 \
      A_[ks] = *(const uint4*)(vt_base + (size_t)(cc) * 192 * 128 + ks * 32);                          \
      E_[ks] = *(const uint4*)(ew_base + (size_t)(cc) * 128 + ks * 32);                                \
      _Pragma("unroll") for (int n = 0; n < 3; ++n)                                                    \
        B_[n][ks] = *(const uint4*)(kt_base + (size_t)(cc) * 192 * 128 + (size_t)n * 16 * 128 + ks * 32); \
    }                                                                                                  \
    bl_ = blA[bh * 128 + (cc)]; um_ = umaxA[bh * 128 + (cc)];                                          \
  } while (0)
    SCAN_LOAD(A, B, E, bl, um, ca);
    VMWAIT();
    for (int c = ca; c < ca + 64; ++c) {
#pragma unroll
      for (int n = 0; n < 3; ++n)
#pragma unroll
        for (int j = 0; j < 4; ++j) c0_base[(size_t)c * 208 * 192 + j * 192 + n * 16] = f2bf(acc[n][j]);
      if (rem == 0 && lane == 0) { m0A[bh * 128 + c] = m; DcA[bh * 128 + c] = sc2 ? __expf(dsum + m_a - m) : 0.f; }
      uint4 nA[4], nB[3][4], nE[4];
      float nbl = 0.f, num = 0.f;
      const int cn = (c + 1 < ca + 64) ? c + 1 : c;
      SCAN_LOAD(nA, nB, nE, nbl, num, cn);
      const float mn = fmaxf(bl + m, bl + um);
      const float decay = __expf(bl + m - mn), sc = __expf(um + bl - mn);
      m = mn;
      dsum += bl;
      f32x4 U[3];
#pragma unroll
      for (int n = 0; n < 3; ++n) U[n] = (f32x4){0.f, 0.f, 0.f, 0.f};
#pragma unroll
      for (int ks = 0; ks < 4; ++ks) {
        uint4 af;
        if (mv < 12) af = mul_bf16x8(A[ks], E[ks]);
        else af = (r == 0) ? E[ks] : make_uint4(0u, 0u, 0u, 0u);
#pragma unroll
        for (int n = 0; n < 3; ++n)
          U[n] = __builtin_amdgcn_mfma_f32_16x16x32_bf16(u4_to_frag(af), u4_to_frag(B[n][ks]), U[n], 0, 0, 0);
      }
#pragma unroll
      for (int n = 0; n < 3; ++n)
#pragma unroll
        for (int j = 0; j < 4; ++j) acc[n][j] = acc[n][j] * decay + sc * U[n][j];
      VMWAIT();
#pragma unroll
      for (int ks = 0; ks < 4; ++ks) {
        A[ks] = nA[ks]; E[ks] = nE[ks];
#pragma unroll
        for (int n = 0; n < 3; ++n) B[n][ks] = nB[n][ks];
      }
      bl = nbl; um = num;
    }
    if (sc2 == 0) {
      bf16_t* cs_base = CS + ((size_t)bh * 208 + mv * 16 + q * 4) * 192 + nk * 48 + r;
#pragma unroll
      for (int n = 0; n < 3; ++n)
#pragma unroll
        for (int j = 0; j < 4; ++j) cs_base[j * 192 + n * 16] = f2bf(acc[n][j]);
    }
#undef SCAN_LOAD
  }
}

__device__ __forceinline__ void phase_chunk(const Params& P) {
  const bf16_t* Pq = (const bf16_t*)(P.ws + OFF_R1);
  const bf16_t* Po = Pq + (size_t)3 * kT * 768;
  const bf16_t* C0T = Pq + (size_t)kT * 768;
  const bf16_t* kc = (const bf16_t*)(P.ws + OFF_XB);
  const bf16_t* VT = (const bf16_t*)(P.ws + OFF_R2) + (size_t)kT * 768;
  const float* uArr = (const float*)(P.ws + OFF_U);
  const float* bArr = (const float*)(P.ws + OFF_BC);
  const float* m0A = (const float*)(P.ws + OFF_M0);
  const float* DcA = (const float*)(P.ws + OFF_DC);
  const bf16_t* CS = (const bf16_t*)(P.ws + OFF_CS);
  bf16_t* Cat = (bf16_t*)(P.ws + OFF_CAT);
  bf16_t* sQ = (bf16_t*)smem;
  float* sU = (float*)(smem + 51200);
  float* sMx = (float*)(smem + 51712);
  float* sBt = (float*)(smem + 52224);
  float* sCw = (float*)(smem + 52736);
  const int tid = threadIdx.x, lane = tid & 63, wid = tid >> 6, r = lane & 15, q = lane >> 4;
  bf16_t* sWw = (bf16_t*)(smem + 55808) + wid * (16 * 136);
  for (int item = blockIdx.x; item < 1024; item += gridDim.x) {
    const int bh = item >> 7, c = item & 127, b = bh >> 2, h = bh & 3;
    const size_t tok0 = (size_t)b * kS + (size_t)c * 128;
    __syncthreads();
    for (int i = tid; i < 768; i += NTHR) { int j = i / 192, ch = i - j * 192; sCw[i] = P.a_conv[j * 1536 + h * 192 + ch]; }
    if (tid < 128) { sU[tid] = uArr[(size_t)item * 128 + tid]; sBt[tid] = bArr[(size_t)item * 128 + tid]; }
    const float m0 = m0A[item];
    __syncthreads();
    if (tid < 128) {
      float mx = m0;
      for (int s2 = 0; s2 <= tid; ++s2) mx = fmaxf(mx, sU[s2]);
      sMx[tid] = mx;
    }
    for (int it = tid; it < 128 * 24; it += NTHR) {
      const int t = it / 24, ch = (it - t * 24) * 8;
      const int spos = c * 128 + t;
      const bf16_t* src = Pq + (tok0 + t) * 768 + h * 192 + ch;
      float a[8] = {0.f, 0.f, 0.f, 0.f, 0.f, 0.f, 0.f, 0.f};
#pragma unroll
      for (int j = 0; j < 4; ++j) {
        uint4 xv = make_uint4(0u, 0u, 0u, 0u);
        if (spos - 3 + j >= 0) xv = *(const uint4*)(src - (ptrdiff_t)(3 - j) * 768);
        const float* w = sCw + j * 192 + ch;
        a[0] += w[0] * bflo(xv.x); a[1] += w[1] * bfhi(xv.x); a[2] += w[2] * bflo(xv.y); a[3] += w[3] * bfhi(xv.y);
        a[4] += w[4] * bflo(xv.z); a[5] += w[5] * bfhi(xv.z); a[6] += w[6] * bflo(xv.w); a[7] += w[7] * bfhi(xv.w);
      }
#pragma unroll
      for (int e = 0; e < 8; ++e) a[e] = a[e] / (1.f + __expf(-a[e]));
      uint4 o; o.x = pack2(a[0], a[1]); o.y = pack2(a[2], a[3]); o.z = pack2(a[4], a[5]); o.w = pack2(a[6], a[7]);
      *(uint4*)(sQ + t * 200 + ch) = o;
    }
    __syncthreads();
    {
      const int t0 = wid * 16, nmax = t0 >> 4, ks2max = (t0 + 15) >> 5;
      {
        bf16x8 Qf[6];
#pragma unroll
        for (int ks = 0; ks < 6; ++ks) Qf[ks] = *(const bf16x8*)(sQ + (t0 + r) * 200 + ks * 32 + q * 8);
        float mxr[4];
#pragma unroll
        for (int j = 0; j < 4; ++j) mxr[j] = sMx[t0 + q * 4 + j];
#pragma unroll
        for (int n = 0; n < 8; ++n) {
          f32x4 sa = (f32x4){0.f, 0.f, 0.f, 0.f};
          if (n <= nmax) {
            uint4 Kf[6];
#pragma unroll
            for (int ks = 0; ks < 6; ++ks) Kf[ks] = *(const uint4*)(kc + (tok0 + n * 16 + r) * 768 + h * 192 + ks * 32 + q * 8);
#pragma unroll
            for (int ks = 0; ks < 6; ++ks) sa = __builtin_amdgcn_mfma_f32_16x16x32_bf16(Qf[ks], u4_to_frag(Kf[ks]), sa, 0, 0, 0);
          }
          const int scol = n * 16 + r;
          const float us = sU[scol];
#pragma unroll
          for (int j = 0; j < 4; ++j) {
            const int trow = t0 + q * 4 + j;
            float w = (n <= nmax && scol <= trow) ? __expf(us - mxr[j]) * sa[j] : 0.f;
            sWw[(q * 4 + j) * 136 + scol] = f2bf(w);
          }
        }
      }
      f32x4 acc[13];
#pragma unroll
      for (int nv = 0; nv < 13; ++nv) acc[nv] = (f32x4){0.f, 0.f, 0.f, 0.f};
      if (c >= 64) {
#pragma unroll 1
        for (int ks = 0; ks < 6; ++ks) {
          const bf16x8 qf = *(const bf16x8*)(sQ + (t0 + r) * 200 + ks * 32 + q * 8);
          uint4 Bf[13];
#pragma unroll
          for (int nv = 0; nv < 13; ++nv) Bf[nv] = *(const uint4*)(CS + ((size_t)bh * 208 + nv * 16 + r) * 192 + ks * 32 + q * 8);
#pragma unroll
          for (int nv = 0; nv < 13; ++nv) acc[nv] = __builtin_amdgcn_mfma_f32_16x16x32_bf16(qf, u4_to_frag(Bf[nv]), acc[nv], 0, 0, 0);
        }
        const float Dc = DcA[item];
#pragma unroll
        for (int nv = 0; nv < 13; ++nv) acc[nv] = acc[nv] * Dc;
      }
#pragma unroll 1
      for (int ks = 0; ks < 6; ++ks) {
        const bf16x8 qf = *(const bf16x8*)(sQ + (t0 + r) * 200 + ks * 32 + q * 8);
        uint4 Bf[13];
#pragma unroll
        for (int nv = 0; nv < 13; ++nv) Bf[nv] = *(const uint4*)(C0T + ((size_t)item * 208 + nv * 16 + r) * 192 + ks * 32 + q * 8);
#pragma unroll
        for (int nv = 0; nv < 13; ++nv) acc[nv] = __builtin_amdgcn_mfma_f32_16x16x32_bf16(qf, u4_to_frag(Bf[nv]), acc[nv], 0, 0, 0);
      }
#pragma unroll
      for (int j = 0; j < 4; ++j) {
        const float inter = __expf(m0 - sMx[t0 + q * 4 + j]);
#pragma unroll
        for (int nv = 0; nv < 13; ++nv) acc[nv][j] *= inter;
      }
#pragma unroll 1
      for (int ks2 = 0; ks2 <= ks2max; ++ks2) {
        const bf16x8 wf = *(const bf16x8*)(sWw + r * 136 + ks2 * 32 + q * 8);
        uint4 Bf[12];
#pragma unroll
        for (int nv = 0; nv < 12; ++nv) Bf[nv] = *(const uint4*)(VT + ((size_t)item * 192 + nv * 16 + r) * 128 + ks2 * 32 + q * 8);
#pragma unroll
        for (int nv = 0; nv < 12; ++nv) acc[nv] = __builtin_amdgcn_mfma_f32_16x16x32_bf16(wf, u4_to_frag(Bf[nv]), acc[nv], 0, 0, 0);
        const uint32_t one2 = (r == 0) ? 0x3F803F80u : 0u;
        acc[12] = __builtin_amdgcn_mfma_f32_16x16x32_bf16(wf, u4_to_frag(make_uint4(one2, one2, one2, one2)), acc[12], 0, 0, 0);
      }
      float hg[12];
#pragma unroll
      for (int nv = 0; nv < 12; ++nv) hg[nv] = P.a_h_norm[h * 192 + nv * 16 + r];
#pragma unroll 1
      for (int j = 0; j < 4; ++j) {
        const int trow = t0 + q * 4 + j;
        const size_t tok = tok0 + trow;
        float og[12];
#pragma unroll
        for (int nv = 0; nv < 12; ++nv) og[nv] = bf2f(Po[tok * 768 + h * 192 + nv * 16 + r]);
        float accj[13];
#pragma unroll
        for (int nv = 0; nv < 13; ++nv) accj[nv] = (j == 0) ? acc[nv][0] : (j == 1) ? acc[nv][1] : (j == 2) ? acc[nv][2] : acc[nv][3];
        const float den = __shfl(accj[12], lane & 48);
        const float mt = sBt[trow] + sMx[trow];
        const float inv = 1.f / fmaxf(fabsf(den), __expf(-mt));
        float ss = 0.f;
#pragma unroll
        for (int nv = 0; nv < 12; ++nv) { accj[nv] *= inv; ss += accj[nv] * accj[nv]; }
        ss = sum16(ss);
        const float rstd = rsqrtf(ss * (1.f / 192.f) + EPS);
        VMWAIT();
#pragma unroll
        for (int nv = 0; nv < 12; ++nv)
          Cat[tok * 1024 + h * 192 + nv * 16 + r] = f2bf(accj[nv] * rstd * hg[nv] * sigmoidf_(og[nv]));
      }
    }
  }
}

__device__ __forceinline__ float t5_bias(const float* rel_bias, int dist, int head) {
  int bucket;
  if (dist < 16) bucket = dist;
  else {
    int large = 16 + (int)(logf((float)dist / 16.f) / 4.852030263919617f * 16.f);
    bucket = large < 31 ? large : 31;
  }
  return rel_bias[bucket * 12 + head];
}

__device__ __forceinline__ void memattn_mfma(const Params& P, int layer, int gw, int nw) {
  bf16_t* Cat = (bf16_t*)(P.ws + OFF_CAT);
  const bf16_t* Kmem = (const bf16_t*)(P.ws + OFF_KMEM) + (size_t)layer * 512 * 256;
  const bf16_t* VmT = (const bf16_t*)(P.ws + OFF_VMEM) + (size_t)layer * 512 * 256;
  const int lane = threadIdx.x & 63, wid = threadIdx.x >> 6, r = lane & 15, q = lane >> 4;
  bf16_t* sP = (bf16_t*)smem + wid * (16 * 264);
  if (gw < 0) return;
  for (int item = gw; item < (kT / 16) * 4; item += nw) {
    const int head = item & 3;
    const size_t tok0 = (size_t)(item >> 2) * 16;
    const int b = (int)(tok0 / kS);
    bf16_t* qbase = Cat + tok0 * 1024 + 768 + head * 64;
    const uint4 qf0 = *(const uint4*)(qbase + (size_t)r * 1024 + q * 8);
    const uint4 qf1 = *(const uint4*)(qbase + (size_t)r * 1024 + 32 + q * 8);
    const bf16_t* Kb = Kmem + (size_t)b * 256 * 256 + head * 64 + q * 8;
    f32x4 sa[16];
#pragma unroll
    for (int n = 0; n < 16; ++n) {
      const uint4 k0 = *(const uint4*)(Kb + (size_t)(n * 16 + r) * 256);
      const uint4 k1 = *(const uint4*)(Kb + (size_t)(n * 16 + r) * 256 + 32);
      sa[n] = __builtin_amdgcn_mfma_f32_16x16x32_bf16(u4_to_frag(qf0), u4_to_frag(k0), (f32x4){0.f, 0.f, 0.f, 0.f}, 0, 0, 0);
      sa[n] = __builtin_amdgcn_mfma_f32_16x16x32_bf16(u4_to_frag(qf1), u4_to_frag(k1), sa[n], 0, 0, 0);
      if ((n & 3) == 3) __builtin_amdgcn_sched_barrier(0);
    }
    float inv[4];
#pragma unroll
    for (int j = 0; j < 4; ++j) {
      float mx = sa[0][j];
#pragma unroll
      for (int n = 1; n < 16; ++n) mx = fmaxf(mx, sa[n][j]);
      mx = max16(mx);
      float sum = 0.f;
#pragma unroll
      for (int n = 0; n < 16; ++n) {
        float p = __expf(sa[n][j] - mx);
        sum += p;
        sP[(q * 4 + j) * 264 + n * 16 + r] = f2bf(p);
      }
      inv[j] = 1.f / sum16(sum);
    }
    f32x4 o[4];
#pragma unroll
    for (int ne = 0; ne < 4; ++ne) o[ne] = (f32x4){0.f, 0.f, 0.f, 0.f};
    const bf16_t* Vb = VmT + (size_t)(b * 4 + head) * 64 * 256 + q * 8;
#pragma unroll
    for (int ks = 0; ks < 8; ++ks) {
      const bf16x8 pf = *(const bf16x8*)(sP + r * 264 + ks * 32 + q * 8);
#pragma unroll
      for (int ne = 0; ne < 4; ++ne) {
        const uint4 vf = *(const uint4*)(Vb + (size_t)(ne * 16 + r) * 256 + ks * 32);
        o[ne] = __builtin_amdgcn_mfma_f32_16x16x32_bf16(pf, u4_to_frag(vf), o[ne], 0, 0, 0);
      }
      if (ks & 1) __builtin_amdgcn_sched_barrier(0);
    }
    VMWAIT();
#pragma unroll
    for (int ne = 0; ne < 4; ++ne)
#pragma unroll
      for (int j = 0; j < 4; ++j) qbase[(size_t)(q * 4 + j) * 1024 + ne * 16 + r] = f2bf(o[ne][j] * inv[j]);
  }
}

__device__ __forceinline__ void dilated_slab(const Params& P, int pass, int sidx, int b, int p0, int hg, const float* sBias,
                                             float* sLse, bf16_t* sP) {
  bf16_t* Cat = (bf16_t*)(P.ws + OFF_CAT);
  const bf16_t* Ksh = (const bf16_t*)(P.ws + OFF_R2);
  const bf16_t* VshT = Ksh + (size_t)kT * 768;
  const int lane = threadIdx.x & 63, r = lane & 15, q = lane >> 4;
  const int g = sidx >> 4, i = sidx & 15, d = 1 << (2 * g), head = g * 4 + hg;
  const int r_res = (g == 0) ? 0 : (g == 1) ? (i >> 2) : i;
  const int sig0 = (g == 0) ? (p0 + 16 * i) : (g == 1) ? ((p0 >> 2) + 16 * (i & 3)) : (p0 >> 4);
  const size_t tokq = (size_t)b * kS + (size_t)(sig0 + r) * d + r_res;
  const uint4 qf0 = *(const uint4*)(Cat + tokq * 1024 + head * 64 + q * 8);
  const uint4 qf1 = *(const uint4*)(Cat + tokq * 1024 + head * 64 + 32 + q * 8);
  f32x4 sa[10];
  sa[0] = (f32x4){0.f, 0.f, 0.f, 0.f};
#pragma unroll
  for (int n = 1; n < 10; ++n) {
    int sigk = sig0 - 144 + n * 16 + r;
    sigk = sigk < 0 ? 0 : sigk;
    const bf16_t* kp = Ksh + ((size_t)b * kS + (size_t)sigk * d + r_res) * 768 + head * 64 + q * 8;
    const uint4 k0 = *(const uint4*)kp;
    const uint4 k1 = *(const uint4*)(kp + 32);
    sa[n] = __builtin_amdgcn_mfma_f32_16x16x32_bf16(u4_to_frag(qf0), u4_to_frag(k0), (f32x4){0.f, 0.f, 0.f, 0.f}, 0, 0, 0);
    sa[n] = __builtin_amdgcn_mfma_f32_16x16x32_bf16(u4_to_frag(qf1), u4_to_frag(k1), sa[n], 0, 0, 0);
  }
  float scl[4];
#pragma unroll
  for (int j = 0; j < 4; ++j) {
    float mx = -1e30f;
#pragma unroll
    for (int n = 1; n < 10; ++n) {
      const int mo = 144 + q * 4 + j - n * 16 - r;
      const int sigk = sig0 - 144 + n * 16 + r;
      const bool ok = (mo >= 0) && (mo <= 128) && (sigk >= 0);
      const float sv = ok ? (sa[n][j] + sBias[g * 132 + (ok ? mo : 0)]) : -1e30f;
      sa[n][j] = sv;
      mx = fmaxf(mx, sv);
    }
    mx = max16(mx);
    float sum = 0.f;
#pragma unroll
    for (int n = 1; n < 10; ++n) {
      const float p = (sa[n][j] > -1e29f) ? __expf(sa[n][j] - mx) : 0.f;
      sa[n][j] = p;
      sum += p;
    }
    sum = sum16(sum);
    const float lse = mx + __logf(sum);
    const int pw = (sig0 + q * 4 + j) * d + r_res - p0;
    if (pass == 0) {
      if (r == 0) sLse[g * 256 + pw] = lse;
      scl[j] = 0.f;
    } else {
      const float l0 = sLse[pw], l1 = sLse[256 + pw], l2 = sLse[512 + pw];
      const float L = fmaxf(fmaxf(l0, l1), l2);
      const float den = __expf(l0 - L) + __expf(l1 - L) + __expf(l2 - L);
      scl[j] = __expf(lse - L) / (den * sum);
    }
  }
  if (pass == 0) return;
#pragma unroll
  for (int j = 0; j < 4; ++j) {
#pragma unroll
    for (int n = 0; n < 10; ++n) sP[(q * 4 + j) * 168 + n * 16 + r] = f2bf(sa[n][j]);
  }
  f32x4 o[4];
#pragma unroll
  for (int ne = 0; ne < 4; ++ne) o[ne] = (f32x4){0.f, 0.f, 0.f, 0.f};
  const bf16_t* Vb = VshT + ((size_t)(b * 12 + head) * 64 + r) * kS + (size_t)r_res * (kS / d);
#pragma unroll
  for (int ks = 0; ks < 5; ++ks) {
    const bf16x8 pf = *(const bf16x8*)(sP + r * 168 + ks * 32 + q * 8);
    int sk0 = sig0 - 144 + ks * 32 + q * 8;
    sk0 = sk0 < 0 ? 0 : sk0;
#pragma unroll
    for (int ne = 0; ne < 4; ++ne) {
      const uint4 vf = *(const uint4*)(Vb + (size_t)ne * 16 * kS + sk0);
      o[ne] = __builtin_amdgcn_mfma_f32_16x16x32_bf16(pf, u4_to_frag(vf), o[ne], 0, 0, 0);
    }
  }
  VMWAIT();
#pragma unroll
  for (int ne = 0; ne < 4; ++ne)
#pragma unroll
    for (int j = 0; j < 4; ++j) {
      const size_t tok = (size_t)b * kS + (size_t)(sig0 + q * 4 + j) * d + r_res;
      Cat[tok * 1024 + head * 64 + ne * 16 + r] = f2bf(o[ne][j] * scl[j]);
    }
}

__device__ __forceinline__ void phase_dilated_mfma(const Params& P) {
  float* sBias = (float*)smem;
  float* sLse = (float*)(smem + 1584);
  const int tid = threadIdx.x, wid = tid >> 6;
  bf16_t* sP = (bf16_t*)(smem + 4656) + wid * (16 * 168);
  for (int item = blockIdx.x; item < 512; item += gridDim.x) {
    const int hg = item & 3, win = item >> 2, b = win >> 6, p0 = (win & 63) * 256;
    __syncthreads();
    for (int i = tid; i < 3 * 129; i += NTHR) {
      const int g = i / 129, mo = i - g * 129;
      sBias[g * 132 + mo] = t5_bias(P.rel_bias, mo << (2 * g), g * 4 + hg);
    }
    __syncthreads();
#pragma unroll 1
    for (int pass = 0; pass < 2; ++pass) {
#pragma unroll 1
      for (int sidx = wid; sidx < 48; sidx += NWAVE) dilated_slab(P, pass, sidx, b, p0, hg, sBias, sLse, sP);
      VMWAIT();
      __syncthreads();
    }
  }
}

#define XB_TMO      128
#define XB_XCNT(j)  (256  + 64 * (j))
#define XB_XSUB(j)  (1280 + 64 * (j))
#define XB_XGEN(j)  (2304 + 64 * (j))
#define XB_TOP      3328
#define XB_TOPGEN   3392
#define XCD_BAR_WORDS 3456
#define XB_SPIN_CAP (1u << 23)
__device__ __forceinline__ unsigned xb_ld(unsigned* p) { return __hip_atomic_load(p, __ATOMIC_RELAXED, __HIP_MEMORY_SCOPE_AGENT); }
__device__ __forceinline__ unsigned xb_add(unsigned* p, unsigned v) { return __hip_atomic_fetch_add(p, v, __ATOMIC_RELAXED, __HIP_MEMORY_SCOPE_AGENT); }
__device__ __forceinline__ unsigned xb_xcc_id() { return (unsigned)__builtin_amdgcn_s_getreg((3 << 11) | 20) & 0xFu; }
#define XB_SPIN(cond, bar) do { unsigned _sp = 0; while (cond) { __builtin_amdgcn_s_sleep(1); \
    if ((++_sp & 255u) == 0u) { if (xb_ld(&(bar)[XB_TMO])) break; if (_sp > XB_SPIN_CAP) { atomicAdd(&(bar)[XB_TMO], 1u); break; } } } } while (0)
struct XcdBarrier { unsigned* bar; unsigned x; volatile LAS unsigned* st; };
__device__ __forceinline__ XcdBarrier xcd_barrier_post(unsigned* bar, volatile LAS unsigned* st) {
  XcdBarrier b; b.bar = bar; b.x = xb_xcc_id(); b.st = st;
  if (threadIdx.x == 0) (void)xb_add(&bar[XB_XCNT(b.x)], 1u);
  return b;
}
__device__ __forceinline__ void xcd_barrier_complete(unsigned* bar, unsigned x, unsigned& nloc, unsigned& nx) {
  const unsigned Gr = gridDim.x * gridDim.y * gridDim.z;
  unsigned sum, cnt, mine, sp = 0u;
  for (;;) {
    sum = 0u; cnt = 0u; mine = 0u;
#pragma unroll
    for (unsigned j = 0; j < 16; ++j) { const unsigned c = xb_ld(&bar[XB_XCNT(j)]); sum += c; cnt += (c > 0u) ? 1u : 0u; mine = (j == x) ? c : mine; }
    if (sum == Gr) break;
    __builtin_amdgcn_s_sleep(1);
    if ((++sp & 255u) == 0u) { if (xb_ld(&bar[XB_TMO])) break; if (sp > XB_SPIN_CAP) { atomicAdd(&bar[XB_TMO], 1u); break; } }
  }
  nloc = mine > 0u ? mine : 1u; nx = cnt > 0u ? cnt : 1u;
}
__device__ __forceinline__ void xcd_barrier(const XcdBarrier& b) {
  asm volatile("s_waitcnt vmcnt(0)" ::: "memory");
  __syncthreads();
  if (threadIdx.x == 0) {
    unsigned* bar = b.bar;
    __builtin_amdgcn_s_waitcnt(0);
    unsigned nloc = b.st[0], nx = b.st[1];
    if (nloc == 0u) { xcd_barrier_complete(bar, b.x, nloc, nx); b.st[0] = nloc; b.st[1] = nx; }
    const unsigned old = xb_add(&bar[XB_XSUB(b.x)], 1u);
    const unsigned gen = old / nloc;
    if (old + 1u == (gen + 1u) * nloc) {
      __builtin_amdgcn_fence(__ATOMIC_RELEASE, "agent");
      asm volatile("s_waitcnt vmcnt(0)" ::: "memory");
      const unsigned og = xb_add(&bar[XB_TOP], 1u);
      const unsigned tg = og / nx;
      if (og + 1u == (tg + 1u) * nx) xb_add(&bar[XB_TOPGEN], 1u);
      else XB_SPIN(xb_ld(&bar[XB_TOPGEN]) == tg, bar);
      __builtin_amdgcn_fence(__ATOMIC_ACQUIRE, "agent");
      xb_add(&bar[XB_XGEN(b.x)], 1u);
      asm volatile("s_waitcnt vmcnt(0)" ::: "memory");
    } else {
      XB_SPIN(xb_ld(&bar[XB_XGEN(b.x)]) == gen, bar);
      __builtin_amdgcn_fence(__ATOMIC_ACQUIRE, "agent");
      asm volatile("s_waitcnt vmcnt(0)" ::: "memory");
    }
  }
  __syncthreads();
}
#define grid_barrier() xcd_barrier(xbar_)

constexpr int NPHASE = 17;
#ifndef ONLY_PHASE
#define ONLY_PHASE -1
#endif
#ifndef SKIP12
#define SKIP12 0
#endif
#ifndef SKIP14
#define SKIP14 0
#endif
#define PH(n) (ONLY_PHASE < 0 || ONLY_PHASE == (n))

__device__ __forceinline__ char* launder(char* p) { asm volatile("" : "+s"(p)); return p; }
__global__ void __launch_bounds__(512, 2) fwd_megakernel(Params P, int pb, int pe) {
#define W ((bf16_t*)(wsl + OFF_W))
#define xb ((bf16_t*)(wsl + OFF_XB))
#define H ((bf16_t*)(wsl + OFF_R1))
#define Pbase ((bf16_t*)(wsl + OFF_R1))
#define Ksh ((bf16_t*)(wsl + OFF_R2))
#define Vsh (Ksh + (size_t)kT * 768)
#define Cat ((bf16_t*)(wsl + OFF_CAT))
#define ssq ((float*)(wsl + OFF_SSQ))
#define G ((float*)(wsl + OFF_G))
#define memb ((bf16_t*)(wsl + OFF_MEMB))
#define ssqm ((float*)(wsl + OFF_SSQM))
#define Kmem ((bf16_t*)(wsl + OFF_KMEM))
#define Vmem ((bf16_t*)(wsl + OFF_VMEM))
  if (pe < -12345) cg::this_grid().sync();
  volatile LAS unsigned* xst_ = (volatile LAS unsigned*)(smem + 131072);
  if (threadIdx.x == 0) { xst_[0] = 0u; xst_[1] = 0u; }
  __syncthreads();
  XcdBarrier xbar_;
  xbar_.bar = (unsigned*)(P.ws + OFF_BAR); xbar_.x = 0; xbar_.st = xst_;
  if (pe - pb > 1) xbar_ = xcd_barrier_post((unsigned*)(P.ws + OFF_BAR), xst_);
  if (pb == 100) {
    char* wsl = P.ws;
    for (size_t i = (size_t)blockIdx.x * NTHR + threadIdx.x; i < (size_t)kT * 1024; i += (size_t)gridDim.x * NTHR) P.out[i] = bf2f(Cat[i]);
    return;
  }
  {
    if (pb <= 0 && 0 < pe && PH(0)) { char* wsl = launder(P.ws); Params Q = P; Q.ws = wsl; (void)Q; phase_convert(Q); }
    if (pb <= 0 && 0 + 1 < pe) grid_barrier();
    if (pb <= 1 && 1 < pe && PH(1)) { char* wsl = launder(P.ws); Params Q = P; Q.ws = wsl; (void)Q; gemm8(xb, W + W_GU0, kT, 5632, 1024, Epi8Swiglu{ssq, H}); }
    if (pb <= 1 && 1 + 1 < pe) grid_barrier();
    if (pb <= 2 && 2 < pe && PH(2)) { char* wsl = launder(P.ws); Params Q = P; Q.ws = wsl; (void)Q; { gemm8(H, W + W_DN0, kT, 1024, 2816, Epi8Resid{P.x, P.out, xb, ssq, 0.5f});
      gemm8(memb, W + W_MKV0, 512, 512, 1024, Epi8MemKv{ssqm, Kmem, (bf16_t*)(wsl + OFF_VTOK), P.mem_k_norm}, 64);
      gemm8(memb, W + W_MKV1, 512, 512, 1024, Epi8MemKv{ssqm, Kmem + 512 * 256, (bf16_t*)(wsl + OFF_VTOK) + 512 * 256, P.mem_k_norm + 64}, 192);
    } }
    if (pb <= 2 && 2 + 1 < pe) grid_barrier();
    if (pb <= 3 && 3 < pe && PH(3)) { char* wsl = launder(P.ws); Params Q = P; Q.ws = wsl; (void)Q; {
      gemm8(xb, W + W_IN, kT, 3584, 1024, Epi8InProj{ssq, Pbase, Cat, G, P.mem_q_norm, P.a_gate_bias});
    } }
    if (pb <= 3 && 3 + 1 < pe) grid_barrier();
    if (pb <= 4 && 4 < pe && PH(4)) { char* wsl = launder(P.ws); Params Q = P; Q.ws = wsl; (void)Q; { memv_transpose((const bf16_t*)(wsl + OFF_VTOK), Vmem); phase_prep(Q); } }
    if (pb <= 4 && 4 + 1 < pe) grid_barrier();
    if (pb <= 5 && 5 < pe && PH(5)) { char* wsl = launder(P.ws); Params Q = P; Q.ws = wsl; (void)Q; phase_scan(Q); { const int wv = (int)(threadIdx.x >> 6) * (int)gridDim.x + (int)blockIdx.x, tot = (int)gridDim.x * NWAVE; if (tot > 832 + 64) { memattn_mfma(Q, 0, wv - 832, tot - 832); if (wv >= 832) wave_convert(Q, wv - 832, tot - 832, false); } else { memattn_mfma(Q, 0, wv, tot); wave_convert(Q, wv, tot, false); } } }
    if (pb <= 5 && 5 + 1 < pe) grid_barrier();
    if (pb <= 6 && 6 < pe && PH(6)) { char* wsl = launder(P.ws); Params Q = P; Q.ws = wsl; (void)Q; phase_chunk(Q); }
    if (pb <= 6 && 6 + 1 < pe) grid_barrier();
    if (pb <= 7 && 7 < pe && PH(7)) { char* wsl = launder(P.ws); Params Q = P; Q.ws = wsl; (void)Q; gemm8(Cat, W + W_AOUT, kT, 1024, 1024, Epi8Resid{P.out, P.out, xb, ssq, 1.f}); }
    if (pb <= 7 && 7 + 1 < pe) grid_barrier();
    if (pb <= 8 && 8 < pe && PH(8)) { char* wsl = launder(P.ws); Params Q = P; Q.ws = wsl; (void)Q; gemm8(xb, W + W_GU1, kT, 5632, 1024, Epi8Swiglu{ssq, H}); }
    if (pb <= 8 && 8 + 1 < pe) grid_barrier();
    if (pb <= 9 && 9 < pe && PH(9)) { char* wsl = launder(P.ws); Params Q = P; Q.ws = wsl; (void)Q; gemm8(H, W + W_DN1, kT, 1024, 2816, Epi8Resid{P.out, P.out, xb, ssq, 0.5f}); }
    if (pb <= 9 && 9 + 1 < pe) grid_barrier();
    if (pb <= 10 && 10 < pe && PH(10)) { char* wsl = launder(P.ws); Params Q = P; Q.ws = wsl; (void)Q; gemm8(xb, W + W_GU2, kT, 7168, 1024, Epi8KvFfn{ssq, H, Ksh, Cat, P.kv_k_norm}); }
    if (pb <= 10 && 10 + 1 < pe) grid_barrier();
    if (pb <= 11 && 11 < pe && PH(11)) { char* wsl = launder(P.ws); Params Q = P; Q.ws = wsl; (void)Q; { gemm8(H, W + W_DN2, kT, 1024, 2816, Epi8Resid{P.out, P.out, xb, ssq, 0.5f}); phase_vtranspose(Cat, Vsh); } }
    if (pb <= 11 && 11 + 1 < pe) grid_barrier();
    if (pb <= 12 && 12 < pe && PH(12) && !SKIP12) { char* wsl = launder(P.ws); Params Q = P; Q.ws = wsl; (void)Q; gemm8(xb, W + W_BQ, kT, 1024, 1024, Epi8QProj{ssq, Cat, P.b_q_norm, P.mem_q_norm + 64}); }
    if (pb <= 12 && 12 + 1 < pe) grid_barrier();
    if (pb <= 13 && 13 < pe && PH(13)) { char* wsl = launder(P.ws); Params Q = P; Q.ws = wsl; (void)Q; { phase_dilated_mfma(Q); memattn_mfma(Q, 1, (int)blockIdx.x * NWAVE + (int)(threadIdx.x >> 6), (int)gridDim.x * NWAVE); } }
    if (pb <= 13 && 13 + 1 < pe) grid_barrier();
    if (pb <= 14 && 14 < pe && PH(14) && !SKIP14) { char* wsl = launder(P.ws); Params Q = P; Q.ws = wsl; (void)Q; gemm8(Cat, W + W_BOUT, kT, 1024, 1024, Epi8Resid{P.out, P.out, xb, ssq, 1.f}); }
    if (pb <= 14 && 14 + 1 < pe) grid_barrier();
    if (pb <= 15 && 15 < pe && PH(15)) { char* wsl = launder(P.ws); Params Q = P; Q.ws = wsl; (void)Q; gemm8(xb, W + W_GU3, kT, 5632, 1024, Epi8Swiglu{ssq, H}); }
    if (pb <= 15 && 15 + 1 < pe) grid_barrier();
    if (pb <= 16 && 16 < pe && PH(16)) { char* wsl = launder(P.ws); Params Q = P; Q.ws = wsl; (void)Q; gemm8(H, W + W_DN3, kT, 1024, 2816, Epi8Resid{P.out, P.out, nullptr, ssq, 0.5f}); }
  }
}
#undef W
#undef xb
#undef H
#undef Pbase
#undef Ksh
#undef Vsh
#undef Cat
#undef ssq
#undef G
#undef memb
#undef ssqm
#undef Kmem
#undef Vmem

extern "C" void kernel_launch(void* const* d_in, const int* in_sizes, int n_in, void* d_out, int out_size, void* d_ws,
                              size_t ws_size, hipStream_t stream) {
  (void)in_sizes; (void)n_in; (void)out_size;
  static int grid_blocks = 0;
  if (!grid_blocks) {
    int dev = 0, cus = 0, per_cu = 0;
    hipGetDevice(&dev);
    hipDeviceGetAttribute(&cus, hipDeviceAttributeMultiprocessorCount, dev);
    hipOccupancyMaxActiveBlocksPerMultiprocessor(&per_cu, fwd_megakernel, NTHR, 0);
    if (per_cu > 1) per_cu = 1;
    grid_blocks = cus * per_cu;
    if (ws_size < OFF_END) fprintf(stderr, "workspace too small: %zu < %zu\n", ws_size, (size_t)OFF_END);
  }
  Params p{};
  const float** pf = (const float**)&p;
  for (int i = 0; i < 27; ++i) pf[i] = (const float*)d_in[i];
  p.out = (float*)d_out;
  p.ws = (char*)d_ws;
#ifndef RUN_PE
#define RUN_PE NPHASE
#endif
#ifdef MULTI_LAUNCH
  hipError_t e = hipSuccess;
  for (int ph = 0; ph < RUN_PE; ++ph) {
    int pb = ph, pe = ph + 1;
    hipLaunchKernelGGL(fwd_megakernel, dim3(grid_blocks), dim3(NTHR), 0, stream, p, pb, pe);
  }
#else
  hipMemsetAsync((char*)d_ws + OFF_BAR, 0, 16384, stream);
  int pb = 0, pe = RUN_PE;
  void* args[] = {&p, &pb, &pe};
  hipError_t e = hipLaunchCooperativeKernel((void*)fwd_megakernel, dim3(grid_blocks), dim3(NTHR), args, 0, stream);
#endif
  if (e != hipSuccess) fprintf(stderr, "cooperative launch failed: %s (grid %d)\n", hipGetErrorString(e), grid_blocks);
}
```

```cpp
#include <hip/hip_runtime.h>
#include <hip/hip_cooperative_groups.h>
#include <stdint.h>
#include <stdio.h>
namespace cg = cooperative_groups;

typedef unsigned short bf16_t;
typedef __attribute__((ext_vector_type(8))) short bf16x8;
typedef __attribute__((ext_vector_type(4))) float f32x4;
#define LAS __attribute__((address_space(3)))
#define VMWAIT() asm volatile("s_waitcnt vmcnt(0)" ::: "memory")

constexpr int kT = 32768, kS = 16384;
constexpr int NTHR = 512, NWAVE = 8;
constexpr float EPS = 1e-6f;

constexpr size_t GU_SZ = 5632ull * 1024, DN_SZ = 1024ull * 2816, KV_SZ = 1536ull * 1024, IN_SZ = 3584ull * 1024,
                 SQ_SZ = 1024ull * 1024, MKV_SZ = 512ull * 1024;
constexpr size_t W_GU0 = 0, W_GU1 = GU_SZ, W_GU2 = 2 * GU_SZ, W_KV = 3 * GU_SZ, W_GU3 = W_KV + KV_SZ,
                 W_DN0 = W_GU3 + GU_SZ, W_DN1 = W_DN0 + DN_SZ, W_DN2 = W_DN1 + DN_SZ, W_DN3 = W_DN2 + DN_SZ,
                 W_IN = W_DN3 + DN_SZ, W_AOUT = W_IN + IN_SZ, W_BQ = W_AOUT + SQ_SZ, W_BOUT = W_BQ + SQ_SZ,
                 W_MKV0 = W_BOUT + SQ_SZ, W_MKV1 = W_MKV0 + MKV_SZ, W_END = W_MKV1 + MKV_SZ;
constexpr size_t PSZ = (size_t)kT * 768 * 2;
constexpr size_t OFF_W = 0;
constexpr size_t OFF_XB = (W_END * 2 + 255) / 256 * 256;
constexpr size_t OFF_R1 = OFF_XB + (size_t)kT * 1024 * 2;
constexpr size_t OFF_R2 = OFF_R1 + 4 * PSZ;
constexpr size_t OFF_CAT = OFF_R2 + 2 * PSZ;
constexpr size_t OFF_SSQ = OFF_CAT + (size_t)kT * 1024 * 2;
constexpr size_t OFF_G = OFF_SSQ + (size_t)kT * 16 * 4;
constexpr size_t OFF_MEMB = OFF_G + (size_t)kT * 8 * 4;
constexpr size_t OFF_SSQM = OFF_MEMB + 512ull * 1024 * 2;
constexpr size_t OFF_KMEM = OFF_SSQM + 512ull * 16 * 4;
constexpr size_t OFF_VMEM = OFF_KMEM + 2ull * 512 * 256 * 2;
constexpr size_t OFF_U = OFF_VMEM + 2ull * 512 * 256 * 2;
constexpr size_t OFF_BC = OFF_U + 1024ull * 128 * 4;
constexpr size_t OFF_EW = OFF_BC + 1024ull * 128 * 4;
constexpr size_t OFF_UMAX = OFF_EW + 1024ull * 128 * 2;
constexpr size_t OFF_BL = OFF_UMAX + 4096;
constexpr size_t OFF_M0 = OFF_BL + 4096;
constexpr size_t OFF_BAR = OFF_M0 + 4096;
constexpr size_t OFF_VTOK = OFF_BAR + 16384;
constexpr size_t OFF_END = OFF_VTOK + 2ull * 512 * 256 * 2;

struct Params {
  const float *x, *mem, *ffn1_norm, *ffn1_wg, *ffn1_wu, *ffn1_wd, *ffn2_norm, *ffn2_wg, *ffn2_wu, *ffn2_wd, *mix_norm,
      *mem_norm, *w_mem_kv, *mem_q_norm, *mem_k_norm, *a_w_in, *a_conv, *a_gate_bias, *a_h_norm, *a_w_out, *b_w_q,
      *b_q_norm, *b_w_out, *kv_norm, *w_kv, *kv_k_norm, *rel_bias;
  float* out;
  char* ws;
};

__shared__ __attribute__((aligned(16))) char smem[146432];

__device__ __forceinline__ bf16_t f2bf(float f) {
  uint32_t u = __float_as_uint(f);
  u += 0x7fffu + ((u >> 16) & 1u);
  return (bf16_t)(u >> 16);
}
__device__ __forceinline__ float bf2f(bf16_t h) { return __uint_as_float(((uint32_t)h) << 16); }
__device__ __forceinline__ float bflo(uint32_t u) { return __uint_as_float(u << 16); }
__device__ __forceinline__ float bfhi(uint32_t u) { return __uint_as_float(u & 0xffff0000u); }
__device__ __forceinline__ uint32_t pack2(float a, float b) { uint32_t r; asm("v_cvt_pk_bf16_f32 %0, %1, %2" : "=v"(r) : "v"(a), "v"(b)); return r; }
__device__ __forceinline__ float dot8(uint4 a, uint4 b) {
  return bflo(a.x) * bflo(b.x) + bfhi(a.x) * bfhi(b.x) + bflo(a.y) * bflo(b.y) + bfhi(a.y) * bfhi(b.y) +
         bflo(a.z) * bflo(b.z) + bfhi(a.z) * bfhi(b.z) + bflo(a.w) * bflo(b.w) + bfhi(a.w) * bfhi(b.w);
}
__device__ __forceinline__ float wave_sum(float v) {
  for (int o = 32; o > 0; o >>= 1) v += __shfl_xor(v, o);
  return v;
}
__device__ __forceinline__ float wave_max(float v) {
  for (int o = 32; o > 0; o >>= 1) v = fmaxf(v, __shfl_xor(v, o));
  return v;
}
__device__ __forceinline__ float dpp_ror_(float v, int) { return v; }
#define DPP_ROR_ADD(v, ctrl) v += __builtin_bit_cast(float, __builtin_amdgcn_update_dpp(0, __builtin_bit_cast(int, v), ctrl, 0xf, 0xf, false))
__device__ __forceinline__ float sum16(float v) {
  DPP_ROR_ADD(v, 0x128); DPP_ROR_ADD(v, 0x124); DPP_ROR_ADD(v, 0x122); DPP_ROR_ADD(v, 0x121);
  return v;
}
#define DPP_ROR_MAX(v, ctrl) v = fmaxf(v, __builtin_bit_cast(float, __builtin_amdgcn_update_dpp(0, __builtin_bit_cast(int, v), ctrl, 0xf, 0xf, false)))
__device__ __forceinline__ float max16(float v) {
  DPP_ROR_MAX(v, 0x128); DPP_ROR_MAX(v, 0x124); DPP_ROR_MAX(v, 0x122); DPP_ROR_MAX(v, 0x121);
  return v;
}
__device__ __forceinline__ float sigmoidf_(float x) { return __builtin_amdgcn_rcpf(1.f + __expf(-x)); }

struct WJob { size_t dst; int Nd, K; };
__device__ __forceinline__ WJob wjob(int j) {
  switch (j) {
    case 0: return {W_GU0, 5632, 1024};
    case 1: return {W_GU1, 5632, 1024};
    case 2: return {W_GU2, 5632, 1024};
    case 3: return {W_GU3, 5632, 1024};
    case 4: return {W_DN0, 1024, 2816};
    case 5: return {W_DN1, 1024, 2816};
    case 6: return {W_DN2, 1024, 2816};
    case 7: return {W_DN3, 1024, 2816};
    case 8: return {W_IN, 3584, 1024};
    case 9: return {W_AOUT, 1024, 1024};
    case 10: return {W_BQ, 1024, 1024};
    case 11: return {W_BOUT, 1024, 1024};
    case 12: return {W_KV, 1536, 1024};
    case 13: return {W_MKV0, 512, 1024};
    default: return {W_MKV1, 512, 1024};
  }
}
__device__ __forceinline__ int headmap(int r256) { const int bj = r256 >> 7, hh = (r256 & 127) >> 5, i = r256 & 31; return hh * 64 + bj * 32 + i; }
__device__ __forceinline__ void wsrc(const Params& P, int j, int n, const float*& p, int& ld, const float*& gain) {
  p = nullptr; ld = 0; gain = nullptr;
  if (j < 4) {
    int layer = j >> 1, which = j & 1;
    int pn = n >> 8, r = n & 255, bj = r >> 7, col = pn * 128 + (r & 127);
    const float* wg = which ? P.ffn2_wg : P.ffn1_wg;
    const float* wu = which ? P.ffn2_wu : P.ffn1_wu;
    p = (bj ? wu : wg) + (size_t)layer * 1024 * 2816 + col;
    ld = 2816;
    gain = (which ? P.ffn2_norm : P.ffn1_norm) + layer * 1024;
  } else if (j < 8) {
    int i = j - 4, layer = i >> 1, which = i & 1;
    p = (which ? P.ffn2_wd : P.ffn1_wd) + (size_t)layer * 2816 * 1024 + n;
    ld = 1024;
  } else if (j == 8) {
    int col = -1;
    if (n < 3072) col = n; else if (n < 3328) col = 3080 + headmap(n - 3072); else if (n < 3336) col = 3072 + (n - 3328);
    if (col >= 0) { p = P.a_w_in + col; ld = 3336; }
    gain = P.mix_norm;
  } else if (j == 9) { p = P.a_w_out + n; ld = 1024; }
  else if (j == 10) { p = P.b_w_q + (n & ~255) + headmap(n & 255); ld = 1024; gain = P.mix_norm + 1024; }
  else if (j == 11) { p = P.b_w_out + n; ld = 1024; }
  else if (j == 12) { int col = (n < 768) ? ((n & ~255) + headmap(n & 255)) : n; p = P.w_kv + col; ld = 1536; gain = P.kv_norm; }
  else { int l = j - 13; int col = (n < 256) ? headmap(n) : n; p = P.w_mem_kv + (size_t)l * 1024 * 512 + col; ld = 512; gain = P.mem_norm + l * 1024; }
}

__device__ __forceinline__ void convert_tile(const Params& P, int j, int t, int lane) {
  bf16_t* W = (bf16_t*)(P.ws + OFF_W);
  WJob wj = wjob(j);
  const int tk_cnt = wj.K >> 6;
  const int tn = t / tk_cnt, tk = t - tn * tk_cnt, n = (tn << 6) + lane, k0 = tk << 6;
  const float* sp; int ld; const float* gain;
  wsrc(P, j, n, sp, ld, gain);
  float v[64];
#pragma unroll
  for (int k = 0; k < 64; ++k) v[k] = sp ? sp[(size_t)(k0 + k) * ld] : 0.f;
  if (gain) {
#pragma unroll
    for (int k4 = 0; k4 < 16; ++k4) {
      const float4 g4 = *(const float4*)(gain + k0 + k4 * 4);
      v[k4 * 4 + 0] *= g4.x; v[k4 * 4 + 1] *= g4.y; v[k4 * 4 + 2] *= g4.z; v[k4 * 4 + 3] *= g4.w;
    }
  }
  VMWAIT();
  bf16_t* dst = W + wj.dst + (size_t)n * wj.K + k0;
#pragma unroll
  for (int k8 = 0; k8 < 8; ++k8) {
    uint4 o;
    o.x = pack2(v[k8 * 8 + 0], v[k8 * 8 + 1]); o.y = pack2(v[k8 * 8 + 2], v[k8 * 8 + 3]);
    o.z = pack2(v[k8 * 8 + 4], v[k8 * 8 + 5]); o.w = pack2(v[k8 * 8 + 6], v[k8 * 8 + 7]);
    *(uint4*)(dst + k8 * 8) = o;
  }
}
__device__ __forceinline__ void wave_convert(const Params& P, int widx, int nwv, bool early) {
  const int lane = threadIdx.x & 63;
  int base = 0;
  for (int j = 0; j < 15; ++j) {
    const bool is_early = (j == 0 || j == 4 || j == 8 || j >= 13);
    if (is_early != early) continue;
    WJob wj = wjob(j);
    const int ntile = (wj.Nd >> 6) * (wj.K >> 6);
    const int first = (widx + nwv - (base % nwv)) % nwv;
    for (int t = first; t < ntile; t += nwv) convert_tile(P, j, t, lane);
    base += ntile;
  }
}
__device__ __forceinline__ void wave_convert_queue(const Params& P, unsigned* counter) {
  const int lane = threadIdx.x & 63;
  for (;;) {
    unsigned t0 = 0;
    if (lane == 0) t0 = __hip_atomic_fetch_add(counter, 2u, __ATOMIC_RELAXED, __HIP_MEMORY_SCOPE_AGENT);
    t0 = (unsigned)__builtin_amdgcn_readfirstlane((int)t0);
    if (t0 >= 7488u) break;
#pragma unroll 1
    for (int e = 0; e < 2; ++e) {
      int t = (int)t0 + e;
      if (t >= 7488) break;
      int j;
      if (t < 4224) { j = 1 + t / 1408; t -= (j - 1) * 1408; }
      else if (t < 6336) { t -= 4224; j = 5 + t / 704; t -= (j - 5) * 704; }
      else if (t < 7104) { t -= 6336; j = 9 + t / 256; t -= (j - 9) * 256; }
      else { t -= 7104; j = 12; }
      convert_tile(P, j, t, lane);
    }
  }
}

__device__ __forceinline__ void phase_convert(const Params& P) {
  bf16_t* W = (bf16_t*)(P.ws + OFF_W);
  float* sT = (float*)smem;
  const int tid = threadIdx.x;
  wave_convert(P, (int)(blockIdx.x * NWAVE + (threadIdx.x >> 6)), (int)(gridDim.x * NWAVE), true);
  bf16_t* xb = (bf16_t*)(P.ws + OFF_XB);
  float* ssq = (float*)(P.ws + OFF_SSQ);
  bf16_t* memb = (bf16_t*)(P.ws + OFF_MEMB);
  float* ssqm = (float*)(P.ws + OFF_SSQM);
  const int lane = tid & 63, gw = blockIdx.x * NWAVE + (tid >> 6), nw = gridDim.x * NWAVE;
  for (int row = gw; row < kT + 512; row += nw) {
    const float* src = (row < kT) ? (P.x + (size_t)row * 1024) : (P.mem + (size_t)(row - kT) * 1024);
    bf16_t* dst = (row < kT) ? (xb + (size_t)row * 1024) : (memb + (size_t)(row - kT) * 1024);
    float* sq = (row < kT) ? (ssq + (size_t)row * 16) : (ssqm + (size_t)(row - kT) * 16);
    float ss = 0.f;
#pragma unroll
    for (int i = 0; i < 4; ++i) {
      float4 v = ((const float4*)src)[lane + 64 * i];
      ss += v.x * v.x + v.y * v.y + v.z * v.z + v.w * v.w;
      uint2 o; o.x = pack2(v.x, v.y); o.y = pack2(v.z, v.w);
      ((uint2*)dst)[lane + 64 * i] = o;
    }
    ss = wave_sum(ss);
    if (lane < 16) sq[lane] = (lane == 0) ? ss : 0.f;
  }
}

constexpr int G8_BM = 256, G8_BK = 64, G8_HALF = 128, G8_HTB = G8_HALF * G8_BK * 2, G8_NXCD = 8, G8_WGM = 8;
__device__ __forceinline__ int lds_byte(int r, int c) { const int st = (r >> 4) * 2 + (c >> 5), rr = r & 15, cc = c & 31, ob = rr * 64 + cc * 2; return st * 1024 + (ob ^ (((ob >> 9) & 1) << 5)); }
__device__ __forceinline__ void stage_rc(int b, int& R, int& C) { const int st = b / 1024, sb = b % 1024, swz = sb ^ (((sb >> 9) & 1) << 5); R = (st >> 1) * 16 + swz / 64; C = (st & 1) * 32 + (swz % 64) / 2; }
__device__ __forceinline__ int perm32(int rho) { const int n = rho >> 4, i = rho & 15; return 8 * (i >> 2) + 4 * n + (i & 3); }
struct Unit { int pm, pn; };
struct StaticOrder {
  int nM, nN, nwg, G, c;
  __device__ void init(int M, int N, int G_, int c_) { nM = M / G8_BM; nN = N / G8_BM; nwg = nM * nN; G = G_; c = c_; }
  __device__ bool next(int i, Unit& u) const {
    const long L = (long)i * G + c; if (L >= nwg) return false;
    int wgid = (int)L; { const int q = nwg / G8_NXCD, r = nwg % G8_NXCD, xcd = wgid % G8_NXCD, off = wgid / G8_NXCD; wgid = (xcd < r ? xcd * (q + 1) : r * (q + 1) + (xcd - r) * q) + off; }
    const int nig = G8_WGM * nN, gid = wgid / nig, fm = gid * G8_WGM, gsz = (nM - fm) < G8_WGM ? (nM - fm) : G8_WGM;
    u.pm = fm + ((wgid % nig) % gsz); u.pn = (wgid % nig) / gsz; return true;
  }
};

__device__ __forceinline__ float rstd_row(const float* ssq, size_t row) {
  const float4* q = (const float4*)(ssq + row * 16);
  float4 a = q[0], b = q[1], c = q[2], d = q[3];
  float s = ((a.x + a.y) + (a.z + a.w)) + ((b.x + b.y) + (b.z + b.w)) + ((c.x + c.y) + (c.z + c.w)) + ((d.x + d.y) + (d.z + d.w));
  return rsqrtf(s * (1.f / 1024.f) + EPS);
}
template <class Epi>
__device__ __forceinline__ void gemm8(const bf16_t* gA, const bf16_t* gBt, int M, int N, int K, const Epi& E, int coff = 0) {
  LAS unsigned char* lds = (LAS unsigned char*)smem;
  StaticOrder S; S.init(M, N, (int)gridDim.x, (int)((blockIdx.x + coff) % gridDim.x));
  const int tid = threadIdx.x, wid = __builtin_amdgcn_readfirstlane(tid >> 6), lane = tid & 63, wr = wid >> 2, wc = wid & 3, fr = lane & 15, fq = lane >> 4;
  const int nt = K / G8_BK;
  unsigned voffA[2], voffB[2];
#pragma unroll
  for (int i = 0; i < 2; ++i) { int R, C; stage_rc(tid * 16 + i * 8192, R, C); const int Rb = Epi::PERM ? ((R & ~31) + perm32(R & 31)) : R;
    voffA[i] = (unsigned)(R * K + C) * 2u; voffB[i] = (unsigned)(Rb * K + C) * 2u; }
  const size_t kstep = (size_t)(G8_BK * 2);
  const size_t hstep = (size_t)G8_HALF * K * 2;
  const size_t tstep = 2 * hstep;
  const unsigned ldsw = (unsigned)wid * 1024u;
  const int aoff = lds_byte(wr * 64 + fr, fq * 8), boff = lds_byte(wc * 32 + fr, fq * 8);
#define PG8_SA(b, h) (((b) * 2 + (h)) * G8_HTB)
#define PG8_SB(b, h) ((4 + (b) * 2 + (h)) * G8_HTB)
#define PG8_STAGE(bufoff, gbase, voff) do { _Pragma("unroll") for (int _i = 0; _i < 2; ++_i) \
    __builtin_amdgcn_global_load_lds((const unsigned*)((const char*)(gbase) + (voff)[_i]), (LAS unsigned*)(lds + (bufoff) + ldsw + _i * 8192), 16, 0, 0); } while (0)
#define PG8_LDA(dst, b, h) do { _Pragma("unroll") for (int m = 0; m < 4; ++m) _Pragma("unroll") for (int k = 0; k < 2; ++k) dst[m][k] = *(const LAS bf16x8*)(lds + PG8_SA(b, h) + aoff + m * 2048 + k * 1024); } while (0)
#define PG8_LDB(dst, b, h) do { _Pragma("unroll") for (int n = 0; n < 2; ++n) _Pragma("unroll") for (int k = 0; k < 2; ++k) dst[n][k] = *(const LAS bf16x8*)(lds + PG8_SB(b, h) + boff + n * 2048 + k * 1024); } while (0)
#define PG8_MMA(ai, bj, At, Bt) do { __builtin_amdgcn_s_setprio(1); _Pragma("unroll") for (int m = 0; m < 4; ++m) _Pragma("unroll") for (int n = 0; n < 2; ++n) _Pragma("unroll") for (int k = 0; k < 2; ++k) \
    acc[ai][bj][m][n] = __builtin_amdgcn_mfma_f32_16x16x32_bf16(Bt[n][k], At[m][k], acc[ai][bj][m][n], 0, 0, 0); __builtin_amdgcn_s_setprio(0); } while (0)
#define PG8_WAIT_V(n) asm volatile("s_waitcnt vmcnt(" #n ")" ::: "memory")
#define PG8_WAIT_L(n) asm volatile("s_waitcnt lgkmcnt(" #n ")" ::: "memory")
#define PG8_BAR __builtin_amdgcn_s_barrier()
#define PG8_SCHED __builtin_amdgcn_sched_barrier(0)
  Unit cur, nxt; int ui = 0;
  if (E.ssq != nullptr) {
    float* sRs = (float*)(smem + 132096);
    Unit uu;
    for (int i = 0; S.next(i, uu); ++i)
      if (tid < 256) sRs[i * 256 + tid] = rstd_row(E.ssq, (size_t)uu.pm * 256 + tid);
    __syncthreads();
  }
  if (!S.next(0, cur)) return;
  f32x4 acc[2][2][4][2];
#pragma unroll
  for (int a = 0; a < 2; ++a)
#pragma unroll
    for (int b = 0; b < 2; ++b)
#pragma unroll
      for (int m = 0; m < 4; ++m)
#pragma unroll
        for (int n = 0; n < 2; ++n) acc[a][b][m][n] = (f32x4){0.f, 0.f, 0.f, 0.f};
  bf16x8 At[4][2], B0[2][2], B1[2][2];
  const char* cA = (const char*)gA + (size_t)cur.pm * tstep; const char* cB = (const char*)gBt + (size_t)cur.pn * tstep;
  PG8_STAGE(PG8_SB(0, 0), cB, voffB); PG8_STAGE(PG8_SA(0, 0), cA, voffA); PG8_STAGE(PG8_SB(0, 1), cB + hstep, voffB); PG8_STAGE(PG8_SA(0, 1), cA + hstep, voffA);
  if (wr == 1) PG8_BAR;
  PG8_WAIT_V(4); PG8_BAR;
  PG8_STAGE(PG8_SB(1, 0), cB + kstep, voffB); PG8_STAGE(PG8_SA(1, 0), cA + kstep, voffA); PG8_STAGE(PG8_SB(1, 1), cB + hstep + kstep, voffB);
  PG8_WAIT_V(6); PG8_BAR;
  for (;;) {
    const bool has_next = S.next(ui + 1, nxt);
    const char* nA = has_next ? (const char*)gA + (size_t)nxt.pm * tstep : cA; const char* nB = has_next ? (const char*)gBt + (size_t)nxt.pn * tstep : cB;
    for (int t = 0; t < nt; t += 2) {
      const bool last = (t == nt - 2);
      const char* a1 = cA + (size_t)(t + 1) * kstep;
      const char* a2 = last ? nA : cA + (size_t)(t + 2) * kstep; const char* b2 = last ? nB : cB + (size_t)(t + 2) * kstep;
      const char* a3 = a2 + kstep; const char* b3 = b2 + kstep;
      PG8_LDB(B0, 0, 0); PG8_SCHED; PG8_LDA(At, 0, 0); PG8_STAGE(PG8_SA(1, 1), a1 + hstep, voffA);
      PG8_WAIT_L(8); PG8_BAR; PG8_WAIT_L(0); PG8_MMA(0, 0, At, B0); PG8_BAR; PG8_SCHED;
      PG8_LDB(B1, 0, 1); PG8_STAGE(PG8_SB(0, 0), b2, voffB);
      PG8_BAR; PG8_WAIT_L(0); PG8_MMA(0, 1, At, B1); PG8_BAR;
      PG8_LDA(At, 0, 1); PG8_STAGE(PG8_SA(0, 0), a2, voffA);
      PG8_BAR; PG8_WAIT_L(0); PG8_MMA(1, 0, At, B0); PG8_BAR; PG8_SCHED;
      PG8_STAGE(PG8_SB(0, 1), b2 + hstep, voffB);
      PG8_WAIT_V(6); PG8_BAR; PG8_MMA(1, 1, At, B1); PG8_BAR;
      PG8_LDB(B0, 1, 0); PG8_SCHED; PG8_LDA(At, 1, 0); PG8_STAGE(PG8_SA(0, 1), a2 + hstep, voffA);
      PG8_WAIT_L(8); PG8_BAR; PG8_WAIT_L(0); PG8_MMA(0, 0, At, B0); PG8_BAR; PG8_SCHED;
      PG8_LDB(B1, 1, 1); PG8_STAGE(PG8_SB(1, 0), b3, voffB);
      PG8_BAR; PG8_WAIT_L(0); PG8_MMA(0, 1, At, B1); PG8_BAR;
      PG8_LDA(At, 1, 1); PG8_STAGE(PG8_SA(1, 0), a3, voffA);
      PG8_BAR; PG8_WAIT_L(0); PG8_MMA(1, 0, At, B0); PG8_BAR; PG8_SCHED;
      PG8_STAGE(PG8_SB(1, 1), b3 + hstep, voffB);
      PG8_WAIT_V(6); PG8_BAR; PG8_MMA(1, 1, At, B1); PG8_BAR;
    }
    E(acc, cur, ui, wr, wc, fr, fq);
    if (!has_next) break;
#pragma unroll
    for (int a = 0; a < 2; ++a)
#pragma unroll
      for (int b = 0; b < 2; ++b)
#pragma unroll
        for (int m = 0; m < 4; ++m)
#pragma unroll
          for (int n = 0; n < 2; ++n) acc[a][b][m][n] = (f32x4){0.f, 0.f, 0.f, 0.f};
    cur = nxt; cA = nA; cB = nB; ++ui;
  }
  PG8_WAIT_V(0);
  if (wr == 0) PG8_BAR;
  PG8_BAR;
#undef PG8_SA
#undef PG8_SB
#undef PG8_STAGE
#undef PG8_LDA
#undef PG8_LDB
#undef PG8_MMA
#undef PG8_WAIT_V
#undef PG8_WAIT_L
#undef PG8_BAR
#undef PG8_SCHED
}

typedef f32x4 Acc8[2][2][4][2];
__device__ __forceinline__ float sumq4(float v) {
  v += __shfl_xor(v, 16); v += __shfl_xor(v, 32);
  return v;
}
__device__ __forceinline__ void rstd8(int ui, int wr, int fr, float (&rs)[2][4]) {
  const float* sRs = (const float*)(smem + 132096) + ui * 256 + wr * 64 + fr;
#pragma unroll
  for (int ai = 0; ai < 2; ++ai)
#pragma unroll
    for (int m = 0; m < 4; ++m) rs[ai][m] = sRs[ai * 128 + m * 16];
}
__device__ __forceinline__ uint4 pack8(f32x4 a, f32x4 b) {
  uint4 o; o.x = pack2(a[0], a[1]); o.y = pack2(a[2], a[3]); o.z = pack2(b[0], b[1]); o.w = pack2(b[2], b[3]); return o;
}
__device__ __forceinline__ void epi8_swiglu(const Acc8& acc, const Unit& u, int ui, int wr, int wc, int fr, int fq, const float* ssq, bf16_t* H) {
  float rs8[2][4];
  rstd8(ui, wr, fr, rs8);
#pragma unroll
  for (int ai = 0; ai < 2; ++ai)
#pragma unroll
    for (int m = 0; m < 4; ++m) {
      const size_t row = (size_t)u.pm * 256 + ai * 128 + wr * 64 + m * 16 + fr;
      const float rs = rs8[ai][m];
      f32x4 h0, h1;
#pragma unroll
      for (int jj = 0; jj < 4; ++jj) {
        float g0 = acc[ai][0][m][0][jj] * rs, u0 = acc[ai][1][m][0][jj] * rs, g1 = acc[ai][0][m][1][jj] * rs, u1 = acc[ai][1][m][1][jj] * rs;
        h0[jj] = g0 * __builtin_amdgcn_rcpf(1.f + __expf(-g0)) * u0;
        h1[jj] = g1 * __builtin_amdgcn_rcpf(1.f + __expf(-g1)) * u1;
      }
      *(uint4*)(H + row * 2816 + u.pn * 128 + wc * 32 + fq * 8) = pack8(h0, h1);
    }
}
__device__ __forceinline__ void epi8_plain(const Acc8& acc, const Unit& u, int ui, int wr, int wc, int fr, int fq, const float* ssq, bf16_t* dst, int ld, int col0) {
  float rs8[2][4];
  rstd8(ui, wr, fr, rs8);
#pragma unroll
  for (int ai = 0; ai < 2; ++ai)
#pragma unroll
    for (int m = 0; m < 4; ++m) {
      const size_t row = (size_t)u.pm * 256 + ai * 128 + wr * 64 + m * 16 + fr;
      const float rs = rs8[ai][m];
#pragma unroll
      for (int bj = 0; bj < 2; ++bj)
        *(uint4*)(dst + row * ld + col0 + bj * 128 + wc * 32 + fq * 8) = pack8(acc[ai][bj][m][0] * rs, acc[ai][bj][m][1] * rs);
    }
}
__device__ __forceinline__ void epi8_headnorm(const Acc8& acc, const Unit& u, int ui, int wr, int wc, int fr, int fq, const float* ssq, const float* gain,
                                              float scale, bf16_t* dst, int ld, int colbase) {
  f32x4 gn[2][2];
#pragma unroll
  for (int bj = 0; bj < 2; ++bj)
#pragma unroll
    for (int n = 0; n < 2; ++n) gn[bj][n] = *(const f32x4*)(gain + bj * 32 + fq * 8 + n * 4) * scale;
  VMWAIT();
  float rs8[2][4];
  rstd8(ui, wr, fr, rs8);
#pragma unroll
  for (int ai = 0; ai < 2; ++ai)
#pragma unroll
    for (int m = 0; m < 4; ++m) {
      const size_t row = (size_t)u.pm * 256 + ai * 128 + wr * 64 + m * 16 + fr;
      const float rs = rs8[ai][m];
      float ss = 0.f;
#pragma unroll
      for (int bj = 0; bj < 2; ++bj)
#pragma unroll
        for (int n = 0; n < 2; ++n) {
          const f32x4 a = acc[ai][bj][m][n];
          ss += a[0] * a[0] + a[1] * a[1] + a[2] * a[2] + a[3] * a[3];
        }
      ss = sumq4(ss) * rs * rs;
      const float r2 = rsqrtf(ss * (1.f / 64.f) + EPS) * rs;
#pragma unroll
      for (int bj = 0; bj < 2; ++bj)
        *(uint4*)(dst + row * ld + colbase + wc * 64 + bj * 32 + fq * 8) = pack8(acc[ai][bj][m][0] * r2 * gn[bj][0], acc[ai][bj][m][1] * r2 * gn[bj][1]);
    }
}

struct Epi8Swiglu {
  static constexpr bool PERM = true;
  const float* ssq; bf16_t* H;
  __device__ __forceinline__ void operator()(const Acc8& acc, const Unit& u, int ui, int wr, int wc, int fr, int fq) const { epi8_swiglu(acc, u, ui, wr, wc, fr, fq, ssq, H); }
};
struct Epi8Resid {
  static constexpr bool PERM = false;
  static constexpr const float* ssq = nullptr;
  const float* xin; float* xout; bf16_t* xb; float* ssqo; float scale;
  __device__ __forceinline__ void operator()(const Acc8& acc, const Unit& u, int ui, int wr, int wc, int fr, int fq) const {
#pragma unroll
    for (int ai = 0; ai < 2; ++ai)
#pragma unroll
      for (int mh = 0; mh < 2; ++mh) {
        f32x4 xv[2][2][2];
#pragma unroll
        for (int m2 = 0; m2 < 2; ++m2)
#pragma unroll
          for (int bj = 0; bj < 2; ++bj)
#pragma unroll
            for (int n = 0; n < 2; ++n)
              xv[m2][bj][n] = *(const f32x4*)(xin + ((size_t)u.pm * 256 + ai * 128 + wr * 64 + (mh * 2 + m2) * 16 + fr) * 1024 + u.pn * 256 + bj * 128 + wc * 32 + n * 16 + fq * 4);
        VMWAIT();
#pragma unroll
        for (int m2 = 0; m2 < 2; ++m2) {
          const int m = mh * 2 + m2;
          const size_t row = (size_t)u.pm * 256 + ai * 128 + wr * 64 + m * 16 + fr;
          float ss = 0.f;
#pragma unroll
          for (int bj = 0; bj < 2; ++bj)
#pragma unroll
            for (int n = 0; n < 2; ++n) {
              const size_t idx = row * 1024 + u.pn * 256 + bj * 128 + wc * 32 + n * 16 + fq * 4;
              f32x4 v = xv[m2][bj][n] + acc[ai][bj][m][n] * scale;
              *(f32x4*)(xout + idx) = v;
              if (xb != nullptr) { uint2 o; o.x = pack2(v[0], v[1]); o.y = pack2(v[2], v[3]); *(uint2*)(xb + idx) = o; }
              ss += v[0] * v[0] + v[1] * v[1] + v[2] * v[2] + v[3] * v[3];
            }
          ss = sumq4(ss);
          if (fq == 0 && xb != nullptr) ssqo[row * 16 + u.pn * 4 + wc] = ss;
        }
      }
  }
};
struct Epi8InProj {
  static constexpr bool PERM = true;
  const float* ssq; bf16_t* Pbase; bf16_t* Cat; float* G; const float* mq_gain; const float* gate_bias;
  __device__ __forceinline__ void operator()(const Acc8& acc, const Unit& u, int ui, int wr, int wc, int fr, int fq) const {
    if (u.pn < 12) {
      const int arr = u.pn / 3, c0 = (u.pn - arr * 3) * 256;
      epi8_plain(acc, u, ui, wr, wc, fr, fq, ssq, Pbase + (size_t)arr * kT * 768, 768, c0);
    } else if (u.pn == 12) {
      epi8_headnorm(acc, u, ui, wr, wc, fr, fq, ssq, mq_gain, 0.125f, Cat, 1024, 768);
    } else if (wc == 0) {
      float rs8[2][4];
      rstd8(ui, wr, fr, rs8);
      if (fq == 0) {
#pragma unroll
        for (int ai = 0; ai < 2; ++ai)
#pragma unroll
          for (int m = 0; m < 4; ++m) {
            const size_t row = (size_t)u.pm * 256 + ai * 128 + wr * 64 + m * 16 + fr;
            *(f32x4*)(G + row * 8) = acc[ai][0][m][0] * rs8[ai][m];
            *(f32x4*)(G + row * 8 + 4) = acc[ai][0][m][1] * rs8[ai][m];
          }
      }
    }
  }
};
struct Epi8KvFfn {
  static constexpr bool PERM = true;
  const float* ssq; bf16_t* H; bf16_t* Ksh; bf16_t* Vtmp; const float* kgain;
  __device__ __forceinline__ void operator()(const Acc8& acc, const Unit& u, int ui, int wr, int wc, int fr, int fq) const {
    if (u.pn < 22) epi8_swiglu(acc, u, ui, wr, wc, fr, fq, ssq, H);
    else if (u.pn < 25) epi8_headnorm(acc, u, ui, wr, wc, fr, fq, ssq, kgain, 1.f, Ksh, 768, (u.pn - 22) * 256);
    else epi8_plain(acc, u, ui, wr, wc, fr, fq, ssq, Vtmp, 768, (u.pn - 25) * 256);
  }
};
struct Epi8QProj {
  static constexpr bool PERM = true;
  const float* ssq; bf16_t* Cat; const float* qgain; const float* mqgain;
  __device__ __forceinline__ void operator()(const Acc8& acc, const Unit& u, int ui, int wr, int wc, int fr, int fq) const {
    epi8_headnorm(acc, u, ui, wr, wc, fr, fq, ssq, (u.pn < 3) ? qgain : mqgain, 0.125f, Cat, 1024, u.pn * 256);
  }
};
struct Epi8MemKv {
  static constexpr bool PERM = true;
  const float* ssq; bf16_t* Kmem; bf16_t* Vtok; const float* kgain;
  __device__ __forceinline__ void operator()(const Acc8& acc, const Unit& u, int ui, int wr, int wc, int fr, int fq) const {
    if (u.pn == 0) epi8_headnorm(acc, u, ui, wr, wc, fr, fq, ssq, kgain, 1.f, Kmem, 256, 0);
    else epi8_plain(acc, u, ui, wr, wc, fr, fq, ssq, Vtok, 256, 0);
  }
};
__device__ __forceinline__ void memv_transpose(const bf16_t* Vtok, bf16_t* VmT) {
  for (int i = blockIdx.x * NTHR + threadIdx.x; i < 2 * 512 * 256; i += gridDim.x * NTHR) {
    const int mm = i & 255, e = (i >> 8) & 255, lb = i >> 16;
    VmT[i] = Vtok[((size_t)lb * 256 + mm) * 256 + e];
  }
}

__device__ __forceinline__ void phase_vtranspose(const bf16_t* Vtmp, bf16_t* VshT) {
  bf16_t* sT = (bf16_t*)smem;
  const int tid = threadIdx.x;
  for (int item = blockIdx.x; item < 256 * 12; item += gridDim.x) {
    const int head = item % 12, tt = item / 12, tokbase = tt * 128, b = tokbase / kS, pos0 = tokbase - b * kS;
    const int g = head >> 2, d = 1 << (2 * g);
    __syncthreads();
    for (int it = tid; it < 128 * 8; it += NTHR) {
      const int t = it >> 3, e8 = (it & 7) * 8;
      uint4 v = *(const uint4*)(Vtmp + (size_t)(tokbase + t) * 768 + head * 64 + e8);
      sT[(e8 + 0) * 136 + t] = (bf16_t)(v.x & 0xffff); sT[(e8 + 1) * 136 + t] = (bf16_t)(v.x >> 16);
      sT[(e8 + 2) * 136 + t] = (bf16_t)(v.y & 0xffff); sT[(e8 + 3) * 136 + t] = (bf16_t)(v.y >> 16);
      sT[(e8 + 4) * 136 + t] = (bf16_t)(v.z & 0xffff); sT[(e8 + 5) * 136 + t] = (bf16_t)(v.z >> 16);
      sT[(e8 + 6) * 136 + t] = (bf16_t)(v.w & 0xffff); sT[(e8 + 7) * 136 + t] = (bf16_t)(v.w >> 16);
    }
    __syncthreads();
    for (int pc = tid; pc < 64 * 16; pc += NTHR) {
      const int e = pc >> 4, piece = pc & 15;
      const int rr = (g == 0) ? 0 : (g == 1) ? (piece >> 2) : piece;
      const int s8 = (g == 0) ? piece : (g == 1) ? (piece & 3) : 0;
      const bf16_t* src = sT + e * 136 + rr;
      uint4 o;
      o.x = (uint32_t)src[(s8 * 8 + 0) * d] | ((uint32_t)src[(s8 * 8 + 1) * d] << 16);
      o.y = (uint32_t)src[(s8 * 8 + 2) * d] | ((uint32_t)src[(s8 * 8 + 3) * d] << 16);
      o.z = (uint32_t)src[(s8 * 8 + 4) * d] | ((uint32_t)src[(s8 * 8 + 5) * d] << 16);
      o.w = (uint32_t)src[(s8 * 8 + 6) * d] | ((uint32_t)src[(s8 * 8 + 7) * d] << 16);
      *(uint4*)(VshT + ((size_t)(b * 12 + head) * 64 + e) * kS + rr * (kS / d) + pos0 / d + s8 * 8) = o;
    }
  }
}

__device__ __forceinline__ bf16x8 u4_to_frag(uint4 v) { return __builtin_bit_cast(bf16x8, v); }
__device__ __forceinline__ uint4 mul_bf16x8(uint4 a, uint4 b) {
  uint4 o;
  o.x = pack2(bflo(a.x) * bflo(b.x), bfhi(a.x) * bfhi(b.x));
  o.y = pack2(bflo(a.y) * bflo(b.y), bfhi(a.y) * bfhi(b.y));
  o.z = pack2(bflo(a.z) * bflo(b.z), bfhi(a.z) * bfhi(b.z));
  o.w = pack2(bflo(a.w) * bflo(b.w), bfhi(a.w) * bfhi(b.w));
  return o;
}

__device__ __forceinline__ void phase_prep(const Params& P) {
  const bf16_t* Pk = (const bf16_t*)(P.ws + OFF_R1) + (size_t)kT * 768;
  const bf16_t* Pv = Pk + (size_t)kT * 768;
  bf16_t* kc = (bf16_t*)(P.ws + OFF_XB);
  bf16_t* kTt = (bf16_t*)(P.ws + OFF_R2);
  bf16_t* VT = kTt + (size_t)kT * 768;
  const float* G = (const float*)(P.ws + OFF_G);
  float* uArr = (float*)(P.ws + OFF_U);
  float* bArr = (float*)(P.ws + OFF_BC);
  bf16_t* eW = (bf16_t*)(P.ws + OFF_EW);
  float* umaxA = (float*)(P.ws + OFF_UMAX);
  float* blA = (float*)(P.ws + OFF_BL);
  bf16_t* sX = (bf16_t*)smem;
  float* sF = (float*)(smem + 51200);
  const int tid = threadIdx.x;
  const float kscale = 0.07216878364870322f;
  for (int item = blockIdx.x; item < 1024; item += gridDim.x) {
    const int bh = item >> 7, c = item & 127, b = bh >> 2, h = bh & 3;
    const size_t tok0 = (size_t)b * kS + (size_t)c * 128;
    __syncthreads();
    float ig = 0.f;
    if (tid < 128) {
      ig = G[(tok0 + tid) * 8 + h] + P.a_gate_bias[h];
      float fg = G[(tok0 + tid) * 8 + 4 + h] + P.a_gate_bias[4 + h];
      sF[tid] = fminf(fg, 0.f) - log1pf(__expf(-fabsf(fg)));
    }
    __syncthreads();
    float bt = 0.f;
    if (tid < 128) for (int s2 = 0; s2 <= tid; ++s2) bt += sF[s2];
    const float ut = ig - bt;
    __syncthreads();
    if (tid < 128) sF[tid] = ut;
    __syncthreads();
    float um = -3.0e38f;
    for (int s2 = 0; s2 < 128; ++s2) um = fmaxf(um, sF[s2]);
    if (tid < 128) {
      uArr[(size_t)item * 128 + tid] = ut;
      bArr[(size_t)item * 128 + tid] = bt;
      eW[(size_t)item * 128 + tid] = f2bf(__expf(ut - um));
      if (tid == 127) blA[item] = bt;
      if (tid == 0) umaxA[item] = um;
    }
    for (int it = tid; it < 128 * 24; it += NTHR) {
      const int t = it / 24, ch = (it - t * 24) * 8;
      const int spos = c * 128 + t;
      const bf16_t* src = Pk + (tok0 + t) * 768 + h * 192 + ch;
      uint4 xv[4];
      float4 w0[4], w1[4];
#pragma unroll
      for (int j = 0; j < 4; ++j) {
        xv[j] = make_uint4(0u, 0u, 0u, 0u);
        if (spos - 3 + j >= 0) xv[j] = *(const uint4*)(src - (ptrdiff_t)(3 - j) * 768);
        const float4* wp = (const float4*)(P.a_conv + j * 1536 + 768 + h * 192 + ch);
        w0[j] = wp[0]; w1[j] = wp[1];
      }
      VMWAIT();
      float a[8] = {0.f, 0.f, 0.f, 0.f, 0.f, 0.f, 0.f, 0.f};
#pragma unroll
      for (int j = 0; j < 4; ++j) {
        a[0] += w0[j].x * bflo(xv[j].x); a[1] += w0[j].y * bfhi(xv[j].x); a[2] += w0[j].z * bflo(xv[j].y); a[3] += w0[j].w * bfhi(xv[j].y);
        a[4] += w1[j].x * bflo(xv[j].z); a[5] += w1[j].y * bfhi(xv[j].z); a[6] += w1[j].z * bflo(xv[j].w); a[7] += w1[j].w * bfhi(xv[j].w);
      }
#pragma unroll
      for (int e = 0; e < 8; ++e) a[e] = a[e] / (1.f + __expf(-a[e])) * kscale;
      uint4 o; o.x = pack2(a[0], a[1]); o.y = pack2(a[2], a[3]); o.z = pack2(a[4], a[5]); o.w = pack2(a[6], a[7]);
      *(uint4*)(kc + (tok0 + t) * 768 + h * 192 + ch) = o;
      *(uint4*)(sX + t * 200 + ch) = o;
    }
    __syncthreads();
    for (int it = tid; it < 192 * 16; it += NTHR) {
      const int k = it >> 4, lg = it & 15;
      uint4 o;
      o.x = (uint32_t)sX[(lg * 8 + 0) * 200 + k] | ((uint32_t)sX[(lg * 8 + 1) * 200 + k] << 16);
      o.y = (uint32_t)sX[(lg * 8 + 2) * 200 + k] | ((uint32_t)sX[(lg * 8 + 3) * 200 + k] << 16);
      o.z = (uint32_t)sX[(lg * 8 + 4) * 200 + k] | ((uint32_t)sX[(lg * 8 + 5) * 200 + k] << 16);
      o.w = (uint32_t)sX[(lg * 8 + 6) * 200 + k] | ((uint32_t)sX[(lg * 8 + 7) * 200 + k] << 16);
      *(uint4*)(kTt + ((size_t)item * 192 + k) * 128 + lg * 8) = o;
    }
    __syncthreads();
    for (int it = tid; it < 128 * 24; it += NTHR) {
      const int t = it / 24, ch = (it - t * 24) * 8;
      uint4 v = *(const uint4*)(Pv + (tok0 + t) * 768 + h * 192 + ch);
      *(uint4*)(sX + t * 200 + ch) = v;
    }
    __syncthreads();
    for (int it = tid; it < 192 * 16; it += NTHR) {
      const int k = it >> 4, lg = it & 15;
      uint4 o;
      o.x = (uint32_t)sX[(lg * 8 + 0) * 200 + k] | ((uint32_t)sX[(lg * 8 + 1) * 200 + k] << 16);
      o.y = (uint32_t)sX[(lg * 8 + 2) * 200 + k] | ((uint32_t)sX[(lg * 8 + 3) * 200 + k] << 16);
      o.z = (uint32_t)sX[(lg * 8 + 4) * 200 + k] | ((uint32_t)sX[(lg * 8 + 5) * 200 + k] << 16);
      o.w = (uint32_t)sX[(lg * 8 + 6) * 200 + k] | ((uint32_t)sX[(lg * 8 + 7) * 200 + k] << 16);
      *(uint4*)(VT + ((size_t)item * 192 + k) * 128 + lg * 8) = o;
    }
  }
}

__device__ __forceinline__ void phase_scan(const Params& P) {
  const bf16_t* kTt = (const bf16_t*)(P.ws + OFF_R2);
  const bf16_t* VT = kTt + (size_t)kT * 768;
  const bf16_t* eW = (const bf16_t*)(P.ws + OFF_EW);
  const float* umaxA = (const float*)(P.ws + OFF_UMAX);
  const float* blA = (const float*)(P.ws + OFF_BL);
  float* m0A = (float*)(P.ws + OFF_M0);
  bf16_t* C0T = (bf16_t*)(P.ws + OFF_R1) + (size_t)kT * 768;
  const int lane = threadIdx.x & 63, wid = threadIdx.x >> 6, nw = gridDim.x * NWAVE;
  const int r = lane & 15, q = lane >> 4;
  for (int unit = wid * gridDim.x + blockIdx.x; unit < 416; unit += nw) {
    const int bh = unit / 52, rem = unit - bh * 52, mv = rem >> 2, nk = rem & 3;
    const bf16_t* vt_base = VT + ((size_t)bh * 128 * 192 + (mv < 12 ? mv : 0) * 16 + r) * 128 + q * 8;
    const bf16_t* kt_base = kTt + ((size_t)bh * 128 * 192 + nk * 48 + r) * 128 + q * 8;
    const bf16_t* ew_base = eW + (size_t)bh * 128 * 128 + q * 8;
    bf16_t* c0_base = C0T + ((size_t)bh * 128 * 208 + mv * 16 + q * 4) * 192 + nk * 48 + r;
    f32x4 acc[3];
#pragma unroll
    for (int n = 0; n < 3; ++n) acc[n] = (f32x4){0.f, 0.f, 0.f, 0.f};
    float m = 0.f;
    uint4 A[4], B[3][4], E[4];
    float bl, um;
#define SCAN_LOAD(A_, B_, E_, bl_, um_, cc)                                                            \
  do {                                                                                                 \
    _Pragma("unroll") for (int ks = 0; ks < 4; ++ks) {                                                 \
      A_[ks] = *(const uint4*)(vt_base + (size_t)(cc) * 192 * 128 + ks * 32);                          \
      E_[ks] = *(const uint4*)(ew_base + (size_t)(cc) * 128 + ks * 32);                                \
      _Pragma("unroll") for (int n = 0; n < 3; ++n)                                                    \
        B_[n][ks] = *(const uint4*)(kt_base + (size_t)(cc) * 192 * 128 + (size_t)n * 16 * 128 + ks * 32); \
    }                                                                                                  \
    bl_ = blA[bh * 128 + (cc)]; um_ = umaxA[bh * 128 + (cc)];                                          \
  } while (0)
    SCAN_LOAD(A, B, E, bl, um, 0);
    VMWAIT();
    for (int c = 0; c < 128; ++c) {
#pragma unroll
      for (int n = 0; n < 3; ++n)
#pragma unroll
        for (int j = 0; j < 4; ++j) c0_base[(size_t)c * 208 * 192 + j * 192 + n * 16] = f2bf(acc[n][j]);
      if (rem == 0 && lane == 0) m0A[bh * 128 + c] = m;
      uint4 nA[4], nB[3][4], nE[4];
      float nbl = 0.f, num = 0.f;
      const int cn = (c + 1 < 128) ? c + 1 : c;
      SCAN_LOAD(nA, nB, nE, nbl, num, cn);
      const float mn = fmaxf(bl + m, bl + um);
      const float decay = __expf(bl + m - mn), sc = __expf(um + bl - mn);
      m = mn;
      f32x4 U[3];
#pragma unroll
      for (int n = 0; n < 3; ++n) U[n] = (f32x4){0.f, 0.f, 0.f, 0.f};
#pragma unroll
      for (int ks = 0; ks < 4; ++ks) {
        uint4 af;
        if (mv < 12) af = mul_bf16x8(A[ks], E[ks]);
        else af = (r == 0) ? E[ks] : make_uint4(0u, 0u, 0u, 0u);
#pragma unroll
        for (int n = 0; n < 3; ++n)
          U[n] = __builtin_amdgcn_mfma_f32_16x16x32_bf16(u4_to_frag(af), u4_to_frag(B[n][ks]), U[n], 0, 0, 0);
      }
#pragma unroll
      for (int n = 0; n < 3; ++n)
#pragma unroll
        for (int j = 0; j < 4; ++j) acc[n][j] = acc[n][j] * decay + sc * U[n][j];
      VMWAIT();
#pragma unroll
      for (int ks = 0; ks < 4; ++ks) {
        A[ks] = nA[ks]; E[ks] = nE[ks];
#pragma unroll
        for (int n = 0; n < 3; ++n) B[n][ks] = nB[n][ks];
      }
      bl = nbl; um = num;
    }
#undef SCAN_LOAD
  }
}

__device__ __forceinline__ void phase_chunk(const Params& P) {
  const bf16_t* Pq = (const bf16_t*)(P.ws + OFF_R1);
  const bf16_t* Po = Pq + (size_t)3 * kT * 768;
  const bf16_t* C0T = Pq + (size_t)kT * 768;
  const bf16_t* kc = (const bf16_t*)(P.ws + OFF_XB);
  const bf16_t* VT = (const bf16_t*)(P.ws + OFF_R2) + (size_t)kT * 768;
  const float* uArr = (const float*)(P.ws + OFF_U);
  const float* bArr = (const float*)(P.ws + OFF_BC);
  const float* m0A = (const float*)(P.ws + OFF_M0);
  bf16_t* Cat = (bf16_t*)(P.ws + OFF_CAT);
  bf16_t* sQ = (bf16_t*)smem;
  float* sU = (float*)(smem + 51200);
  float* sMx = (float*)(smem + 51712);
  float* sBt = (float*)(smem + 52224);
  float* sCw = (float*)(smem + 52736);
  const int tid = threadIdx.x, lane = tid & 63, wid = tid >> 6, r = lane & 15, q = lane >> 4;
  bf16_t* sWw = (bf16_t*)(smem + 55808) + wid * (16 * 136);
  for (int item = blockIdx.x; item < 1024; item += gridDim.x) {
    const int bh = item >> 7, c = item & 127, b = bh >> 2, h = bh & 3;
    const size_t tok0 = (size_t)b * kS + (size_t)c * 128;
    __syncthreads();
    for (int i = tid; i < 768; i += NTHR) { int j = i / 192, ch = i - j * 192; sCw[i] = P.a_conv[j * 1536 + h * 192 + ch]; }
    if (tid < 128) { sU[tid] = uArr[(size_t)item * 128 + tid]; sBt[tid] = bArr[(size_t)item * 128 + tid]; }
    const float m0 = m0A[item];
    __syncthreads();
    if (tid < 128) {
      float mx = m0;
      for (int s2 = 0; s2 <= tid; ++s2) mx = fmaxf(mx, sU[s2]);
      sMx[tid] = mx;
    }
    for (int it = tid; it < 128 * 24; it += NTHR) {
      const int t = it / 24, ch = (it - t * 24) * 8;
      const int spos = c * 128 + t;
      const bf16_t* src = Pq + (tok0 + t) * 768 + h * 192 + ch;
      float a[8] = {0.f, 0.f, 0.f, 0.f, 0.f, 0.f, 0.f, 0.f};
#pragma unroll
      for (int j = 0; j < 4; ++j) {
        uint4 xv = make_uint4(0u, 0u, 0u, 0u);
        if (spos - 3 + j >= 0) xv = *(const uint4*)(src - (ptrdiff_t)(3 - j) * 768);
        const float* w = sCw + j * 192 + ch;
        a[0] += w[0] * bflo(xv.x); a[1] += w[1] * bfhi(xv.x); a[2] += w[2] * bflo(xv.y); a[3] += w[3] * bfhi(xv.y);
        a[4] += w[4] * bflo(xv.z); a[5] += w[5] * bfhi(xv.z); a[6] += w[6] * bflo(xv.w); a[7] += w[7] * bfhi(xv.w);
      }
#pragma unroll
      for (int e = 0; e < 8; ++e) a[e] = a[e] / (1.f + __expf(-a[e]));
      uint4 o; o.x = pack2(a[0], a[1]); o.y = pack2(a[2], a[3]); o.z = pack2(a[4], a[5]); o.w = pack2(a[6], a[7]);
      *(uint4*)(sQ + t * 200 + ch) = o;
    }
    __syncthreads();
    {
      const int t0 = wid * 16, nmax = t0 >> 4, ks2max = (t0 + 15) >> 5;
      {
        bf16x8 Qf[6];
#pragma unroll
        for (int ks = 0; ks < 6; ++ks) Qf[ks] = *(const bf16x8*)(sQ + (t0 + r) * 200 + ks * 32 + q * 8);
        float mxr[4];
#pragma unroll
        for (int j = 0; j < 4; ++j) mxr[j] = sMx[t0 + q * 4 + j];
#pragma unroll
        for (int n = 0; n < 8; ++n) {
          f32x4 sa = (f32x4){0.f, 0.f, 0.f, 0.f};
          if (n <= nmax) {
            uint4 Kf[6];
#pragma unroll
            for (int ks = 0; ks < 6; ++ks) Kf[ks] = *(const uint4*)(kc + (tok0 + n * 16 + r) * 768 + h * 192 + ks * 32 + q * 8);
#pragma unroll
            for (int ks = 0; ks < 6; ++ks) sa = __builtin_amdgcn_mfma_f32_16x16x32_bf16(Qf[ks], u4_to_frag(Kf[ks]), sa, 0, 0, 0);
          }
          const int scol = n * 16 + r;
          const float us = sU[scol];
#pragma unroll
          for (int j = 0; j < 4; ++j) {
            const int trow = t0 + q * 4 + j;
            float w = (n <= nmax && scol <= trow) ? __expf(us - mxr[j]) * sa[j] : 0.f;
            sWw[(q * 4 + j) * 136 + scol] = f2bf(w);
          }
        }
      }
      f32x4 acc[13];
#pragma unroll
      for (int nv = 0; nv < 13; ++nv) acc[nv] = (f32x4){0.f, 0.f, 0.f, 0.f};
#pragma unroll 1
      for (int ks = 0; ks < 6; ++ks) {
        const bf16x8 qf = *(const bf16x8*)(sQ + (t0 + r) * 200 + ks * 32 + q * 8);
        uint4 Bf[13];
#pragma unroll
        for (int nv = 0; nv < 13; ++nv) Bf[nv] = *(const uint4*)(C0T + ((size_t)item * 208 + nv * 16 + r) * 192 + ks * 32 + q * 8);
#pragma unroll
        for (int nv = 0; nv < 13; ++nv) acc[nv] = __builtin_amdgcn_mfma_f32_16x16x32_bf16(qf, u4_to_frag(Bf[nv]), acc[nv], 0, 0, 0);
      }
#pragma unroll
      for (int j = 0; j < 4; ++j) {
        const float inter = __expf(m0 - sMx[t0 + q * 4 + j]);
#pragma unroll
        for (int nv = 0; nv < 13; ++nv) acc[nv][j] *= inter;
      }
#pragma unroll 1
      for (int ks2 = 0; ks2 <= ks2max; ++ks2) {
        const bf16x8 wf = *(const bf16x8*)(sWw + r * 136 + ks2 * 32 + q * 8);
        uint4 Bf[12];
#pragma unroll
        for (int nv = 0; nv < 12; ++nv) Bf[nv] = *(const uint4*)(VT + ((size_t)item * 192 + nv * 16 + r) * 128 + ks2 * 32 + q * 8);
#pragma unroll
        for (int nv = 0; nv < 12; ++nv) acc[nv] = __builtin_amdgcn_mfma_f32_16x16x32_bf16(wf, u4_to_frag(Bf[nv]), acc[nv], 0, 0, 0);
        const uint32_t one2 = (r == 0) ? 0x3F803F80u : 0u;
        acc[12] = __builtin_amdgcn_mfma_f32_16x16x32_bf16(wf, u4_to_frag(make_uint4(one2, one2, one2, one2)), acc[12], 0, 0, 0);
      }
      float hg[12];
#pragma unroll
      for (int nv = 0; nv < 12; ++nv) hg[nv] = P.a_h_norm[h * 192 + nv * 16 + r];
#pragma unroll 1
      for (int j = 0; j < 4; ++j) {
        const int trow = t0 + q * 4 + j;
        const size_t tok = tok0 + trow;
        float og[12];
#pragma unroll
        for (int nv = 0; nv < 12; ++nv) og[nv] = bf2f(Po[tok * 768 + h * 192 + nv * 16 + r]);
        float accj[13];
#pragma unroll
        for (int nv = 0; nv < 13; ++nv) accj[nv] = (j == 0) ? acc[nv][0] : (j == 1) ? acc[nv][1] : (j == 2) ? acc[nv][2] : acc[nv][3];
        const float den = __shfl(accj[12], lane & 48);
        const float mt = sBt[trow] + sMx[trow];
        const float inv = 1.f / fmaxf(fabsf(den), __expf(-mt));
        float ss = 0.f;
#pragma unroll
        for (int nv = 0; nv < 12; ++nv) { accj[nv] *= inv; ss += accj[nv] * accj[nv]; }
        ss = sum16(ss);
        const float rstd = rsqrtf(ss * (1.f / 192.f) + EPS);
        VMWAIT();
#pragma unroll
        for (int nv = 0; nv < 12; ++nv)
          Cat[tok * 1024 + h * 192 + nv * 16 + r] = f2bf(accj[nv] * rstd * hg[nv] * sigmoidf_(og[nv]));
      }
    }
  }
}

__device__ __forceinline__ float t5_bias(const float* rel_bias, int dist, int head) {
  int bucket;
  if (dist < 16) bucket = dist;
  else {
    int large = 16 + (int)(logf((float)dist / 16.f) / 4.852030263919617f * 16.f);
    bucket = large < 31 ? large : 31;
  }
  return rel_bias[bucket * 12 + head];
}

__device__ __forceinline__ void memattn_mfma(const Params& P, int layer, int gw, int nw) {
  bf16_t* Cat = (bf16_t*)(P.ws + OFF_CAT);
  const bf16_t* Kmem = (const bf16_t*)(P.ws + OFF_KMEM) + (size_t)layer * 512 * 256;
  const bf16_t* VmT = (const bf16_t*)(P.ws + OFF_VMEM) + (size_t)layer * 512 * 256;
  const int lane = threadIdx.x & 63, wid = threadIdx.x >> 6, r = lane & 15, q = lane >> 4;
  bf16_t* sP = (bf16_t*)smem + wid * (16 * 264);
  if (gw < 0) return;
  for (int item = gw; item < (kT / 16) * 4; item += nw) {
    const int head = item & 3;
    const size_t tok0 = (size_t)(item >> 2) * 16;
    const int b = (int)(tok0 / kS);
    bf16_t* qbase = Cat + tok0 * 1024 + 768 + head * 64;
    const uint4 qf0 = *(const uint4*)(qbase + (size_t)r * 1024 + q * 8);
    const uint4 qf1 = *(const uint4*)(qbase + (size_t)r * 1024 + 32 + q * 8);
    const bf16_t* Kb = Kmem + (size_t)b * 256 * 256 + head * 64 + q * 8;
    f32x4 sa[16];
#pragma unroll
    for (int n = 0; n < 16; ++n) {
      const uint4 k0 = *(const uint4*)(Kb + (size_t)(n * 16 + r) * 256);
      const uint4 k1 = *(const uint4*)(Kb + (size_t)(n * 16 + r) * 256 + 32);
      sa[n] = __builtin_amdgcn_mfma_f32_16x16x32_bf16(u4_to_frag(qf0), u4_to_frag(k0), (f32x4){0.f, 0.f, 0.f, 0.f}, 0, 0, 0);
      sa[n] = __builtin_amdgcn_mfma_f32_16x16x32_bf16(u4_to_frag(qf1), u4_to_frag(k1), sa[n], 0, 0, 0);
      if ((n & 3) == 3) __builtin_amdgcn_sched_barrier(0);
    }
    float inv[4];
#pragma unroll
    for (int j = 0; j < 4; ++j) {
      float mx = sa[0][j];
#pragma unroll
      for (int n = 1; n < 16; ++n) mx = fmaxf(mx, sa[n][j]);
      mx = max16(mx);
      float sum = 0.f;
#pragma unroll
      for (int n = 0; n < 16; ++n) {
        float p = __expf(sa[n][j] - mx);
        sum += p;
        sP[(q * 4 + j) * 264 + n * 16 + r] = f2bf(p);
      }
      inv[j] = 1.f / sum16(sum);
    }
    f32x4 o[4];
#pragma unroll
    for (int ne = 0; ne < 4; ++ne) o[ne] = (f32x4){0.f, 0.f, 0.f, 0.f};
    const bf16_t* Vb = VmT + (size_t)(b * 4 + head) * 64 * 256 + q * 8;
#pragma unroll
    for (int ks = 0; ks < 8; ++ks) {
      const bf16x8 pf = *(const bf16x8*)(sP + r * 264 + ks * 32 + q * 8);
#pragma unroll
      for (int ne = 0; ne < 4; ++ne) {
        const uint4 vf = *(const uint4*)(Vb + (size_t)(ne * 16 + r) * 256 + ks * 32);
        o[ne] = __builtin_amdgcn_mfma_f32_16x16x32_bf16(pf, u4_to_frag(vf), o[ne], 0, 0, 0);
      }
      if (ks & 1) __builtin_amdgcn_sched_barrier(0);
    }
    VMWAIT();
#pragma unroll
    for (int ne = 0; ne < 4; ++ne)
#pragma unroll
      for (int j = 0; j < 4; ++j) qbase[(size_t)(q * 4 + j) * 1024 + ne * 16 + r] = f2bf(o[ne][j] * inv[j]);
  }
}

__device__ __forceinline__ void dilated_slab(const Params& P, int pass, int sidx, int b, int p0, int hg, const float* sBias,
                                             float* sLse, bf16_t* sP) {
  bf16_t* Cat = (bf16_t*)(P.ws + OFF_CAT);
  const bf16_t* Ksh = (const bf16_t*)(P.ws + OFF_R2);
  const bf16_t* VshT = Ksh + (size_t)kT * 768;
  const int lane = threadIdx.x & 63, r = lane & 15, q = lane >> 4;
  const int g = sidx >> 4, i = sidx & 15, d = 1 << (2 * g), head = g * 4 + hg;
  const int r_res = (g == 0) ? 0 : (g == 1) ? (i >> 2) : i;
  const int sig0 = (g == 0) ? (p0 + 16 * i) : (g == 1) ? ((p0 >> 2) + 16 * (i & 3)) : (p0 >> 4);
  const size_t tokq = (size_t)b * kS + (size_t)(sig0 + r) * d + r_res;
  const uint4 qf0 = *(const uint4*)(Cat + tokq * 1024 + head * 64 + q * 8);
  const uint4 qf1 = *(const uint4*)(Cat + tokq * 1024 + head * 64 + 32 + q * 8);
  f32x4 sa[10];
  sa[0] = (f32x4){0.f, 0.f, 0.f, 0.f};
#pragma unroll
  for (int n = 1; n < 10; ++n) {
    int sigk = sig0 - 144 + n * 16 + r;
    sigk = sigk < 0 ? 0 : sigk;
    const bf16_t* kp = Ksh + ((size_t)b * kS + (size_t)sigk * d + r_res) * 768 + head * 64 + q * 8;
    const uint4 k0 = *(const uint4*)kp;
    const uint4 k1 = *(const uint4*)(kp + 32);
    sa[n] = __builtin_amdgcn_mfma_f32_16x16x32_bf16(u4_to_frag(qf0), u4_to_frag(k0), (f32x4){0.f, 0.f, 0.f, 0.f}, 0, 0, 0);
    sa[n] = __builtin_amdgcn_mfma_f32_16x16x32_bf16(u4_to_frag(qf1), u4_to_frag(k1), sa[n], 0, 0, 0);
  }
  float scl[4];
#pragma unroll
  for (int j = 0; j < 4; ++j) {
    float mx = -1e30f;
#pragma unroll
    for (int n = 1; n < 10; ++n) {
      const int mo = 144 + q * 4 + j - n * 16 - r;
      const int sigk = sig0 - 144 + n * 16 + r;
      const bool ok = (mo >= 0) && (mo <= 128) && (sigk >= 0);
      const float sv = ok ? (sa[n][j] + sBias[g * 132 + (ok ? mo : 0)]) : -1e30f;
      sa[n][j] = sv;
      mx = fmaxf(mx, sv);
    }
    mx = max16(mx);
    float sum = 0.f;
#pragma unroll
    for (int n = 1; n < 10; ++n) {
      const float p = (sa[n][j] > -1e29f) ? __expf(sa[n][j] - mx) : 0.f;
      sa[n][j] = p;
      sum += p;
    }
    sum = sum16(sum);
    const float lse = mx + __logf(sum);
    const int pw = (sig0 + q * 4 + j) * d + r_res - p0;
    if (pass == 0) {
      if (r == 0) sLse[g * 256 + pw] = lse;
      scl[j] = 0.f;
    } else {
      const float l0 = sLse[pw], l1 = sLse[256 + pw], l2 = sLse[512 + pw];
      const float L = fmaxf(fmaxf(l0, l1), l2);
      const float den = __expf(l0 - L) + __expf(l1 - L) + __expf(l2 - L);
      scl[j] = __expf(lse - L) / (den * sum);
    }
  }
  if (pass == 0) return;
#pragma unroll
  for (int j = 0; j < 4; ++j) {
#pragma unroll
    for (int n = 0; n < 10; ++n) sP[(q * 4 + j) * 168 + n * 16 + r] = f2bf(sa[n][j]);
  }
  f32x4 o[4];
#pragma unroll
  for (int ne = 0; ne < 4; ++ne) o[ne] = (f32x4){0.f, 0.f, 0.f, 0.f};
  const bf16_t* Vb = VshT + ((size_t)(b * 12 + head) * 64 + r) * kS + (size_t)r_res * (kS / d);
#pragma unroll
  for (int ks = 0; ks < 5; ++ks) {
    const bf16x8 pf = *(const bf16x8*)(sP + r * 168 + ks * 32 + q * 8);
    int sk0 = sig0 - 144 + ks * 32 + q * 8;
    sk0 = sk0 < 0 ? 0 : sk0;
#pragma unroll
    for (int ne = 0; ne < 4; ++ne) {
      const uint4 vf = *(const uint4*)(Vb + (size_t)ne * 16 * kS + sk0);
      o[ne] = __builtin_amdgcn_mfma_f32_16x16x32_bf16(pf, u4_to_frag(vf), o[ne], 0, 0, 0);
    }
  }
  VMWAIT();
#pragma unroll
  for (int ne = 0; ne < 4; ++ne)
#pragma unroll
    for (int j = 0; j < 4; ++j) {
      const size_t tok = (size_t)b * kS + (size_t)(sig0 + q * 4 + j) * d + r_res;
      Cat[tok * 1024 + head * 64 + ne * 16 + r] = f2bf(o[ne][j] * scl[j]);
    }
}

__device__ __forceinline__ void phase_dilated_mfma(const Params& P) {
  float* sBias = (float*)smem;
  float* sLse = (float*)(smem + 1584);
  const int tid = threadIdx.x, wid = tid >> 6;
  bf16_t* sP = (bf16_t*)(smem + 4656) + wid * (16 * 168);
  for (int item = blockIdx.x; item < 512; item += gridDim.x) {
    const int hg = item & 3, win = item >> 2, b = win >> 6, p0 = (win & 63) * 256;
    __syncthreads();
    for (int i = tid; i < 3 * 129; i += NTHR) {
      const int g = i / 129, mo = i - g * 129;
      sBias[g * 132 + mo] = t5_bias(P.rel_bias, mo << (2 * g), g * 4 + hg);
    }
    __syncthreads();
#pragma unroll 1
    for (int pass = 0; pass < 2; ++pass) {
#pragma unroll 1
      for (int sidx = wid; sidx < 48; sidx += NWAVE) dilated_slab(P, pass, sidx, b, p0, hg, sBias, sLse, sP);
      VMWAIT();
      __syncthreads();
    }
  }
}

#define XB_TMO      128
#define XB_XCNT(j)  (256  + 64 * (j))
#define XB_XSUB(j)  (1280 + 64 * (j))
#define XB_XGEN(j)  (2304 + 64 * (j))
#define XB_TOP      3328
#define XB_TOPGEN   3392
#define XCD_BAR_WORDS 3456
#define XB_SPIN_CAP (1u << 23)
__device__ __forceinline__ unsigned xb_ld(unsigned* p) { return __hip_atomic_load(p, __ATOMIC_RELAXED, __HIP_MEMORY_SCOPE_AGENT); }
__device__ __forceinline__ unsigned xb_add(unsigned* p, unsigned v) { return __hip_atomic_fetch_add(p, v, __ATOMIC_RELAXED, __HIP_MEMORY_SCOPE_AGENT); }
__device__ __forceinline__ unsigned xb_xcc_id() { return (unsigned)__builtin_amdgcn_s_getreg((3 << 11) | 20) & 0xFu; }
#define XB_SPIN(cond, bar) do { unsigned _sp = 0; while (cond) { __builtin_amdgcn_s_sleep(1); \
    if ((++_sp & 255u) == 0u) { if (xb_ld(&(bar)[XB_TMO])) break; if (_sp > XB_SPIN_CAP) { atomicAdd(&(bar)[XB_TMO], 1u); break; } } } } while (0)
struct XcdBarrier { unsigned* bar; unsigned x; volatile LAS unsigned* st; };
__device__ __forceinline__ XcdBarrier xcd_barrier_post(unsigned* bar, volatile LAS unsigned* st) {
  XcdBarrier b; b.bar = bar; b.x = xb_xcc_id(); b.st = st;
  if (threadIdx.x == 0) (void)xb_add(&bar[XB_XCNT(b.x)], 1u);
  return b;
}
__device__ __forceinline__ void xcd_barrier_complete(unsigned* bar, unsigned x, unsigned& nloc, unsigned& nx) {
  const unsigned Gr = gridDim.x * gridDim.y * gridDim.z;
  unsigned sum, cnt, mine, sp = 0u;
  for (;;) {
    sum = 0u; cnt = 0u; mine = 0u;
#pragma unroll
    for (unsigned j = 0; j < 16; ++j) { const unsigned c = xb_ld(&bar[XB_XCNT(j)]); sum += c; cnt += (c > 0u) ? 1u : 0u; mine = (j == x) ? c : mine; }
    if (sum == Gr) break;
    __builtin_amdgcn_s_sleep(1);
    if ((++sp & 255u) == 0u) { if (xb_ld(&bar[XB_TMO])) break; if (sp > XB_SPIN_CAP) { atomicAdd(&bar[XB_TMO], 1u); break; } }
  }
  nloc = mine > 0u ? mine : 1u; nx = cnt > 0u ? cnt : 1u;
}
__device__ __forceinline__ void xcd_barrier(const XcdBarrier& b) {
  asm volatile("s_waitcnt vmcnt(0)" ::: "memory");
  __syncthreads();
  if (threadIdx.x == 0) {
    unsigned* bar = b.bar;
    __builtin_amdgcn_s_waitcnt(0);
    unsigned nloc = b.st[0], nx = b.st[1];
    if (nloc == 0u) { xcd_barrier_complete(bar, b.x, nloc, nx); b.st[0] = nloc; b.st[1] = nx; }
    const unsigned old = xb_add(&bar[XB_XSUB(b.x)], 1u);
    const unsigned gen = old / nloc;
    if (old + 1u == (gen + 1u) * nloc) {
      __builtin_amdgcn_fence(__ATOMIC_RELEASE, "agent");
      asm volatile("s_waitcnt vmcnt(0)" ::: "memory");
      const unsigned og = xb_add(&bar[XB_TOP], 1u);
      const unsigned tg = og / nx;
      if (og + 1u == (tg + 1u) * nx) xb_add(&bar[XB_TOPGEN], 1u);
      else XB_SPIN(xb_ld(&bar[XB_TOPGEN]) == tg, bar);
      __builtin_amdgcn_fence(__ATOMIC_ACQUIRE, "agent");
      xb_add(&bar[XB_XGEN(b.x)], 1u);
      asm volatile("s_waitcnt vmcnt(0)" ::: "memory");
    } else {
      XB_SPIN(xb_ld(&bar[XB_XGEN(b.x)]) == gen, bar);
      __builtin_amdgcn_fence(__ATOMIC_ACQUIRE, "agent");
      asm volatile("s_waitcnt vmcnt(0)" ::: "memory");
    }
  }
  __syncthreads();
}
#define grid_barrier() xcd_barrier(xbar_)

constexpr int NPHASE = 17;
#ifndef ONLY_PHASE
#define ONLY_PHASE -1
#endif
#ifndef SKIP12
#define SKIP12 0
#endif
#ifndef SKIP14
#define SKIP14 0
#endif
#define PH(n) (ONLY_PHASE < 0 || ONLY_PHASE == (n))

__device__ __forceinline__ char* launder(char* p) { asm volatile("" : "+s"(p)); return p; }
__global__ void __launch_bounds__(512, 2) fwd_megakernel(Params P, int pb, int pe) {
#define W ((bf16_t*)(wsl + OFF_W))
#define xb ((bf16_t*)(wsl + OFF_XB))
#define H ((bf16_t*)(wsl + OFF_R1))
#define Pbase ((bf16_t*)(wsl + OFF_R1))
#define Ksh ((bf16_t*)(wsl + OFF_R2))
#define Vsh (Ksh + (size_t)kT * 768)
#define Cat ((bf16_t*)(wsl + OFF_CAT))
#define ssq ((float*)(wsl + OFF_SSQ))
#define G ((float*)(wsl + OFF_G))
#define memb ((bf16_t*)(wsl + OFF_MEMB))
#define ssqm ((float*)(wsl + OFF_SSQM))
#define Kmem ((bf16_t*)(wsl + OFF_KMEM))
#define Vmem ((bf16_t*)(wsl + OFF_VMEM))
  if (pe < -12345) cg::this_grid().sync();
  volatile LAS unsigned* xst_ = (volatile LAS unsigned*)(smem + 131072);
  if (threadIdx.x == 0) { xst_[0] = 0u; xst_[1] = 0u; }
  __syncthreads();
  XcdBarrier xbar_;
  xbar_.bar = (unsigned*)(P.ws + OFF_BAR); xbar_.x = 0; xbar_.st = xst_;
  if (pe - pb > 1) xbar_ = xcd_barrier_post((unsigned*)(P.ws + OFF_BAR), xst_);
  if (pb == 100) {
    char* wsl = P.ws;
    for (size_t i = (size_t)blockIdx.x * NTHR + threadIdx.x; i < (size_t)kT * 1024; i += (size_t)gridDim.x * NTHR) P.out[i] = bf2f(Cat[i]);
    return;
  }
  {
    if (pb <= 0 && 0 < pe && PH(0)) { char* wsl = launder(P.ws); Params Q = P; Q.ws = wsl; (void)Q; phase_convert(Q); }
    if (pb <= 0 && 0 + 1 < pe) grid_barrier();
    if (pb <= 1 && 1 < pe && PH(1)) { char* wsl = launder(P.ws); Params Q = P; Q.ws = wsl; (void)Q; gemm8(xb, W + W_GU0, kT, 5632, 1024, Epi8Swiglu{ssq, H}); }
    if (pb <= 1 && 1 + 1 < pe) grid_barrier();
    if (pb <= 2 && 2 < pe && PH(2)) { char* wsl = launder(P.ws); Params Q = P; Q.ws = wsl; (void)Q; { gemm8(H, W + W_DN0, kT, 1024, 2816, Epi8Resid{P.x, P.out, xb, ssq, 0.5f});
      gemm8(memb, W + W_MKV0, 512, 512, 1024, Epi8MemKv{ssqm, Kmem, (bf16_t*)(wsl + OFF_VTOK), P.mem_k_norm}, 64);
      gemm8(memb, W + W_MKV1, 512, 512, 1024, Epi8MemKv{ssqm, Kmem + 512 * 256, (bf16_t*)(wsl + OFF_VTOK) + 512 * 256, P.mem_k_norm + 64}, 192);
    } }
    if (pb <= 2 && 2 + 1 < pe) grid_barrier();
    if (pb <= 3 && 3 < pe && PH(3)) { char* wsl = launder(P.ws); Params Q = P; Q.ws = wsl; (void)Q; {
      gemm8(xb, W + W_IN, kT, 3584, 1024, Epi8InProj{ssq, Pbase, Cat, G, P.mem_q_norm, P.a_gate_bias});
    } }
    if (pb <= 3 && 3 + 1 < pe) grid_barrier();
    if (pb <= 4 && 4 < pe && PH(4)) { char* wsl = launder(P.ws); Params Q = P; Q.ws = wsl; (void)Q; { memv_transpose((const bf16_t*)(wsl + OFF_VTOK), Vmem); phase_prep(Q); } }
    if (pb <= 4 && 4 + 1 < pe) grid_barrier();
    if (pb <= 5 && 5 < pe && PH(5)) { char* wsl = launder(P.ws); Params Q = P; Q.ws = wsl; (void)Q; phase_scan(Q); { const int wv = (int)(threadIdx.x >> 6) * (int)gridDim.x + (int)blockIdx.x, tot = (int)gridDim.x * NWAVE; if (tot > 416 + 64) { memattn_mfma(Q, 0, wv - 416, tot - 416); wave_convert_queue(Q, (unsigned*)(wsl + OFF_BAR) + 3584); } else { memattn_mfma(Q, 0, wv, tot); wave_convert(Q, wv, tot, false); } } }
    if (pb <= 5 && 5 + 1 < pe) grid_barrier();
    if (pb <= 6 && 6 < pe && PH(6)) { char* wsl = launder(P.ws); Params Q = P; Q.ws = wsl; (void)Q; phase_chunk(Q); }
    if (pb <= 6 && 6 + 1 < pe) grid_barrier();
    if (pb <= 7 && 7 < pe && PH(7)) { char* wsl = launder(P.ws); Params Q = P; Q.ws = wsl; (void)Q; gemm8(Cat, W + W_AOUT, kT, 1024, 1024, Epi8Resid{P.out, P.out, xb, ssq, 1.f}); }
    if (pb <= 7 && 7 + 1 < pe) grid_barrier();
    if (pb <= 8 && 8 < pe && PH(8)) { char* wsl = launder(P.ws); Params Q = P; Q.ws = wsl; (void)Q; gemm8(xb, W + W_GU1, kT, 5632, 1024, Epi8Swiglu{ssq, H}); }
    if (pb <= 8 && 8 + 1 < pe) grid_barrier();
    if (pb <= 9 && 9 < pe && PH(9)) { char* wsl = launder(P.ws); Params Q = P; Q.ws = wsl; (void)Q; gemm8(H, W + W_DN1, kT, 1024, 2816, Epi8Resid{P.out, P.out, xb, ssq, 0.5f}); }
    if (pb <= 9 && 9 + 1 < pe) grid_barrier();
    if (pb <= 10 && 10 < pe && PH(10)) { char* wsl = launder(P.ws); Params Q = P; Q.ws = wsl; (void)Q; gemm8(xb, W + W_GU2, kT, 7168, 1024, Epi8KvFfn{ssq, H, Ksh, Cat, P.kv_k_norm}); }
    if (pb <= 10 && 10 + 1 < pe) grid_barrier();
    if (pb <= 11 && 11 < pe && PH(11)) { char* wsl = launder(P.ws); Params Q = P; Q.ws = wsl; (void)Q; { gemm8(H, W + W_DN2, kT, 1024, 2816, Epi8Resid{P.out, P.out, xb, ssq, 0.5f}); phase_vtranspose(Cat, Vsh); } }
    if (pb <= 11 && 11 + 1 < pe) grid_barrier();
    if (pb <= 12 && 12 < pe && PH(12) && !SKIP12) { char* wsl = launder(P.ws); Params Q = P; Q.ws = wsl; (void)Q; gemm8(xb, W + W_BQ, kT, 1024, 1024, Epi8QProj{ssq, Cat, P.b_q_norm, P.mem_q_norm + 64}); }
    if (pb <= 12 && 12 + 1 < pe) grid_barrier();
    if (pb <= 13 && 13 < pe && PH(13)) { char* wsl = launder(P.ws); Params Q = P; Q.ws = wsl; (void)Q; { phase_dilated_mfma(Q); memattn_mfma(Q, 1, (int)blockIdx.x * NWAVE + (int)(threadIdx.x >> 6), (int)gridDim.x * NWAVE); } }
    if (pb <= 13 && 13 + 1 < pe) grid_barrier();
    if (pb <= 14 && 14 < pe && PH(14) && !SKIP14) { char* wsl = launder(P.ws); Params Q = P; Q.ws = wsl; (void)Q; gemm8(Cat, W + W_BOUT, kT, 1024, 1024, Epi8Resid{P.out, P.out, xb, ssq, 1.f}); }
    if (pb <= 14 && 14 + 1 < pe) grid_barrier();
    if (pb <= 15 && 15 < pe && PH(15)) { char* wsl = launder(P.ws); Params Q = P; Q.ws = wsl; (void)Q; gemm8(xb, W + W_GU3, kT, 5632, 1024, Epi8Swiglu{ssq, H}); }
    if (pb <= 15 && 15 + 1 < pe) grid_barrier();
    if (pb <= 16 && 16 < pe && PH(16)) { char* wsl = launder(P.ws); Params Q = P; Q.ws = wsl; (void)Q; gemm8(H, W + W_DN3, kT, 1024, 2816, Epi8Resid{P.out, P.out, nullptr, ssq, 0.5f}); }
  }
}
#undef W
#undef xb
#undef H
#undef Pbase
#undef Ksh
#undef Vsh
#undef Cat
#undef ssq
#undef G
#undef memb
#undef ssqm
#undef Kmem
#undef Vmem

extern "C" void kernel_launch(void* const* d_in, const int* in_sizes, int n_in, void* d_out, int out_size, void* d_ws,
                              size_t ws_size, hipStream_t stream) {
  (void)in_sizes; (void)n_in; (void)out_size;
  static int grid_blocks = 0;
  if (!grid_blocks) {
    int dev = 0, cus = 0, per_cu = 0;
    hipGetDevice(&dev);
    hipDeviceGetAttribute(&cus, hipDeviceAttributeMultiprocessorCount, dev);
    hipOccupancyMaxActiveBlocksPerMultiprocessor(&per_cu, fwd_megakernel, NTHR, 0);
    if (per_cu > 1) per_cu = 1;
    grid_blocks = cus * per_cu;
    if (ws_size < OFF_END) fprintf(stderr, "workspace too small: %zu < %zu\n", ws_size, (size_t)OFF_END);
  }
  Params p{};
  const float** pf = (const float**)&p;
  for (int i = 0; i < 27; ++i) pf[i] = (const float*)d_in[i];
  p.out = (float*)d_out;
  p.ws = (char*)d_ws;
#ifndef RUN_PE
#define RUN_PE NPHASE
#endif
#ifdef MULTI_LAUNCH
  hipError_t e = hipSuccess;
  for (int ph = 0; ph < RUN_PE; ++ph) {
    int pb = ph, pe = ph + 1;
    hipLaunchKernelGGL(fwd_megakernel, dim3(grid_blocks), dim3(NTHR), 0, stream, p, pb, pe);
  }
#else
  hipMemsetAsync((char*)d_ws + OFF_BAR, 0, 16384, stream);
  int pb = 0, pe = RUN_PE;
  void* args[] = {&p, &pb, &pe};
  hipError_t e = hipLaunchCooperativeKernel((void*)fwd_megakernel, dim3(grid_blocks), dim3(NTHR), args, 0, stream);
#endif
  if (e != hipSuccess) fprintf(stderr, "cooperative launch failed: %s (grid %d)\n", hipGetErrorString(e), grid_blocks);
}
```

```cpp
#include <hip/hip_runtime.h>
#include <hip/hip_cooperative_groups.h>
#include <stdint.h>
#include <stdio.h>
namespace cg = cooperative_groups;

typedef unsigned short bf16_t;
typedef __attribute__((ext_vector_type(8))) short bf16x8;
typedef __attribute__((ext_vector_type(4))) float f32x4;
#define LAS __attribute__((address_space(3)))
#define VMWAIT() asm volatile("s_waitcnt vmcnt(0)" ::: "memory")

constexpr int kT = 32768, kS = 16384;
constexpr int NTHR = 512, NWAVE = 8;
constexpr float EPS = 1e-6f;

constexpr size_t GU_SZ = 5632ull * 1024, DN_SZ = 1024ull * 2816, KV_SZ = 1536ull * 1024, IN_SZ = 3584ull * 1024,
                 SQ_SZ = 1024ull * 1024, MKV_SZ = 512ull * 1024;
constexpr size_t W_GU0 = 0, W_GU1 = GU_SZ, W_GU2 = 2 * GU_SZ, W_KV = 3 * GU_SZ, W_GU3 = W_KV + KV_SZ,
                 W_DN0 = W_GU3 + GU_SZ, W_DN1 = W_DN0 + DN_SZ, W_DN2 = W_DN1 + DN_SZ, W_DN3 = W_DN2 + DN_SZ,
                 W_IN = W_DN3 + DN_SZ, W_AOUT = W_IN + IN_SZ, W_BQ = W_AOUT + SQ_SZ, W_BOUT = W_BQ + SQ_SZ,
                 W_MKV0 = W_BOUT + SQ_SZ, W_MKV1 = W_MKV0 + MKV_SZ, W_END = W_MKV1 + MKV_SZ;
constexpr size_t PSZ = (size_t)kT * 768 * 2;
constexpr size_t OFF_W = 0;
constexpr size_t OFF_XB = (W_END * 2 + 255) / 256 * 256;
constexpr size_t OFF_R1 = OFF_XB + (size_t)kT * 1024 * 2;
constexpr size_t OFF_R2 = OFF_R1 + 4 * PSZ;
constexpr size_t OFF_CAT = OFF_R2 + 2 * PSZ;
constexpr size_t OFF_SSQ = OFF_CAT + (size_t)kT * 1024 * 2;
constexpr size_t OFF_G = OFF_SSQ + (size_t)kT * 16 * 4;
constexpr size_t OFF_MEMB = OFF_G + (size_t)kT * 8 * 4;
constexpr size_t OFF_SSQM = OFF_MEMB + 512ull * 1024 * 2;
constexpr size_t OFF_KMEM = OFF_SSQM + 512ull * 16 * 4;
constexpr size_t OFF_VMEM = OFF_KMEM + 2ull * 512 * 256 * 2;
constexpr size_t OFF_U = OFF_VMEM + 2ull * 512 * 256 * 2;
constexpr size_t OFF_BC = OFF_U + 1024ull * 128 * 4;
constexpr size_t OFF_EW = OFF_BC + 1024ull * 128 * 4;
constexpr size_t OFF_UMAX = OFF_EW + 1024ull * 128 * 2;
constexpr size_t OFF_BL = OFF_UMAX + 4096;
constexpr size_t OFF_M0 = OFF_BL + 4096;
constexpr size_t OFF_BAR = OFF_M0 + 4096;
constexpr size_t OFF_VTOK = OFF_BAR + 16384;
constexpr size_t OFF_END = OFF_VTOK + 2ull * 512 * 256 * 2;

struct Params {
  const float *x, *mem, *ffn1_norm, *ffn1_wg, *ffn1_wu, *ffn1_wd, *ffn2_norm, *ffn2_wg, *ffn2_wu, *ffn2_wd, *mix_norm,
      *mem_norm, *w_mem_kv, *mem_q_norm, *mem_k_norm, *a_w_in, *a_conv, *a_gate_bias, *a_h_norm, *a_w_out, *b_w_q,
      *b_q_norm, *b_w_out, *kv_norm, *w_kv, *kv_k_norm, *rel_bias;
  float* out;
  char* ws;
};

__shared__ __attribute__((aligned(16))) char smem[146432];

__device__ __forceinline__ bf16_t f2bf(float f) {
  uint32_t u = __float_as_uint(f);
  u += 0x7fffu + ((u >> 16) & 1u);
  return (bf16_t)(u >> 16);
}
__device__ __forceinline__ float bf2f(bf16_t h) { return __uint_as_float(((uint32_t)h) << 16); }
__device__ __forceinline__ float bflo(uint32_t u) { return __uint_as_float(u << 16); }
__device__ __forceinline__ float bfhi(uint32_t u) { return __uint_as_float(u & 0xffff0000u); }
__device__ __forceinline__ uint32_t pack2(float a, float b) { uint32_t r; asm("v_cvt_pk_bf16_f32 %0, %1, %2" : "=v"(r) : "v"(a), "v"(b)); return r; }
__device__ __forceinline__ float dot8(uint4 a, uint4 b) {
  return bflo(a.x) * bflo(b.x) + bfhi(a.x) * bfhi(b.x) + bflo(a.y) * bflo(b.y) + bfhi(a.y) * bfhi(b.y) +
         bflo(a.z) * bflo(b.z) + bfhi(a.z) * bfhi(b.z) + bflo(a.w) * bflo(b.w) + bfhi(a.w) * bfhi(b.w);
}
__device__ __forceinline__ float wave_sum(float v) {
  for (int o = 32; o > 0; o >>= 1) v += __shfl_xor(v, o);
  return v;
}
__device__ __forceinline__ float wave_max(float v) {
  for (int o = 32; o > 0; o >>= 1) v = fmaxf(v, __shfl_xor(v, o));
  return v;
}
__device__ __forceinline__ float dpp_ror_(float v, int) { return v; }
#define DPP_ROR_ADD(v, ctrl) v += __builtin_bit_cast(float, __builtin_amdgcn_update_dpp(0, __builtin_bit_cast(int, v), ctrl, 0xf, 0xf, false))
__device__ __forceinline__ float sum16(float v) {
  DPP_ROR_ADD(v, 0x128); DPP_ROR_ADD(v, 0x124); DPP_ROR_ADD(v, 0x122); DPP_ROR_ADD(v, 0x121);
  return v;
}
#define DPP_ROR_MAX(v, ctrl) v = fmaxf(v, __builtin_bit_cast(float, __builtin_amdgcn_update_dpp(0, __builtin_bit_cast(int, v), ctrl, 0xf, 0xf, false)))
__device__ __forceinline__ float max16(float v) {
  DPP_ROR_MAX(v, 0x128); DPP_ROR_MAX(v, 0x124); DPP_ROR_MAX(v, 0x122); DPP_ROR_MAX(v, 0x121);
  return v;
}
__device__ __forceinline__ float sigmoidf_(float x) { return __builtin_amdgcn_rcpf(1.f + __expf(-x)); }

struct WJob { size_t dst; int Nd, K; };
__device__ __forceinline__ WJob wjob(int j) {
  switch (j) {
    case 0: return {W_GU0, 5632, 1024};
    case 1: return {W_GU1, 5632, 1024};
    case 2: return {W_GU2, 5632, 1024};
    case 3: return {W_GU3, 5632, 1024};
    case 4: return {W_DN0, 1024, 2816};
    case 5: return {W_DN1, 1024, 2816};
    case 6: return {W_DN2, 1024, 2816};
    case 7: return {W_DN3, 1024, 2816};
    case 8: return {W_IN, 3584, 1024};
    case 9: return {W_AOUT, 1024, 1024};
    case 10: return {W_BQ, 1024, 1024};
    case 11: return {W_BOUT, 1024, 1024};
    case 12: return {W_KV, 1536, 1024};
    case 13: return {W_MKV0, 512, 1024};
    default: return {W_MKV1, 512, 1024};
  }
}
__device__ __forceinline__ int headmap(int r256) { const int bj = r256 >> 7, hh = (r256 & 127) >> 5, i = r256 & 31; return hh * 64 + bj * 32 + i; }
__device__ __forceinline__ void wsrc(const Params& P, int j, int n, const float*& p, int& ld, const float*& gain) {
  p = nullptr; ld = 0; gain = nullptr;
  if (j < 4) {
    int layer = j >> 1, which = j & 1;
    int pn = n >> 8, r = n & 255, bj = r >> 7, col = pn * 128 + (r & 127);
    const float* wg = which ? P.ffn2_wg : P.ffn1_wg;
    const float* wu = which ? P.ffn2_wu : P.ffn1_wu;
    p = (bj ? wu : wg) + (size_t)layer * 1024 * 2816 + col;
    ld = 2816;
    gain = (which ? P.ffn2_norm : P.ffn1_norm) + layer * 1024;
  } else if (j < 8) {
    int i = j - 4, layer = i >> 1, which = i & 1;
    p = (which ? P.ffn2_wd : P.ffn1_wd) + (size_t)layer * 2816 * 1024 + n;
    ld = 1024;
  } else if (j == 8) {
    int col = -1;
    if (n < 3072) col = n; else if (n < 3328) col = 3080 + headmap(n - 3072); else if (n < 3336) col = 3072 + (n - 3328);
    if (col >= 0) { p = P.a_w_in + col; ld = 3336; }
    gain = P.mix_norm;
  } else if (j == 9) { p = P.a_w_out + n; ld = 1024; }
  else if (j == 10) { p = P.b_w_q + (n & ~255) + headmap(n & 255); ld = 1024; gain = P.mix_norm + 1024; }
  else if (j == 11) { p = P.b_w_out + n; ld = 1024; }
  else if (j == 12) { int col = (n < 768) ? ((n & ~255) + headmap(n & 255)) : n; p = P.w_kv + col; ld = 1536; gain = P.kv_norm; }
  else { int l = j - 13; int col = (n < 256) ? headmap(n) : n; p = P.w_mem_kv + (size_t)l * 1024 * 512 + col; ld = 512; gain = P.mem_norm + l * 1024; }
}

__device__ __forceinline__ void wave_convert(const Params& P, int widx, int nwv, bool early) {
  bf16_t* W = (bf16_t*)(P.ws + OFF_W);
  const int lane = threadIdx.x & 63;
  int base = 0;
  for (int j = 0; j < 15; ++j) {
    const bool is_early = (j == 0 || j == 4 || j == 8 || j >= 13);
    if (is_early != early) continue;
    WJob wj = wjob(j);
    const int tk_cnt = wj.K >> 6, ntile = (wj.Nd >> 6) * tk_cnt;
    const int first = (widx + nwv - (base % nwv)) % nwv;
    for (int t = first; t < ntile; t += nwv) {
      const int tn = t / tk_cnt, tk = t - tn * tk_cnt, n = (tn << 6) + lane, k0 = tk << 6;
      const float* sp; int ld; const float* gain;
      wsrc(P, j, n, sp, ld, gain);
      float v[64];
#pragma unroll
      for (int k = 0; k < 64; ++k) v[k] = sp ? sp[(size_t)(k0 + k) * ld] : 0.f;
      if (gain) {
#pragma unroll
        for (int k4 = 0; k4 < 16; ++k4) {
          const float4 g4 = *(const float4*)(gain + k0 + k4 * 4);
          v[k4 * 4 + 0] *= g4.x; v[k4 * 4 + 1] *= g4.y; v[k4 * 4 + 2] *= g4.z; v[k4 * 4 + 3] *= g4.w;
        }
      }
      VMWAIT();
      bf16_t* dst = W + wj.dst + (size_t)n * wj.K + k0;
#pragma unroll
      for (int k8 = 0; k8 < 8; ++k8) {
        uint4 o;
        o.x = pack2(v[k8 * 8 + 0], v[k8 * 8 + 1]); o.y = pack2(v[k8 * 8 + 2], v[k8 * 8 + 3]);
        o.z = pack2(v[k8 * 8 + 4], v[k8 * 8 + 5]); o.w = pack2(v[k8 * 8 + 6], v[k8 * 8 + 7]);
        *(uint4*)(dst + k8 * 8) = o;
      }
    }
    base += ntile;
  }
}

__device__ __forceinline__ void phase_convert(const Params& P) {
  bf16_t* W = (bf16_t*)(P.ws + OFF_W);
  float* sT = (float*)smem;
  const int tid = threadIdx.x;
  wave_convert(P, (int)(blockIdx.x * NWAVE + (threadIdx.x >> 6)), (int)(gridDim.x * NWAVE), true);
  bf16_t* xb = (bf16_t*)(P.ws + OFF_XB);
  float* ssq = (float*)(P.ws + OFF_SSQ);
  bf16_t* memb = (bf16_t*)(P.ws + OFF_MEMB);
  float* ssqm = (float*)(P.ws + OFF_SSQM);
  const int lane = tid & 63, gw = blockIdx.x * NWAVE + (tid >> 6), nw = gridDim.x * NWAVE;
  for (int row = gw; row < kT + 512; row += nw) {
    const float* src = (row < kT) ? (P.x + (size_t)row * 1024) : (P.mem + (size_t)(row - kT) * 1024);
    bf16_t* dst = (row < kT) ? (xb + (size_t)row * 1024) : (memb + (size_t)(row - kT) * 1024);
    float* sq = (row < kT) ? (ssq + (size_t)row * 16) : (ssqm + (size_t)(row - kT) * 16);
    float ss = 0.f;
#pragma unroll
    for (int i = 0; i < 4; ++i) {
      float4 v = ((const float4*)src)[lane + 64 * i];
      ss += v.x * v.x + v.y * v.y + v.z * v.z + v.w * v.w;
      uint2 o; o.x = pack2(v.x, v.y); o.y = pack2(v.z, v.w);
      ((uint2*)dst)[lane + 64 * i] = o;
    }
    ss = wave_sum(ss);
    if (lane < 16) sq[lane] = (lane == 0) ? ss : 0.f;
  }
}

constexpr int G8_BM = 256, G8_BK = 64, G8_HALF = 128, G8_HTB = G8_HALF * G8_BK * 2, G8_NXCD = 8, G8_WGM = 8;
__device__ __forceinline__ int lds_byte(int r, int c) { const int st = (r >> 4) * 2 + (c >> 5), rr = r & 15, cc = c & 31, ob = rr * 64 + cc * 2; return st * 1024 + (ob ^ (((ob >> 9) & 1) << 5)); }
__device__ __forceinline__ void stage_rc(int b, int& R, int& C) { const int st = b / 1024, sb = b % 1024, swz = sb ^ (((sb >> 9) & 1) << 5); R = (st >> 1) * 16 + swz / 64; C = (st & 1) * 32 + (swz % 64) / 2; }
__device__ __forceinline__ int perm32(int rho) { const int n = rho >> 4, i = rho & 15; return 8 * (i >> 2) + 4 * n + (i & 3); }
struct Unit { int pm, pn; };
struct StaticOrder {
  int nM, nN, nwg, G, c;
  __device__ void init(int M, int N, int G_, int c_) { nM = M / G8_BM; nN = N / G8_BM; nwg = nM * nN; G = G_; c = c_; }
  __device__ bool next(int i, Unit& u) const {
    const long L = (long)i * G + c; if (L >= nwg) return false;
    int wgid = (int)L; { const int q = nwg / G8_NXCD, r = nwg % G8_NXCD, xcd = wgid % G8_NXCD, off = wgid / G8_NXCD; wgid = (xcd < r ? xcd * (q + 1) : r * (q + 1) + (xcd - r) * q) + off; }
    const int nig = G8_WGM * nN, gid = wgid / nig, fm = gid * G8_WGM, gsz = (nM - fm) < G8_WGM ? (nM - fm) : G8_WGM;
    u.pm = fm + ((wgid % nig) % gsz); u.pn = (wgid % nig) / gsz; return true;
  }
};

__device__ __forceinline__ float rstd_row(const float* ssq, size_t row) {
  const float4* q = (const float4*)(ssq + row * 16);
  float4 a = q[0], b = q[1], c = q[2], d = q[3];
  float s = ((a.x + a.y) + (a.z + a.w)) + ((b.x + b.y) + (b.z + b.w)) + ((c.x + c.y) + (c.z + c.w)) + ((d.x + d.y) + (d.z + d.w));
  return rsqrtf(s * (1.f / 1024.f) + EPS);
}
template <class Epi>
__device__ __forceinline__ void gemm8(const bf16_t* gA, const bf16_t* gBt, int M, int N, int K, const Epi& E, int coff = 0) {
  LAS unsigned char* lds = (LAS unsigned char*)smem;
  StaticOrder S; S.init(M, N, (int)gridDim.x, (int)((blockIdx.x + coff) % gridDim.x));
  const int tid = threadIdx.x, wid = __builtin_amdgcn_readfirstlane(tid >> 6), lane = tid & 63, wr = wid >> 2, wc = wid & 3, fr = lane & 15, fq = lane >> 4;
  const int nt = K / G8_BK;
  unsigned voffA[2], voffB[2];
#pragma unroll
  for (int i = 0; i < 2; ++i) { int R, C; stage_rc(tid * 16 + i * 8192, R, C); const int Rb = Epi::PERM ? ((R & ~31) + perm32(R & 31)) : R;
    voffA[i] = (unsigned)(R * K + C) * 2u; voffB[i] = (unsigned)(Rb * K + C) * 2u; }
  const size_t kstep = (size_t)(G8_BK * 2);
  const size_t hstep = (size_t)G8_HALF * K * 2;
  const size_t tstep = 2 * hstep;
  const unsigned ldsw = (unsigned)wid * 1024u;
  const int aoff = lds_byte(wr * 64 + fr, fq * 8), boff = lds_byte(wc * 32 + fr, fq * 8);
#define PG8_SA(b, h) (((b) * 2 + (h)) * G8_HTB)
#define PG8_SB(b, h) ((4 + (b) * 2 + (h)) * G8_HTB)
#define PG8_STAGE(bufoff, gbase, voff) do { _Pragma("unroll") for (int _i = 0; _i < 2; ++_i) \
    __builtin_amdgcn_global_load_lds((const unsigned*)((const char*)(gbase) + (voff)[_i]), (LAS unsigned*)(lds + (bufoff) + ldsw + _i * 8192), 16, 0, 0); } while (0)
#define PG8_LDA(dst, b, h) do { _Pragma("unroll") for (int m = 0; m < 4; ++m) _Pragma("unroll") for (int k = 0; k < 2; ++k) dst[m][k] = *(const LAS bf16x8*)(lds + PG8_SA(b, h) + aoff + m * 2048 + k * 1024); } while (0)
#define PG8_LDB(dst, b, h) do { _Pragma("unroll") for (int n = 0; n < 2; ++n) _Pragma("unroll") for (int k = 0; k < 2; ++k) dst[n][k] = *(const LAS bf16x8*)(lds + PG8_SB(b, h) + boff + n * 2048 + k * 1024); } while (0)
#define PG8_MMA(ai, bj, At, Bt) do { __builtin_amdgcn_s_setprio(1); _Pragma("unroll") for (int m = 0; m < 4; ++m) _Pragma("unroll") for (int n = 0; n < 2; ++n) _Pragma("unroll") for (int k = 0; k < 2; ++k) \
    acc[ai][bj][m][n] = __builtin_amdgcn_mfma_f32_16x16x32_bf16(Bt[n][k], At[m][k], acc[ai][bj][m][n], 0, 0, 0); __builtin_amdgcn_s_setprio(0); } while (0)
#define PG8_WAIT_V(n) asm volatile("s_waitcnt vmcnt(" #n ")" ::: "memory")
#define PG8_WAIT_L(n) asm volatile("s_waitcnt lgkmcnt(" #n ")" ::: "memory")
#define PG8_BAR __builtin_amdgcn_s_barrier()
#define PG8_SCHED __builtin_amdgcn_sched_barrier(0)
  Unit cur, nxt; int ui = 0;
  if (E.ssq != nullptr) {
    float* sRs = (float*)(smem + 132096);
    Unit uu;
    for (int i = 0; S.next(i, uu); ++i)
      if (tid < 256) sRs[i * 256 + tid] = rstd_row(E.ssq, (size_t)uu.pm * 256 + tid);
    __syncthreads();
  }
  if (!S.next(0, cur)) return;
  f32x4 acc[2][2][4][2];
#pragma unroll
  for (int a = 0; a < 2; ++a)
#pragma unroll
    for (int b = 0; b < 2; ++b)
#pragma unroll
      for (int m = 0; m < 4; ++m)
#pragma unroll
        for (int n = 0; n < 2; ++n) acc[a][b][m][n] = (f32x4){0.f, 0.f, 0.f, 0.f};
  bf16x8 At[4][2], B0[2][2], B1[2][2];
  const char* cA = (const char*)gA + (size_t)cur.pm * tstep; const char* cB = (const char*)gBt + (size_t)cur.pn * tstep;
  PG8_STAGE(PG8_SB(0, 0), cB, voffB); PG8_STAGE(PG8_SA(0, 0), cA, voffA); PG8_STAGE(PG8_SB(0, 1), cB + hstep, voffB); PG8_STAGE(PG8_SA(0, 1), cA + hstep, voffA);
  if (wr == 1) PG8_BAR;
  PG8_WAIT_V(4); PG8_BAR;
  PG8_STAGE(PG8_SB(1, 0), cB + kstep, voffB); PG8_STAGE(PG8_SA(1, 0), cA + kstep, voffA); PG8_STAGE(PG8_SB(1, 1), cB + hstep + kstep, voffB);
  PG8_WAIT_V(6); PG8_BAR;
  for (;;) {
    const bool has_next = S.next(ui + 1, nxt);
    const char* nA = has_next ? (const char*)gA + (size_t)nxt.pm * tstep : cA; const char* nB = has_next ? (const char*)gBt + (size_t)nxt.pn * tstep : cB;
    for (int t = 0; t < nt; t += 2) {
      const bool last = (t == nt - 2);
      const char* a1 = cA + (size_t)(t + 1) * kstep;
      const char* a2 = last ? nA : cA + (size_t)(t + 2) * kstep; const char* b2 = last ? nB : cB + (size_t)(t + 2) * kstep;
      const char* a3 = a2 + kstep; const char* b3 = b2 + kstep;
      PG8_LDB(B0, 0, 0); PG8_SCHED; PG8_LDA(At, 0, 0); PG8_STAGE(PG8_SA(1, 1), a1 + hstep, voffA);
      PG8_WAIT_L(8); PG8_BAR; PG8_WAIT_L(0); PG8_MMA(0, 0, At, B0); PG8_BAR; PG8_SCHED;
      PG8_LDB(B1, 0, 1); PG8_STAGE(PG8_SB(0, 0), b2, voffB);
      PG8_BAR; PG8_WAIT_L(0); PG8_MMA(0, 1, At, B1); PG8_BAR;
      PG8_LDA(At, 0, 1); PG8_STAGE(PG8_SA(0, 0), a2, voffA);
      PG8_BAR; PG8_WAIT_L(0); PG8_MMA(1, 0, At, B0); PG8_BAR; PG8_SCHED;
      PG8_STAGE(PG8_SB(0, 1), b2 + hstep, voffB);
      PG8_WAIT_V(6); PG8_BAR; PG8_MMA(1, 1, At, B1); PG8_BAR;
      PG8_LDB(B0, 1, 0); PG8_SCHED; PG8_LDA(At, 1, 0); PG8_STAGE(PG8_SA(0, 1), a2 + hstep, voffA);
      PG8_WAIT_L(8); PG8_BAR; PG8_WAIT_L(0); PG8_MMA(0, 0, At, B0); PG8_BAR; PG8_SCHED;
      PG8_LDB(B1, 1, 1); PG8_STAGE(PG8_SB(1, 0), b3, voffB);
      PG8_BAR; PG8_WAIT_L(0); PG8_MMA(0, 1, At, B1); PG8_BAR;
      PG8_LDA(At, 1, 1); PG8_STAGE(PG8_SA(1, 0), a3, voffA);
      PG8_BAR; PG8_WAIT_L(0); PG8_MMA(1, 0, At, B0); PG8_BAR; PG8_SCHED;
      PG8_STAGE(PG8_SB(1, 1), b3 + hstep, voffB);
      PG8_WAIT_V(6); PG8_BAR; PG8_MMA(1, 1, At, B1); PG8_BAR;
    }
    E(acc, cur, ui, wr, wc, fr, fq);
    if (!has_next) break;
#pragma unroll
    for (int a = 0; a < 2; ++a)
#pragma unroll
      for (int b = 0; b < 2; ++b)
#pragma unroll
        for (int m = 0; m < 4; ++m)
#pragma unroll
          for (int n = 0; n < 2; ++n) acc[a][b][m][n] = (f32x4){0.f, 0.f, 0.f, 0.f};
    cur = nxt; cA = nA; cB = nB; ++ui;
  }
  PG8_WAIT_V(0);
  if (wr == 0) PG8_BAR;
  PG8_BAR;
#undef PG8_SA
#undef PG8_SB
#undef PG8_STAGE
#undef PG8_LDA
#undef PG8_LDB
#undef PG8_MMA
#undef PG8_WAIT_V
#undef PG8_WAIT_L
#undef PG8_BAR
#undef PG8_SCHED
}

typedef f32x4 Acc8[2][2][4][2];
__device__ __forceinline__ float sumq4(float v) {
  v += __shfl_xor(v, 16); v += __shfl_xor(v, 32);
  return v;
}
__device__ __forceinline__ void rstd8(int ui, int wr, int fr, float (&rs)[2][4]) {
  const float* sRs = (const float*)(smem + 132096) + ui * 256 + wr * 64 + fr;
#pragma unroll
  for (int ai = 0; ai < 2; ++ai)
#pragma unroll
    for (int m = 0; m < 4; ++m) rs[ai][m] = sRs[ai * 128 + m * 16];
}
__device__ __forceinline__ uint4 pack8(f32x4 a, f32x4 b) {
  uint4 o; o.x = pack2(a[0], a[1]); o.y = pack2(a[2], a[3]); o.z = pack2(b[0], b[1]); o.w = pack2(b[2], b[3]); return o;
}
__device__ __forceinline__ void epi8_swiglu(const Acc8& acc, const Unit& u, int ui, int wr, int wc, int fr, int fq, const float* ssq, bf16_t* H) {
  float rs8[2][4];
  rstd8(ui, wr, fr, rs8);
#pragma unroll
  for (int ai = 0; ai < 2; ++ai)
#pragma unroll
    for (int m = 0; m < 4; ++m) {
      const size_t row = (size_t)u.pm * 256 + ai * 128 + wr * 64 + m * 16 + fr;
      const float rs = rs8[ai][m];
      f32x4 h0, h1;
#pragma unroll
      for (int jj = 0; jj < 4; ++jj) {
        float g0 = acc[ai][0][m][0][jj] * rs, u0 = acc[ai][1][m][0][jj] * rs, g1 = acc[ai][0][m][1][jj] * rs, u1 = acc[ai][1][m][1][jj] * rs;
        h0[jj] = g0 * __builtin_amdgcn_rcpf(1.f + __expf(-g0)) * u0;
        h1[jj] = g1 * __builtin_amdgcn_rcpf(1.f + __expf(-g1)) * u1;
      }
      { typedef unsigned u32x4_t __attribute__((ext_vector_type(4))); const uint4 hv = pack8(h0, h1); u32x4_t hv4 = {hv.x, hv.y, hv.z, hv.w};
        __builtin_nontemporal_store(hv4, (u32x4_t*)(H + row * 2816 + u.pn * 128 + wc * 32 + fq * 8)); }
    }
}
__device__ __forceinline__ void epi8_plain(const Acc8& acc, const Unit& u, int ui, int wr, int wc, int fr, int fq, const float* ssq, bf16_t* dst, int ld, int col0) {
  float rs8[2][4];
  rstd8(ui, wr, fr, rs8);
#pragma unroll
  for (int ai = 0; ai < 2; ++ai)
#pragma unroll
    for (int m = 0; m < 4; ++m) {
      const size_t row = (size_t)u.pm * 256 + ai * 128 + wr * 64 + m * 16 + fr;
      const float rs = rs8[ai][m];
#pragma unroll
      for (int bj = 0; bj < 2; ++bj)
        *(uint4*)(dst + row * ld + col0 + bj * 128 + wc * 32 + fq * 8) = pack8(acc[ai][bj][m][0] * rs, acc[ai][bj][m][1] * rs);
    }
}
__device__ __forceinline__ void epi8_headnorm(const Acc8& acc, const Unit& u, int ui, int wr, int wc, int fr, int fq, const float* ssq, const float* gain,
                                              float scale, bf16_t* dst, int ld, int colbase) {
  f32x4 gn[2][2];
#pragma unroll
  for (int bj = 0; bj < 2; ++bj)
#pragma unroll
    for (int n = 0; n < 2; ++n) gn[bj][n] = *(const f32x4*)(gain + bj * 32 + fq * 8 + n * 4) * scale;
  VMWAIT();
  float rs8[2][4];
  rstd8(ui, wr, fr, rs8);
#pragma unroll
  for (int ai = 0; ai < 2; ++ai)
#pragma unroll
    for (int m = 0; m < 4; ++m) {
      const size_t row = (size_t)u.pm * 256 + ai * 128 + wr * 64 + m * 16 + fr;
      const float rs = rs8[ai][m];
      float ss = 0.f;
#pragma unroll
      for (int bj = 0; bj < 2; ++bj)
#pragma unroll
        for (int n = 0; n < 2; ++n) {
          const f32x4 a = acc[ai][bj][m][n];
          ss += a[0] * a[0] + a[1] * a[1] + a[2] * a[2] + a[3] * a[3];
        }
      ss = sumq4(ss) * rs * rs;
      const float r2 = rsqrtf(ss * (1.f / 64.f) + EPS) * rs;
#pragma unroll
      for (int bj = 0; bj < 2; ++bj)
        *(uint4*)(dst + row * ld + colbase + wc * 64 + bj * 32 + fq * 8) = pack8(acc[ai][bj][m][0] * r2 * gn[bj][0], acc[ai][bj][m][1] * r2 * gn[bj][1]);
    }
}

struct Epi8Swiglu {
  static constexpr bool PERM = true;
  const float* ssq; bf16_t* H;
  __device__ __forceinline__ void operator()(const Acc8& acc, const Unit& u, int ui, int wr, int wc, int fr, int fq) const { epi8_swiglu(acc, u, ui, wr, wc, fr, fq, ssq, H); }
};
struct Epi8Resid {
  static constexpr bool PERM = false;
  static constexpr const float* ssq = nullptr;
  const float* xin; float* xout; bf16_t* xb; float* ssqo; float scale;
  __device__ __forceinline__ void operator()(const Acc8& acc, const Unit& u, int ui, int wr, int wc, int fr, int fq) const {
#pragma unroll
    for (int ai = 0; ai < 2; ++ai)
#pragma unroll
      for (int mh = 0; mh < 2; ++mh) {
        f32x4 xv[2][2][2];
#pragma unroll
        for (int m2 = 0; m2 < 2; ++m2)
#pragma unroll
          for (int bj = 0; bj < 2; ++bj)
#pragma unroll
            for (int n = 0; n < 2; ++n)
              xv[m2][bj][n] = *(const f32x4*)(xin + ((size_t)u.pm * 256 + ai * 128 + wr * 64 + (mh * 2 + m2) * 16 + fr) * 1024 + u.pn * 256 + bj * 128 + wc * 32 + n * 16 + fq * 4);
        VMWAIT();
#pragma unroll
        for (int m2 = 0; m2 < 2; ++m2) {
          const int m = mh * 2 + m2;
          const size_t row = (size_t)u.pm * 256 + ai * 128 + wr * 64 + m * 16 + fr;
          float ss = 0.f;
#pragma unroll
          for (int bj = 0; bj < 2; ++bj)
#pragma unroll
            for (int n = 0; n < 2; ++n) {
              const size_t idx = row * 1024 + u.pn * 256 + bj * 128 + wc * 32 + n * 16 + fq * 4;
              f32x4 v = xv[m2][bj][n] + acc[ai][bj][m][n] * scale;
              __builtin_nontemporal_store(v, (f32x4*)(xout + idx));
              if (xb != nullptr) { uint2 o; o.x = pack2(v[0], v[1]); o.y = pack2(v[2], v[3]); *(uint2*)(xb + idx) = o; }
              ss += v[0] * v[0] + v[1] * v[1] + v[2] * v[2] + v[3] * v[3];
            }
          ss = sumq4(ss);
          if (fq == 0 && xb != nullptr) ssqo[row * 16 + u.pn * 4 + wc] = ss;
        }
      }
  }
};
struct Epi8InProj {
  static constexpr bool PERM = true;
  const float* ssq; bf16_t* Pbase; bf16_t* Cat; float* G; const float* mq_gain; const float* gate_bias;
  __device__ __forceinline__ void operator()(const Acc8& acc, const Unit& u, int ui, int wr, int wc, int fr, int fq) const {
    if (u.pn < 12) {
      const int arr = u.pn / 3, c0 = (u.pn - arr * 3) * 256;
      epi8_plain(acc, u, ui, wr, wc, fr, fq, ssq, Pbase + (size_t)arr * kT * 768, 768, c0);
    } else if (u.pn == 12) {
      epi8_headnorm(acc, u, ui, wr, wc, fr, fq, ssq, mq_gain, 0.125f, Cat, 1024, 768);
    } else if (wc == 0) {
      float rs8[2][4];
      rstd8(ui, wr, fr, rs8);
      if (fq == 0) {
#pragma unroll
        for (int ai = 0; ai < 2; ++ai)
#pragma unroll
          for (int m = 0; m < 4; ++m) {
            const size_t row = (size_t)u.pm * 256 + ai * 128 + wr * 64 + m * 16 + fr;
            *(f32x4*)(G + row * 8) = acc[ai][0][m][0] * rs8[ai][m];
            *(f32x4*)(G + row * 8 + 4) = acc[ai][0][m][1] * rs8[ai][m];
          }
      }
    }
  }
};
struct Epi8KvFfn {
  static constexpr bool PERM = true;
  const float* ssq; bf16_t* H; bf16_t* Ksh; bf16_t* Vtmp; const float* kgain;
  __device__ __forceinline__ void operator()(const Acc8& acc, const Unit& u, int ui, int wr, int wc, int fr, int fq) const {
    if (u.pn < 22) epi8_swiglu(acc, u, ui, wr, wc, fr, fq, ssq, H);
    else if (u.pn < 25) epi8_headnorm(acc, u, ui, wr, wc, fr, fq, ssq, kgain, 1.f, Ksh, 768, (u.pn - 22) * 256);
    else epi8_plain(acc, u, ui, wr, wc, fr, fq, ssq, Vtmp, 768, (u.pn - 25) * 256);
  }
};
struct Epi8QProj {
  static constexpr bool PERM = true;
  const float* ssq; bf16_t* Cat; const float* qgain; const float* mqgain;
  __device__ __forceinline__ void operator()(const Acc8& acc, const Unit& u, int ui, int wr, int wc, int fr, int fq) const {
    epi8_headnorm(acc, u, ui, wr, wc, fr, fq, ssq, (u.pn < 3) ? qgain : mqgain, 0.125f, Cat, 1024, u.pn * 256);
  }
};
struct Epi8MemKv {
  static constexpr bool PERM = true;
  const float* ssq; bf16_t* Kmem; bf16_t* Vtok; const float* kgain;
  __device__ __forceinline__ void operator()(const Acc8& acc, const Unit& u, int ui, int wr, int wc, int fr, int fq) const {
    if (u.pn == 0) epi8_headnorm(acc, u, ui, wr, wc, fr, fq, ssq, kgain, 1.f, Kmem, 256, 0);
    else epi8_plain(acc, u, ui, wr, wc, fr, fq, ssq, Vtok, 256, 0);
  }
};
__device__ __forceinline__ void memv_transpose(const bf16_t* Vtok, bf16_t* VmT) {
  for (int i = blockIdx.x * NTHR + threadIdx.x; i < 2 * 512 * 256; i += gridDim.x * NTHR) {
    const int mm = i & 255, e = (i >> 8) & 255, lb = i >> 16;
    VmT[i] = Vtok[((size_t)lb * 256 + mm) * 256 + e];
  }
}

__device__ __forceinline__ void phase_vtranspose(const bf16_t* Vtmp, bf16_t* VshT) {
  bf16_t* sT = (bf16_t*)smem;
  const int tid = threadIdx.x;
  for (int item = blockIdx.x; item < 256 * 12; item += gridDim.x) {
    const int head = item % 12, tt = item / 12, tokbase = tt * 128, b = tokbase / kS, pos0 = tokbase - b * kS;
    const int g = head >> 2, d = 1 << (2 * g);
    __syncthreads();
    for (int it = tid; it < 128 * 8; it += NTHR) {
      const int t = it >> 3, e8 = (it & 7) * 8;
      uint4 v = *(const uint4*)(Vtmp + (size_t)(tokbase + t) * 768 + head * 64 + e8);
      sT[(e8 + 0) * 136 + t] = (bf16_t)(v.x & 0xffff); sT[(e8 + 1) * 136 + t] = (bf16_t)(v.x >> 16);
      sT[(e8 + 2) * 136 + t] = (bf16_t)(v.y & 0xffff); sT[(e8 + 3) * 136 + t] = (bf16_t)(v.y >> 16);
      sT[(e8 + 4) * 136 + t] = (bf16_t)(v.z & 0xffff); sT[(e8 + 5) * 136 + t] = (bf16_t)(v.z >> 16);
      sT[(e8 + 6) * 136 + t] = (bf16_t)(v.w & 0xffff); sT[(e8 + 7) * 136 + t] = (bf16_t)(v.w >> 16);
    }
    __syncthreads();
    for (int pc = tid; pc < 64 * 16; pc += NTHR) {
      const int e = pc >> 4, piece = pc & 15;
      const int rr = (g == 0) ? 0 : (g == 1) ? (piece >> 2) : piece;
      const int s8 = (g == 0) ? piece : (g == 1) ? (piece & 3) : 0;
      const bf16_t* src = sT + e * 136 + rr;
      uint4 o;
      o.x = (uint32_t)src[(s8 * 8 + 0) * d] | ((uint32_t)src[(s8 * 8 + 1) * d] << 16);
      o.y = (uint32_t)src[(s8 * 8 + 2) * d] | ((uint32_t)src[(s8 * 8 + 3) * d] << 16);
      o.z = (uint32_t)src[(s8 * 8 + 4) * d] | ((uint32_t)src[(s8 * 8 + 5) * d] << 16);
      o.w = (uint32_t)src[(s8 * 8 + 6) * d] | ((uint32_t)src[(s8 * 8 + 7) * d] << 16);
      *(uint4*)(VshT + ((size_t)(b * 12 + head) * 64 + e) * kS + rr * (kS / d) + pos0 / d + s8 * 8) = o;
    }
  }
}

__device__ __forceinline__ bf16x8 u4_to_frag(uint4 v) { return __builtin_bit_cast(bf16x8, v); }
__device__ __forceinline__ uint4 mul_bf16x8(uint4 a, uint4 b) {
  uint4 o;
  o.x = pack2(bflo(a.x) * bflo(b.x), bfhi(a.x) * bfhi(b.x));
  o.y = pack2(bflo(a.y) * bflo(b.y), bfhi(a.y) * bfhi(b.y));
  o.z = pack2(bflo(a.z) * bflo(b.z), bfhi(a.z) * bfhi(b.z));
  o.w = pack2(bflo(a.w) * bflo(b.w), bfhi(a.w) * bfhi(b.w));
  return o;
}

__device__ __forceinline__ void phase_prep(const Params& P) {
  const bf16_t* Pk = (const bf16_t*)(P.ws + OFF_R1) + (size_t)kT * 768;
  const bf16_t* Pv = Pk + (size_t)kT * 768;
  bf16_t* kc = (bf16_t*)(P.ws + OFF_XB);
  bf16_t* kTt = (bf16_t*)(P.ws + OFF_R2);
  bf16_t* VT = kTt + (size_t)kT * 768;
  const float* G = (const float*)(P.ws + OFF_G);
  float* uArr = (float*)(P.ws + OFF_U);
  float* bArr = (float*)(P.ws + OFF_BC);
  bf16_t* eW = (bf16_t*)(P.ws + OFF_EW);
  float* umaxA = (float*)(P.ws + OFF_UMAX);
  float* blA = (float*)(P.ws + OFF_BL);
  bf16_t* sX = (bf16_t*)smem;
  float* sF = (float*)(smem + 51200);
  const int tid = threadIdx.x;
  const float kscale = 0.07216878364870322f;
  for (int item = blockIdx.x; item < 1024; item += gridDim.x) {
    const int bh = item >> 7, c = item & 127, b = bh >> 2, h = bh & 3;
    const size_t tok0 = (size_t)b * kS + (size_t)c * 128;
    __syncthreads();
    float ig = 0.f;
    if (tid < 128) {
      ig = G[(tok0 + tid) * 8 + h] + P.a_gate_bias[h];
      float fg = G[(tok0 + tid) * 8 + 4 + h] + P.a_gate_bias[4 + h];
      sF[tid] = fminf(fg, 0.f) - log1pf(__expf(-fabsf(fg)));
    }
    __syncthreads();
    float bt = 0.f;
    if (tid < 128) for (int s2 = 0; s2 <= tid; ++s2) bt += sF[s2];
    const float ut = ig - bt;
    __syncthreads();
    if (tid < 128) sF[tid] = ut;
    __syncthreads();
    float um = -3.0e38f;
    for (int s2 = 0; s2 < 128; ++s2) um = fmaxf(um, sF[s2]);
    if (tid < 128) {
      uArr[(size_t)item * 128 + tid] = ut;
      bArr[(size_t)item * 128 + tid] = bt;
      eW[(size_t)item * 128 + tid] = f2bf(__expf(ut - um));
      if (tid == 127) blA[item] = bt;
      if (tid == 0) umaxA[item] = um;
    }
    for (int it = tid; it < 128 * 24; it += NTHR) {
      const int t = it / 24, ch = (it - t * 24) * 8;
      const int spos = c * 128 + t;
      const bf16_t* src = Pk + (tok0 + t) * 768 + h * 192 + ch;
      uint4 xv[4];
      float4 w0[4], w1[4];
#pragma unroll
      for (int j = 0; j < 4; ++j) {
        xv[j] = make_uint4(0u, 0u, 0u, 0u);
        if (spos - 3 + j >= 0) xv[j] = *(const uint4*)(src - (ptrdiff_t)(3 - j) * 768);
        const float4* wp = (const float4*)(P.a_conv + j * 1536 + 768 + h * 192 + ch);
        w0[j] = wp[0]; w1[j] = wp[1];
      }
      VMWAIT();
      float a[8] = {0.f, 0.f, 0.f, 0.f, 0.f, 0.f, 0.f, 0.f};
#pragma unroll
      for (int j = 0; j < 4; ++j) {
        a[0] += w0[j].x * bflo(xv[j].x); a[1] += w0[j].y * bfhi(xv[j].x); a[2] += w0[j].z * bflo(xv[j].y); a[3] += w0[j].w * bfhi(xv[j].y);
        a[4] += w1[j].x * bflo(xv[j].z); a[5] += w1[j].y * bfhi(xv[j].z); a[6] += w1[j].z * bflo(xv[j].w); a[7] += w1[j].w * bfhi(xv[j].w);
      }
#pragma unroll
      for (int e = 0; e < 8; ++e) a[e] = a[e] / (1.f + __expf(-a[e])) * kscale;
      uint4 o; o.x = pack2(a[0], a[1]); o.y = pack2(a[2], a[3]); o.z = pack2(a[4], a[5]); o.w = pack2(a[6], a[7]);
      *(uint4*)(kc + (tok0 + t) * 768 + h * 192 + ch) = o;
      *(uint4*)(sX + t * 200 + ch) = o;
    }
    __syncthreads();
    for (int it = tid; it < 192 * 16; it += NTHR) {
      const int k = it >> 4, lg = it & 15;
      uint4 o;
      o.x = (uint32_t)sX[(lg * 8 + 0) * 200 + k] | ((uint32_t)sX[(lg * 8 + 1) * 200 + k] << 16);
      o.y = (uint32_t)sX[(lg * 8 + 2) * 200 + k] | ((uint32_t)sX[(lg * 8 + 3) * 200 + k] << 16);
      o.z = (uint32_t)sX[(lg * 8 + 4) * 200 + k] | ((uint32_t)sX[(lg * 8 + 5) * 200 + k] << 16);
      o.w = (uint32_t)sX[(lg * 8 + 6) * 200 + k] | ((uint32_t)sX[(lg * 8 + 7) * 200 + k] << 16);
      *(uint4*)(kTt + ((size_t)item * 192 + k) * 128 + lg * 8) = o;
    }
    __syncthreads();
    for (int it = tid; it < 128 * 24; it += NTHR) {
      const int t = it / 24, ch = (it - t * 24) * 8;
      uint4 v = *(const uint4*)(Pv + (tok0 + t) * 768 + h * 192 + ch);
      *(uint4*)(sX + t * 200 + ch) = v;
    }
    __syncthreads();
    for (int it = tid; it < 192 * 16; it += NTHR) {
      const int k = it >> 4, lg = it & 15;
      uint4 o;
      o.x = (uint32_t)sX[(lg * 8 + 0) * 200 + k] | ((uint32_t)sX[(lg * 8 + 1) * 200 + k] << 16);
      o.y = (uint32_t)sX[(lg * 8 + 2) * 200 + k] | ((uint32_t)sX[(lg * 8 + 3) * 200 + k] << 16);
      o.z = (uint32_t)sX[(lg * 8 + 4) * 200 + k] | ((uint32_t)sX[(lg * 8 + 5) * 200 + k] << 16);
      o.w = (uint32_t)sX[(lg * 8 + 6) * 200 + k] | ((uint32_t)sX[(lg * 8 + 7) * 200 + k] << 16);
      *(uint4*)(VT + ((size_t)item * 192 + k) * 128 + lg * 8) = o;
    }
  }
}

__device__ __forceinline__ void phase_scan(const Params& P) {
  const bf16_t* kTt = (const bf16_t*)(P.ws + OFF_R2);
  const bf16_t* VT = kTt + (size_t)kT * 768;
  const bf16_t* eW = (const bf16_t*)(P.ws + OFF_EW);
  const float* umaxA = (const float*)(P.ws + OFF_UMAX);
  const float* blA = (const float*)(P.ws + OFF_BL);
  float* m0A = (float*)(P.ws + OFF_M0);
  bf16_t* C0T = (bf16_t*)(P.ws + OFF_R1) + (size_t)kT * 768;
  const int lane = threadIdx.x & 63, wid = threadIdx.x >> 6, nw = gridDim.x * NWAVE;
  const int r = lane & 15, q = lane >> 4;
  for (int unit = wid * gridDim.x + blockIdx.x; unit < 416; unit += nw) {
    const int bh = unit / 52, rem = unit - bh * 52, mv = rem >> 2, nk = rem & 3;
    const bf16_t* vt_base = VT + ((size_t)bh * 128 * 192 + (mv < 12 ? mv : 0) * 16 + r) * 128 + q * 8;
    const bf16_t* kt_base = kTt + ((size_t)bh * 128 * 192 + nk * 48 + r) * 128 + q * 8;
    const bf16_t* ew_base = eW + (size_t)bh * 128 * 128 + q * 8;
    bf16_t* c0_base = C0T + ((size_t)bh * 128 * 208 + mv * 16 + q * 4) * 192 + nk * 48 + r;
    f32x4 acc[3];
#pragma unroll
    for (int n = 0; n < 3; ++n) acc[n] = (f32x4){0.f, 0.f, 0.f, 0.f};
    float m = 0.f;
    uint4 A[4], B[3][4], E[4];
    float bl, um;
#define SCAN_LOAD(A_, B_, E_, bl_, um_, cc)                                                            \
  do {                                                                                                 \
    _Pragma("unroll") for (int ks = 0; ks < 4; ++ks) {                                                 \
      A_[ks] = *(const uint4*)(vt_base + (size_t)(cc) * 192 * 128 + ks * 32);                          \
      E_[ks] = *(const uint4*)(ew_base + (size_t)(cc) * 128 + ks * 32);                                \
      _Pragma("unroll") for (int n = 0; n < 3; ++n)                                                    \
        B_[n][ks] = *(const uint4*)(kt_base + (size_t)(cc) * 192 * 128 + (size_t)n * 16 * 128 + ks * 32); \
    }                                                                                                  \
    bl_ = blA[bh * 128 + (cc)]; um_ = umaxA[bh * 128 + (cc)];                                          \
  } while (0)
    SCAN_LOAD(A, B, E, bl, um, 0);
    VMWAIT();
    for (int c = 0; c < 128; ++c) {
#pragma unroll
      for (int n = 0; n < 3; ++n)
#pragma unroll
        for (int j = 0; j < 4; ++j) c0_base[(size_t)c * 208 * 192 + j * 192 + n * 16] = f2bf(acc[n][j]);
      if (rem == 0 && lane == 0) m0A[bh * 128 + c] = m;
      uint4 nA[4], nB[3][4], nE[4];
      float nbl = 0.f, num = 0.f;
      const int cn = (c + 1 < 128) ? c + 1 : c;
      SCAN_LOAD(nA, nB, nE, nbl, num, cn);
      const float mn = fmaxf(bl + m, bl + um);
      const float decay = __expf(bl + m - mn), sc = __expf(um + bl - mn);
      m = mn;
      f32x4 U[3];
#pragma unroll
      for (int n = 0; n < 3; ++n) U[n] = (f32x4){0.f, 0.f, 0.f, 0.f};
#pragma unroll
      for (int ks = 0; ks < 4; ++ks) {
        uint4 af;
        if (mv < 12) af = mul_bf16x8(A[ks], E[ks]);
        else af = (r == 0) ? E[ks] : make_uint4(0u, 0u, 0u, 0u);
#pragma unroll
        for (int n = 0; n < 3; ++n)
          U[n] = __builtin_amdgcn_mfma_f32_16x16x32_bf16(u4_to_frag(af), u4_to_frag(B[n][ks]), U[n], 0, 0, 0);
      }
#pragma unroll
      for (int n = 0; n < 3; ++n)
#pragma unroll
        for (int j = 0; j < 4; ++j) acc[n][j] = acc[n][j] * decay + sc * U[n][j];
      VMWAIT();
#pragma unroll
      for (int ks = 0; ks < 4; ++ks) {
        A[ks] = nA[ks]; E[ks] = nE[ks];
#pragma unroll
        for (int n = 0; n < 3; ++n) B[n][ks] = nB[n][ks];
      }
      bl = nbl; um = num;
    }
#undef SCAN_LOAD
  }
}

__device__ __forceinline__ void phase_chunk(const Params& P) {
  const bf16_t* Pq = (const bf16_t*)(P.ws + OFF_R1);
  const bf16_t* Po = Pq + (size_t)3 * kT * 768;
  const bf16_t* C0T = Pq + (size_t)kT * 768;
  const bf16_t* kc = (const bf16_t*)(P.ws + OFF_XB);
  const bf16_t* VT = (const bf16_t*)(P.ws + OFF_R2) + (size_t)kT * 768;
  const float* uArr = (const float*)(P.ws + OFF_U);
  const float* bArr = (const float*)(P.ws + OFF_BC);
  const float* m0A = (const float*)(P.ws + OFF_M0);
  bf16_t* Cat = (bf16_t*)(P.ws + OFF_CAT);
  bf16_t* sQ = (bf16_t*)smem;
  float* sU = (float*)(smem + 51200);
  float* sMx = (float*)(smem + 51712);
  float* sBt = (float*)(smem + 52224);
  float* sCw = (float*)(smem + 52736);
  const int tid = threadIdx.x, lane = tid & 63, wid = tid >> 6, r = lane & 15, q = lane >> 4;
  bf16_t* sWw = (bf16_t*)(smem + 55808) + wid * (16 * 136);
  for (int item = blockIdx.x; item < 1024; item += gridDim.x) {
    const int bh = item >> 7, c = item & 127, b = bh >> 2, h = bh & 3;
    const size_t tok0 = (size_t)b * kS + (size_t)c * 128;
    __syncthreads();
    for (int i = tid; i < 768; i += NTHR) { int j = i / 192, ch = i - j * 192; sCw[i] = P.a_conv[j * 1536 + h * 192 + ch]; }
    if (tid < 128) { sU[tid] = uArr[(size_t)item * 128 + tid]; sBt[tid] = bArr[(size_t)item * 128 + tid]; }
    const float m0 = m0A[item];
    __syncthreads();
    if (tid < 128) {
      float mx = m0;
      for (int s2 = 0; s2 <= tid; ++s2) mx = fmaxf(mx, sU[s2]);
      sMx[tid] = mx;
    }
    for (int it = tid; it < 128 * 24; it += NTHR) {
      const int t = it / 24, ch = (it - t * 24) * 8;
      const int spos = c * 128 + t;
      const bf16_t* src = Pq + (tok0 + t) * 768 + h * 192 + ch;
      float a[8] = {0.f, 0.f, 0.f, 0.f, 0.f, 0.f, 0.f, 0.f};
#pragma unroll
      for (int j = 0; j < 4; ++j) {
        uint4 xv = make_uint4(0u, 0u, 0u, 0u);
        if (spos - 3 + j >= 0) xv = *(const uint4*)(src - (ptrdiff_t)(3 - j) * 768);
        const float* w = sCw + j * 192 + ch;
        a[0] += w[0] * bflo(xv.x); a[1] += w[1] * bfhi(xv.x); a[2] += w[2] * bflo(xv.y); a[3] += w[3] * bfhi(xv.y);
        a[4] += w[4] * bflo(xv.z); a[5] += w[5] * bfhi(xv.z); a[6] += w[6] * bflo(xv.w); a[7] += w[7] * bfhi(xv.w);
      }
#pragma unroll
      for (int e = 0; e < 8; ++e) a[e] = a[e] / (1.f + __expf(-a[e]));
      uint4 o; o.x = pack2(a[0], a[1]); o.y = pack2(a[2], a[3]); o.z = pack2(a[4], a[5]); o.w = pack2(a[6], a[7]);
      *(uint4*)(sQ + t * 200 + ch) = o;
    }
    __syncthreads();
    {
      const int t0 = wid * 16, nmax = t0 >> 4, ks2max = (t0 + 15) >> 5;
      {
        bf16x8 Qf[6];
#pragma unroll
        for (int ks = 0; ks < 6; ++ks) Qf[ks] = *(const bf16x8*)(sQ + (t0 + r) * 200 + ks * 32 + q * 8);
        float mxr[4];
#pragma unroll
        for (int j = 0; j < 4; ++j) mxr[j] = sMx[t0 + q * 4 + j];
#pragma unroll
        for (int n = 0; n < 8; ++n) {
          f32x4 sa = (f32x4){0.f, 0.f, 0.f, 0.f};
          if (n <= nmax) {
            uint4 Kf[6];
#pragma unroll
            for (int ks = 0; ks < 6; ++ks) Kf[ks] = *(const uint4*)(kc + (tok0 + n * 16 + r) * 768 + h * 192 + ks * 32 + q * 8);
#pragma unroll
            for (int ks = 0; ks < 6; ++ks) sa = __builtin_amdgcn_mfma_f32_16x16x32_bf16(Qf[ks], u4_to_frag(Kf[ks]), sa, 0, 0, 0);
          }
          const int scol = n * 16 + r;
          const float us = sU[scol];
#pragma unroll
          for (int j = 0; j < 4; ++j) {
            const int trow = t0 + q * 4 + j;
            float w = (n <= nmax && scol <= trow) ? __expf(us - mxr[j]) * sa[j] : 0.f;
            sWw[(q * 4 + j) * 136 + scol] = f2bf(w);
          }
        }
      }
      f32x4 acc[13];
#pragma unroll
      for (int nv = 0; nv < 13; ++nv) acc[nv] = (f32x4){0.f, 0.f, 0.f, 0.f};
#pragma unroll 1
      for (int ks = 0; ks < 6; ++ks) {
        const bf16x8 qf = *(const bf16x8*)(sQ + (t0 + r) * 200 + ks * 32 + q * 8);
        uint4 Bf[13];
#pragma unroll
        for (int nv = 0; nv < 13; ++nv) Bf[nv] = *(const uint4*)(C0T + ((size_t)item * 208 + nv * 16 + r) * 192 + ks * 32 + q * 8);
#pragma unroll
        for (int nv = 0; nv < 13; ++nv) acc[nv] = __builtin_amdgcn_mfma_f32_16x16x32_bf16(qf, u4_to_frag(Bf[nv]), acc[nv], 0, 0, 0);
      }
#pragma unroll
      for (int j = 0; j < 4; ++j) {
        const float inter = __expf(m0 - sMx[t0 + q * 4 + j]);
#pragma unroll
        for (int nv = 0; nv < 13; ++nv) acc[nv][j] *= inter;
      }
#pragma unroll 1
      for (int ks2 = 0; ks2 <= ks2max; ++ks2) {
        const bf16x8 wf = *(const bf16x8*)(sWw + r * 136 + ks2 * 32 + q * 8);
        uint4 Bf[12];
#pragma unroll
        for (int nv = 0; nv < 12; ++nv) Bf[nv] = *(const uint4*)(VT + ((size_t)item * 192 + nv * 16 + r) * 128 + ks2 * 32 + q * 8);
#pragma unroll
        for (int nv = 0; nv < 12; ++nv) acc[nv] = __builtin_amdgcn_mfma_f32_16x16x32_bf16(wf, u4_to_frag(Bf[nv]), acc[nv], 0, 0, 0);
        const uint32_t one2 = (r == 0) ? 0x3F803F80u : 0u;
        acc[12] = __builtin_amdgcn_mfma_f32_16x16x32_bf16(wf, u4_to_frag(make_uint4(one2, one2, one2, one2)), acc[12], 0, 0, 0);
      }
      float hg[12];
#pragma unroll
      for (int nv = 0; nv < 12; ++nv) hg[nv] = P.a_h_norm[h * 192 + nv * 16 + r];
#pragma unroll 1
      for (int j = 0; j < 4; ++j) {
        const int trow = t0 + q * 4 + j;
        const size_t tok = tok0 + trow;
        float og[12];
#pragma unroll
        for (int nv = 0; nv < 12; ++nv) og[nv] = bf2f(Po[tok * 768 + h * 192 + nv * 16 + r]);
        float accj[13];
#pragma unroll
        for (int nv = 0; nv < 13; ++nv) accj[nv] = (j == 0) ? acc[nv][0] : (j == 1) ? acc[nv][1] : (j == 2) ? acc[nv][2] : acc[nv][3];
        const float den = __shfl(accj[12], lane & 48);
        const float mt = sBt[trow] + sMx[trow];
        const float inv = 1.f / fmaxf(fabsf(den), __expf(-mt));
        float ss = 0.f;
#pragma unroll
        for (int nv = 0; nv < 12; ++nv) { accj[nv] *= inv; ss += accj[nv] * accj[nv]; }
        ss = sum16(ss);
        const float rstd = rsqrtf(ss * (1.f / 192.f) + EPS);
        VMWAIT();
#pragma unroll
        for (int nv = 0; nv < 12; ++nv)
          Cat[tok * 1024 + h * 192 + nv * 16 + r] = f2bf(accj[nv] * rstd * hg[nv] * sigmoidf_(og[nv]));
      }
    }
  }
}

__device__ __forceinline__ float t5_bias(const float* rel_bias, int dist, int head) {
  int bucket;
  if (dist < 16) bucket = dist;
  else {
    int large = 16 + (int)(logf((float)dist / 16.f) / 4.852030263919617f * 16.f);
    bucket = large < 31 ? large : 31;
  }
  return rel_bias[bucket * 12 + head];
}

__device__ __forceinline__ void memattn_mfma(const Params& P, int layer, int gw, int nw) {
  bf16_t* Cat = (bf16_t*)(P.ws + OFF_CAT);
  const bf16_t* Kmem = (const bf16_t*)(P.ws + OFF_KMEM) + (size_t)layer * 512 * 256;
  const bf16_t* VmT = (const bf16_t*)(P.ws + OFF_VMEM) + (size_t)layer * 512 * 256;
  const int lane = threadIdx.x & 63, wid = threadIdx.x >> 6, r = lane & 15, q = lane >> 4;
  bf16_t* sP = (bf16_t*)smem + wid * (16 * 264);
  if (gw < 0) return;
  for (int item = gw; item < (kT / 16) * 4; item += nw) {
    const int head = item & 3;
    const size_t tok0 = (size_t)(item >> 2) * 16;
    const int b = (int)(tok0 / kS);
    bf16_t* qbase = Cat + tok0 * 1024 + 768 + head * 64;
    const uint4 qf0 = *(const uint4*)(qbase + (size_t)r * 1024 + q * 8);
    const uint4 qf1 = *(const uint4*)(qbase + (size_t)r * 1024 + 32 + q * 8);
    const bf16_t* Kb = Kmem + (size_t)b * 256 * 256 + head * 64 + q * 8;
    f32x4 sa[16];
#pragma unroll
    for (int n = 0; n < 16; ++n) {
      const uint4 k0 = *(const uint4*)(Kb + (size_t)(n * 16 + r) * 256);
      const uint4 k1 = *(const uint4*)(Kb + (size_t)(n * 16 + r) * 256 + 32);
      sa[n] = __builtin_amdgcn_mfma_f32_16x16x32_bf16(u4_to_frag(qf0), u4_to_frag(k0), (f32x4){0.f, 0.f, 0.f, 0.f}, 0, 0, 0);
      sa[n] = __builtin_amdgcn_mfma_f32_16x16x32_bf16(u4_to_frag(qf1), u4_to_frag(k1), sa[n], 0, 0, 0);
      if ((n & 3) == 3) __builtin_amdgcn_sched_barrier(0);
    }
    float inv[4];
#pragma unroll
    for (int j = 0; j < 4; ++j) {
      float mx = sa[0][j];
#pragma unroll
      for (int n = 1; n < 16; ++n) mx = fmaxf(mx, sa[n][j]);
      mx = max16(mx);
      float sum = 0.f;
#pragma unroll
      for (int n = 0; n < 16; ++n) {
        float p = __expf(sa[n][j] - mx);
        sum += p;
        sP[(q * 4 + j) * 264 + n * 16 + r] = f2bf(p);
      }
      inv[j] = 1.f / sum16(sum);
    }
    f32x4 o[4];
#pragma unroll
    for (int ne = 0; ne < 4; ++ne) o[ne] = (f32x4){0.f, 0.f, 0.f, 0.f};
    const bf16_t* Vb = VmT + (size_t)(b * 4 + head) * 64 * 256 + q * 8;
#pragma unroll
    for (int ks = 0; ks < 8; ++ks) {
      const bf16x8 pf = *(const bf16x8*)(sP + r * 264 + ks * 32 + q * 8);
#pragma unroll
      for (int ne = 0; ne < 4; ++ne) {
        const uint4 vf = *(const uint4*)(Vb + (size_t)(ne * 16 + r) * 256 + ks * 32);
        o[ne] = __builtin_amdgcn_mfma_f32_16x16x32_bf16(pf, u4_to_frag(vf), o[ne], 0, 0, 0);
      }
      if (ks & 1) __builtin_amdgcn_sched_barrier(0);
    }
    VMWAIT();
#pragma unroll
    for (int ne = 0; ne < 4; ++ne)
#pragma unroll
      for (int j = 0; j < 4; ++j) qbase[(size_t)(q * 4 + j) * 1024 + ne * 16 + r] = f2bf(o[ne][j] * inv[j]);
  }
}

__device__ __forceinline__ void dilated_slab(const Params& P, int pass, int sidx, int b, int p0, int hg, const float* sBias,
                                             float* sLse, bf16_t* sP) {
  bf16_t* Cat = (bf16_t*)(P.ws + OFF_CAT);
  const bf16_t* Ksh = (const bf16_t*)(P.ws + OFF_R2);
  const bf16_t* VshT = Ksh + (size_t)kT * 768;
  const int lane = threadIdx.x & 63, r = lane & 15, q = lane >> 4;
  const int g = sidx >> 4, i = sidx & 15, d = 1 << (2 * g), head = g * 4 + hg;
  const int r_res = (g == 0) ? 0 : (g == 1) ? (i >> 2) : i;
  const int sig0 = (g == 0) ? (p0 + 16 * i) : (g == 1) ? ((p0 >> 2) + 16 * (i & 3)) : (p0 >> 4);
  const size_t tokq = (size_t)b * kS + (size_t)(sig0 + r) * d + r_res;
  const uint4 qf0 = *(const uint4*)(Cat + tokq * 1024 + head * 64 + q * 8);
  const uint4 qf1 = *(const uint4*)(Cat + tokq * 1024 + head * 64 + 32 + q * 8);
  f32x4 sa[10];
  sa[0] = (f32x4){0.f, 0.f, 0.f, 0.f};
#pragma unroll
  for (int n = 1; n < 10; ++n) {
    int sigk = sig0 - 144 + n * 16 + r;
    sigk = sigk < 0 ? 0 : sigk;
    const bf16_t* kp = Ksh + ((size_t)b * kS + (size_t)sigk * d + r_res) * 768 + head * 64 + q * 8;
    const uint4 k0 = *(const uint4*)kp;
    const uint4 k1 = *(const uint4*)(kp + 32);
    sa[n] = __builtin_amdgcn_mfma_f32_16x16x32_bf16(u4_to_frag(qf0), u4_to_frag(k0), (f32x4){0.f, 0.f, 0.f, 0.f}, 0, 0, 0);
    sa[n] = __builtin_amdgcn_mfma_f32_16x16x32_bf16(u4_to_frag(qf1), u4_to_frag(k1), sa[n], 0, 0, 0);
  }
  float scl[4];
#pragma unroll
  for (int j = 0; j < 4; ++j) {
    float mx = -1e30f;
#pragma unroll
    for (int n = 1; n < 10; ++n) {
      const int mo = 144 + q * 4 + j - n * 16 - r;
      const int sigk = sig0 - 144 + n * 16 + r;
      const bool ok = (mo >= 0) && (mo <= 128) && (sigk >= 0);
      const float sv = ok ? (sa[n][j] + sBias[g * 132 + (ok ? mo : 0)]) : -1e30f;
      sa[n][j] = sv;
      mx = fmaxf(mx, sv);
    }
    mx = max16(mx);
    float sum = 0.f;
#pragma unroll
    for (int n = 1; n < 10; ++n) {
      const float p = (sa[n][j] > -1e29f) ? __expf(sa[n][j] - mx) : 0.f;
      sa[n][j] = p;
      sum += p;
    }
    sum = sum16(sum);
    const float lse = mx + __logf(sum);
    const int pw = (sig0 + q * 4 + j) * d + r_res - p0;
    if (pass == 0) {
      if (r == 0) sLse[g * 256 + pw] = lse;
      scl[j] = 0.f;
    } else {
      const float l0 = sLse[pw], l1 = sLse[256 + pw], l2 = sLse[512 + pw];
      const float L = fmaxf(fmaxf(l0, l1), l2);
      const float den = __expf(l0 - L) + __expf(l1 - L) + __expf(l2 - L);
      scl[j] = __expf(lse - L) / (den * sum);
    }
  }
  if (pass == 0) return;
#pragma unroll
  for (int j = 0; j < 4; ++j) {
#pragma unroll
    for (int n = 0; n < 10; ++n) sP[(q * 4 + j) * 168 + n * 16 + r] = f2bf(sa[n][j]);
  }
  f32x4 o[4];
#pragma unroll
  for (int ne = 0; ne < 4; ++ne) o[ne] = (f32x4){0.f, 0.f, 0.f, 0.f};
  const bf16_t* Vb = VshT + ((size_t)(b * 12 + head) * 64 + r) * kS + (size_t)r_res * (kS / d);
#pragma unroll
  for (int ks = 0; ks < 5; ++ks) {
    const bf16x8 pf = *(const bf16x8*)(sP + r * 168 + ks * 32 + q * 8);
    int sk0 = sig0 - 144 + ks * 32 + q * 8;
    sk0 = sk0 < 0 ? 0 : sk0;
#pragma unroll
    for (int ne = 0; ne < 4; ++ne) {
      const uint4 vf = *(const uint4*)(Vb + (size_t)ne * 16 * kS + sk0);
      o[ne] = __builtin_amdgcn_mfma_f32_16x16x32_bf16(pf, u4_to_frag(vf), o[ne], 0, 0, 0);
    }
  }
  VMWAIT();
#pragma unroll
  for (int ne = 0; ne < 4; ++ne)
#pragma unroll
    for (int j = 0; j < 4; ++j) {
      const size_t tok = (size_t)b * kS + (size_t)(sig0 + q * 4 + j) * d + r_res;
      Cat[tok * 1024 + head * 64 + ne * 16 + r] = f2bf(o[ne][j] * scl[j]);
    }
}

__device__ __forceinline__ void phase_dilated_mfma(const Params& P) {
  float* sBias = (float*)smem;
  float* sLse = (float*)(smem + 1584);
  const int tid = threadIdx.x, wid = tid >> 6;
  bf16_t* sP = (bf16_t*)(smem + 4656) + wid * (16 * 168);
  for (int item = blockIdx.x; item < 512; item += gridDim.x) {
    const int hg = item & 3, win = item >> 2, b = win >> 6, p0 = (win & 63) * 256;
    __syncthreads();
    for (int i = tid; i < 3 * 129; i += NTHR) {
      const int g = i / 129, mo = i - g * 129;
      sBias[g * 132 + mo] = t5_bias(P.rel_bias, mo << (2 * g), g * 4 + hg);
    }
    __syncthreads();
#pragma unroll 1
    for (int pass = 0; pass < 2; ++pass) {
#pragma unroll 1
      for (int sidx = wid; sidx < 48; sidx += NWAVE) dilated_slab(P, pass, sidx, b, p0, hg, sBias, sLse, sP);
      VMWAIT();
      __syncthreads();
    }
  }
}

#define XB_TMO      128
#define XB_XCNT(j)  (256  + 64 * (j))
#define XB_XSUB(j)  (1280 + 64 * (j))
#define XB_XGEN(j)  (2304 + 64 * (j))
#define XB_TOP      3328
#define XB_TOPGEN   3392
#define XCD_BAR_WORDS 3456
#define XB_SPIN_CAP (1u << 23)
__device__ __forceinline__ unsigned xb_ld(unsigned* p) { return __hip_atomic_load(p, __ATOMIC_RELAXED, __HIP_MEMORY_SCOPE_AGENT); }
__device__ __forceinline__ unsigned xb_add(unsigned* p, unsigned v) { return __hip_atomic_fetch_add(p, v, __ATOMIC_RELAXED, __HIP_MEMORY_SCOPE_AGENT); }
__device__ __forceinline__ unsigned xb_xcc_id() { return (unsigned)__builtin_amdgcn_s_getreg((3 << 11) | 20) & 0xFu; }
#define XB_SPIN(cond, bar) do { unsigned _sp = 0; while (cond) { __builtin_amdgcn_s_sleep(1); \
    if ((++_sp & 255u) == 0u) { if (xb_ld(&(bar)[XB_TMO])) break; if (_sp > XB_SPIN_CAP) { atomicAdd(&(bar)[XB_TMO], 1u); break; } } } } while (0)
struct XcdBarrier { unsigned* bar; unsigned x; volatile LAS unsigned* st; };
__device__ __forceinline__ XcdBarrier xcd_barrier_post(unsigned* bar, volatile LAS unsigned* st) {
  XcdBarrier b; b.bar = bar; b.x = xb_xcc_id(); b.st = st;
  if (threadIdx.x == 0) (void)xb_add(&bar[XB_XCNT(b.x)], 1u);
  return b;
}
__device__ __forceinline__ void xcd_barrier_complete(unsigned* bar, unsigned x, unsigned& nloc, unsigned& nx) {
  const unsigned Gr = gridDim.x * gridDim.y * gridDim.z;
  unsigned sum, cnt, mine, sp = 0u;
  for (;;) {
    sum = 0u; cnt = 0u; mine = 0u;
#pragma unroll
    for (unsigned j = 0; j < 16; ++j) { const unsigned c = xb_ld(&bar[XB_XCNT(j)]); sum += c; cnt += (c > 0u) ? 1u : 0u; mine = (j == x) ? c : mine; }
    if (sum == Gr) break;
    __builtin_amdgcn_s_sleep(1);
    if ((++sp & 255u) == 0u) { if (xb_ld(&bar[XB_TMO])) break; if (sp > XB_SPIN_CAP) { atomicAdd(&bar[XB_TMO], 1u); break; } }
  }
  nloc = mine > 0u ? mine : 1u; nx = cnt > 0u ? cnt : 1u;
}
__device__ __forceinline__ void xcd_barrier(const XcdBarrier& b) {
  asm volatile("s_waitcnt vmcnt(0)" ::: "memory");
  __syncthreads();
  if (threadIdx.x == 0) {
    unsigned* bar = b.bar;
    __builtin_amdgcn_s_waitcnt(0);
    unsigned nloc = b.st[0], nx = b.st[1];
    if (nloc == 0u) { xcd_barrier_complete(bar, b.x, nloc, nx); b.st[0] = nloc; b.st[1] = nx; }
    const unsigned old = xb_add(&bar[XB_XSUB(b.x)], 1u);
    const unsigned gen = old / nloc;
    if (old + 1u == (gen + 1u) * nloc) {
      __builtin_amdgcn_fence(__ATOMIC_RELEASE, "agent");
      asm volatile("s_waitcnt vmcnt(0)" ::: "memory");
      const unsigned og = xb_add(&bar[XB_TOP], 1u);
      const unsigned tg = og / nx;
      if (og + 1u == (tg + 1u) * nx) xb_add(&bar[XB_TOPGEN], 1u);
      else XB_SPIN(xb_ld(&bar[XB_TOPGEN]) == tg, bar);
      __builtin_amdgcn_fence(__ATOMIC_ACQUIRE, "agent");
      xb_add(&bar[XB_XGEN(b.x)], 1u);
      asm volatile("s_waitcnt vmcnt(0)" ::: "memory");
    } else {
      XB_SPIN(xb_ld(&bar[XB_XGEN(b.x)]) == gen, bar);
      __builtin_amdgcn_fence(__ATOMIC_ACQUIRE, "agent");
      asm volatile("s_waitcnt vmcnt(0)" ::: "memory");
    }
  }
  __syncthreads();
}
#define grid_barrier() xcd_barrier(xbar_)

constexpr int NPHASE = 17;
#ifndef ONLY_PHASE
#define ONLY_PHASE -1
#endif
#ifndef SKIP12
#define SKIP12 0
#endif
#ifndef SKIP14
#define SKIP14 0
#endif
#define PH(n) (ONLY_PHASE < 0 || ONLY_PHASE == (n))

__device__ __forceinline__ char* launder(char* p) { asm volatile("" : "+s"(p)); return p; }
__global__ void __launch_bounds__(512, 2) fwd_megakernel(Params P, int pb, int pe) {
#define W ((bf16_t*)(wsl + OFF_W))
#define xb ((bf16_t*)(wsl + OFF_XB))
#define H ((bf16_t*)(wsl + OFF_R1))
#define Pbase ((bf16_t*)(wsl + OFF_R1))
#define Ksh ((bf16_t*)(wsl + OFF_R2))
#define Vsh (Ksh + (size_t)kT * 768)
#define Cat ((bf16_t*)(wsl + OFF_CAT))
#define ssq ((float*)(wsl + OFF_SSQ))
#define G ((float*)(wsl + OFF_G))
#define memb ((bf16_t*)(wsl + OFF_MEMB))
#define ssqm ((float*)(wsl + OFF_SSQM))
#define Kmem ((bf16_t*)(wsl + OFF_KMEM))
#define Vmem ((bf16_t*)(wsl + OFF_VMEM))
  if (pe < -12345) cg::this_grid().sync();
  volatile LAS unsigned* xst_ = (volatile LAS unsigned*)(smem + 131072);
  if (threadIdx.x == 0) { xst_[0] = 0u; xst_[1] = 0u; }
  __syncthreads();
  XcdBarrier xbar_;
  xbar_.bar = (unsigned*)(P.ws + OFF_BAR); xbar_.x = 0; xbar_.st = xst_;
  if (pe - pb > 1) xbar_ = xcd_barrier_post((unsigned*)(P.ws + OFF_BAR), xst_);
  if (pb == 100) {
    char* wsl = P.ws;
    for (size_t i = (size_t)blockIdx.x * NTHR + threadIdx.x; i < (size_t)kT * 1024; i += (size_t)gridDim.x * NTHR) P.out[i] = bf2f(Cat[i]);
    return;
  }
  {
    if (pb <= 0 && 0 < pe && PH(0)) { char* wsl = launder(P.ws); Params Q = P; Q.ws = wsl; (void)Q; phase_convert(Q); }
    if (pb <= 0 && 0 + 1 < pe) grid_barrier();
    if (pb <= 1 && 1 < pe && PH(1)) { char* wsl = launder(P.ws); Params Q = P; Q.ws = wsl; (void)Q; gemm8(xb, W + W_GU0, kT, 5632, 1024, Epi8Swiglu{ssq, H}); }
    if (pb <= 1 && 1 + 1 < pe) grid_barrier();
    if (pb <= 2 && 2 < pe && PH(2)) { char* wsl = launder(P.ws); Params Q = P; Q.ws = wsl; (void)Q; { gemm8(H, W + W_DN0, kT, 1024, 2816, Epi8Resid{P.x, P.out, xb, ssq, 0.5f});
      gemm8(memb, W + W_MKV0, 512, 512, 1024, Epi8MemKv{ssqm, Kmem, (bf16_t*)(wsl + OFF_VTOK), P.mem_k_norm}, 64);
      gemm8(memb, W + W_MKV1, 512, 512, 1024, Epi8MemKv{ssqm, Kmem + 512 * 256, (bf16_t*)(wsl + OFF_VTOK) + 512 * 256, P.mem_k_norm + 64}, 192);
    } }
    if (pb <= 2 && 2 + 1 < pe) grid_barrier();
    if (pb <= 3 && 3 < pe && PH(3)) { char* wsl = launder(P.ws); Params Q = P; Q.ws = wsl; (void)Q; {
      gemm8(xb, W + W_IN, kT, 3584, 1024, Epi8InProj{ssq, Pbase, Cat, G, P.mem_q_norm, P.a_gate_bias});
    } }
    if (pb <= 3 && 3 + 1 < pe) grid_barrier();
    if (pb <= 4 && 4 < pe && PH(4)) { char* wsl = launder(P.ws); Params Q = P; Q.ws = wsl; (void)Q; { memv_transpose((const bf16_t*)(wsl + OFF_VTOK), Vmem); phase_prep(Q); } }
    if (pb <= 4 && 4 + 1 < pe) grid_barrier();
    if (pb <= 5 && 5 < pe && PH(5)) { char* wsl = launder(P.ws); Params Q = P; Q.ws = wsl; (void)Q; phase_scan(Q); { const int wv = (int)(threadIdx.x >> 6) * (int)gridDim.x + (int)blockIdx.x, tot = (int)gridDim.x * NWAVE; if (tot > 416 + 64) { memattn_mfma(Q, 0, wv - 416, tot - 416); if (wv >= 416) wave_convert(Q, wv - 416, tot - 416, false); } else { memattn_mfma(Q, 0, wv, tot); wave_convert(Q, wv, tot, false); } } }
    if (pb <= 5 && 5 + 1 < pe) grid_barrier();
    if (pb <= 6 && 6 < pe && PH(6)) { char* wsl = launder(P.ws); Params Q = P; Q.ws = wsl; (void)Q; phase_chunk(Q); }
    if (pb <= 6 && 6 + 1 < pe) grid_barrier();
    if (pb <= 7 && 7 < pe && PH(7)) { char* wsl = launder(P.ws); Params Q = P; Q.ws = wsl; (void)Q; gemm8(Cat, W + W_AOUT, kT, 1024, 1024, Epi8Resid{P.out, P.out, xb, ssq, 1.f}); }
    if (pb <= 7 && 7 + 1 < pe) grid_barrier();
    if (pb <= 8 && 8 < pe && PH(8)) { char* wsl = launder(P.ws); Params Q = P; Q.ws = wsl; (void)Q; gemm8(xb, W + W_GU1, kT, 5632, 1024, Epi8Swiglu{ssq, H}); }
    if (pb <= 8 && 8 + 1 < pe) grid_barrier();
    if (pb <= 9 && 9 < pe && PH(9)) { char* wsl = launder(P.ws); Params Q = P; Q.ws = wsl; (void)Q; gemm8(H, W + W_DN1, kT, 1024, 2816, Epi8Resid{P.out, P.out, xb, ssq, 0.5f}); }
    if (pb <= 9 && 9 + 1 < pe) grid_barrier();
    if (pb <= 10 && 10 < pe && PH(10)) { char* wsl = launder(P.ws); Params Q = P; Q.ws = wsl; (void)Q; gemm8(xb, W + W_GU2, kT, 7168, 1024, Epi8KvFfn{ssq, H, Ksh, Cat, P.kv_k_norm}); }
    if (pb <= 10 && 10 + 1 < pe) grid_barrier();
    if (pb <= 11 && 11 < pe && PH(11)) { char* wsl = launder(P.ws); Params Q = P; Q.ws = wsl; (void)Q; { gemm8(H, W + W_DN2, kT, 1024, 2816, Epi8Resid{P.out, P.out, xb, ssq, 0.5f}); phase_vtranspose(Cat, Vsh); } }
    if (pb <= 11 && 11 + 1 < pe) grid_barrier();
    if (pb <= 12 && 12 < pe && PH(12) && !SKIP12) { char* wsl = launder(P.ws); Params Q = P; Q.ws = wsl; (void)Q; gemm8(xb, W + W_BQ, kT, 1024, 1024, Epi8QProj{ssq, Cat, P.b_q_norm, P.mem_q_norm + 64}); }
    if (pb <= 12 && 12 + 1 < pe) grid_barrier();
    if (pb <= 13 && 13 < pe && PH(13)) { char* wsl = launder(P.ws); Params Q = P; Q.ws = wsl; (void)Q; { phase_dilated_mfma(Q); memattn_mfma(Q, 1, (int)blockIdx.x * NWAVE + (int)(threadIdx.x >> 6), (int)gridDim.x * NWAVE); } }
    if (pb <= 13 && 13 + 1 < pe) grid_barrier();
    if (pb <= 14 && 14 < pe && PH(14) && !SKIP14) { char* wsl = launder(P.ws); Params Q = P; Q.ws = wsl; (void)Q; gemm8(Cat, W + W_BOUT, kT, 1024, 1024, Epi8Resid{P.out, P.out, xb, ssq, 1.f}); }
    if (pb <= 14 && 14 + 1 < pe) grid_barrier();
    if (pb <= 15 && 15 < pe && PH(15)) { char* wsl = launder(P.ws); Params Q = P; Q.ws = wsl; (void)Q; gemm8(xb, W + W_GU3, kT, 5632, 1024, Epi8Swiglu{ssq, H}); }
    if (pb <= 15 && 15 + 1 < pe) grid_barrier();
    if (pb <= 16 && 16 < pe && PH(16)) { char* wsl = launder(P.ws); Params Q = P; Q.ws = wsl; (void)Q; gemm8(H, W + W_DN3, kT, 1024, 2816, Epi8Resid{P.out, P.out, nullptr, ssq, 0.5f}); }
  }
}
#undef W
#undef xb
#undef H
#undef Pbase
#undef Ksh
#undef Vsh
#undef Cat
#undef ssq
#undef G
#undef memb
#undef ssqm
#undef Kmem
#undef Vmem

extern "C" void kernel_launch(void* const* d_in, const int* in_sizes, int n_in, void* d_out, int out_size, void* d_ws,
                              size_t ws_size, hipStream_t stream) {
  (void)in_sizes; (void)n_in; (void)out_size;
  static int grid_blocks = 0;
  if (!grid_blocks) {
    int dev = 0, cus = 0, per_cu = 0;
    hipGetDevice(&dev);
    hipDeviceGetAttribute(&cus, hipDeviceAttributeMultiprocessorCount, dev);
    hipOccupancyMaxActiveBlocksPerMultiprocessor(&per_cu, fwd_megakernel, NTHR, 0);
    if (per_cu > 1) per_cu = 1;
    grid_blocks = cus * per_cu;
    if (ws_size < OFF_END) fprintf(stderr, "workspace too small: %zu < %zu\n", ws_size, (size_t)OFF_END);
  }
  Params p{};
  const float** pf = (const float**)&p;
  for (int i = 0; i < 27; ++i) pf[i] = (const float*)d_in[i];
  p.out = (float*)d_out;
  p.ws = (char*)d_ws;
#ifndef RUN_PE
#define RUN_PE NPHASE
#endif
#ifdef MULTI_LAUNCH
  hipError_t e = hipSuccess;
  for (int ph = 0; ph < RUN_PE; ++ph) {
    int pb = ph, pe = ph + 1;
    hipLaunchKernelGGL(fwd_megakernel, dim3(grid_blocks), dim3(NTHR), 0, stream, p, pb, pe);
  }
#else
  hipMemsetAsync((char*)d_ws + OFF_BAR, 0, 16384, stream);
  int pb = 0, pe = RUN_PE;
  void* args[] = {&p, &pb, &pe};
  hipError_t e = hipLaunchCooperativeKernel((void*)fwd_megakernel, dim3(grid_blocks), dim3(NTHR), args, 0, stream);
#endif
  if (e != hipSuccess) fprintf(stderr, "cooperative launch failed: %s (grid %d)\n", hipGetErrorString(e), grid_blocks);
}
```

```cpp
#include <hip/hip_runtime.h>
#include <hip/hip_cooperative_groups.h>
#include <stdint.h>
#include <stdio.h>
namespace cg = cooperative_groups;

typedef unsigned short bf16_t;
typedef __attribute__((ext_vector_type(8))) short bf16x8;
typedef __attribute__((ext_vector_type(4))) float f32x4;
#define LAS __attribute__((address_space(3)))
#define VMWAIT() asm volatile("s_waitcnt vmcnt(0)" ::: "memory")

constexpr int kT = 32768, kS = 16384;
constexpr int NTHR = 512, NWAVE = 8;
constexpr float EPS = 1e-6f;

constexpr size_t GU_SZ = 5632ull * 1024, DN_SZ = 1024ull * 2816, KV_SZ = 1536ull * 1024, IN_SZ = 3584ull * 1024,
                 SQ_SZ = 1024ull * 1024, MKV_SZ = 512ull * 1024;
constexpr size_t W_GU0 = 0, W_GU1 = GU_SZ, W_GU2 = 2 * GU_SZ, W_KV = 3 * GU_SZ, W_GU3 = W_KV + KV_SZ,
                 W_DN0 = W_GU3 + GU_SZ, W_DN1 = W_DN0 + DN_SZ, W_DN2 = W_DN1 + DN_SZ, W_DN3 = W_DN2 + DN_SZ,
                 W_IN = W_DN3 + DN_SZ, W_AOUT = W_IN + IN_SZ, W_BQ = W_AOUT + SQ_SZ, W_BOUT = W_BQ + SQ_SZ,
                 W_MKV0 = W_BOUT + SQ_SZ, W_MKV1 = W_MKV0 + MKV_SZ, W_END = W_MKV1 + MKV_SZ;
constexpr size_t PSZ = (size_t)kT * 768 * 2;
constexpr size_t OFF_W = 0;
constexpr size_t OFF_XB = (W_END * 2 + 255) / 256 * 256;
constexpr size_t OFF_R1 = OFF_XB + (size_t)kT * 1024 * 2;
constexpr size_t OFF_R2 = OFF_R1 + 4 * PSZ;
constexpr size_t OFF_CAT = OFF_R2 + 2 * PSZ;
constexpr size_t OFF_SSQ = OFF_CAT + (size_t)kT * 1024 * 2;
constexpr size_t OFF_G = OFF_SSQ + (size_t)kT * 16 * 4;
constexpr size_t OFF_MEMB = OFF_G + (size_t)kT * 8 * 4;
constexpr size_t OFF_SSQM = OFF_MEMB + 512ull * 1024 * 2;
constexpr size_t OFF_KMEM = OFF_SSQM + 512ull * 16 * 4;
constexpr size_t OFF_VMEM = OFF_KMEM + 2ull * 512 * 256 * 2;
constexpr size_t OFF_U = OFF_VMEM + 2ull * 512 * 256 * 2;
constexpr size_t OFF_BC = OFF_U + 1024ull * 128 * 4;
constexpr size_t OFF_EW = OFF_BC + 1024ull * 128 * 4;
constexpr size_t OFF_UMAX = OFF_EW + 1024ull * 128 * 2;
constexpr size_t OFF_BL = OFF_UMAX + 4096;
constexpr size_t OFF_M0 = OFF_BL + 4096;
constexpr size_t OFF_BAR = OFF_M0 + 4096;
constexpr size_t OFF_VTOK = OFF_BAR + 16384;
constexpr size_t OFF_END = OFF_VTOK + 2ull * 512 * 256 * 2;

struct Params {
  const float *x, *mem, *ffn1_norm, *ffn1_wg, *ffn1_wu, *ffn1_wd, *ffn2_norm, *ffn2_wg, *ffn2_wu, *ffn2_wd, *mix_norm,
      *mem_norm, *w_mem_kv, *mem_q_norm, *mem_k_norm, *a_w_in, *a_conv, *a_gate_bias, *a_h_norm, *a_w_out, *b_w_q,
      *b_q_norm, *b_w_out, *kv_norm, *w_kv, *kv_k_norm, *rel_bias;
  float* out;
  char* ws;
};

__shared__ __attribute__((aligned(16))) char smem[146432];

__device__ __forceinline__ bf16_t f2bf(float f) {
  uint32_t u = __float_as_uint(f);
  u += 0x7fffu + ((u >> 16) & 1u);
  return (bf16_t)(u >> 16);
}
__device__ __forceinline__ float bf2f(bf16_t h) { return __uint_as_float(((uint32_t)h) << 16); }
__device__ __forceinline__ float bflo(uint32_t u) { return __uint_as_float(u << 16); }
__device__ __forceinline__ float bfhi(uint32_t u) { return __uint_as_float(u & 0xffff0000u); }
__device__ __forceinline__ uint32_t pack2(float a, float b) { uint32_t r; asm("v_cvt_pk_bf16_f32 %0, %1, %2" : "=v"(r) : "v"(a), "v"(b)); return r; }
__device__ __forceinline__ float dot8(uint4 a, uint4 b) {
  return bflo(a.x) * bflo(b.x) + bfhi(a.x) * bfhi(b.x) + bflo(a.y) * bflo(b.y) + bfhi(a.y) * bfhi(b.y) +
         bflo(a.z) * bflo(b.z) + bfhi(a.z) * bfhi(b.z) + bflo(a.w) * bflo(b.w) + bfhi(a.w) * bfhi(b.w);
}
__device__ __forceinline__ float wave_sum(float v) {
  for (int o = 32; o > 0; o >>= 1) v += __shfl_xor(v, o);
  return v;
}
__device__ __forceinline__ float wave_max(float v) {
  for (int o = 32; o > 0; o >>= 1) v = fmaxf(v, __shfl_xor(v, o));
  return v;
}
__device__ __forceinline__ float dpp_ror_(float v, int) { return v; }
#define DPP_ROR_ADD(v, ctrl) v += __builtin_bit_cast(float, __builtin_amdgcn_update_dpp(0, __builtin_bit_cast(int, v), ctrl, 0xf, 0xf, false))
__device__ __forceinline__ float sum16(float v) {
  DPP_ROR_ADD(v, 0x128); DPP_ROR_ADD(v, 0x124); DPP_ROR_ADD(v, 0x122); DPP_ROR_ADD(v, 0x121);
  return v;
}
#define DPP_ROR_MAX(v, ctrl) v = fmaxf(v, __builtin_bit_cast(float, __builtin_amdgcn_update_dpp(0, __builtin_bit_cast(int, v), ctrl, 0xf, 0xf, false)))
__device__ __forceinline__ float max16(float v) {
  DPP_ROR_MAX(v, 0x128); DPP_ROR_MAX(v, 0x124); DPP_ROR_MAX(v, 0x122); DPP_ROR_MAX(v, 0x121);
  return v;
}
__device__ __forceinline__ float sigmoidf_(float x) { return __builtin_amdgcn_rcpf(1.f + __expf(-x)); }

struct WJob { size_t dst; int Nd, K; };
__device__ __forceinline__ WJob wjob(int j) {
  switch (j) {
    case 0: return {W_GU0, 5632, 1024};
    case 1: return {W_GU1, 5632, 1024};
    case 2: return {W_GU2, 5632, 1024};
    case 3: return {W_GU3, 5632, 1024};
    case 4: return {W_DN0, 1024, 2816};
    case 5: return {W_DN1, 1024, 2816};
    case 6: return {W_DN2, 1024, 2816};
    case 7: return {W_DN3, 1024, 2816};
    case 8: return {W_IN, 3584, 1024};
    case 9: return {W_AOUT, 1024, 1024};
    case 10: return {W_BQ, 1024, 1024};
    case 11: return {W_BOUT, 1024, 1024};
    case 12: return {W_KV, 1536, 1024};
    case 13: return {W_MKV0, 512, 1024};
    default: return {W_MKV1, 512, 1024};
  }
}
__device__ __forceinline__ int headmap(int r256) { const int bj = r256 >> 7, hh = (r256 & 127) >> 5, i = r256 & 31; return hh * 64 + bj * 32 + i; }
__device__ __forceinline__ void wsrc(const Params& P, int j, int n, const float*& p, int& ld, const float*& gain) {
  p = nullptr; ld = 0; gain = nullptr;
  if (j < 4) {
    int layer = j >> 1, which = j & 1;
    int pn = n >> 8, r = n & 255, bj = r >> 7, col = pn * 128 + (r & 127);
    const float* wg = which ? P.ffn2_wg : P.ffn1_wg;
    const float* wu = which ? P.ffn2_wu : P.ffn1_wu;
    p = (bj ? wu : wg) + (size_t)layer * 1024 * 2816 + col;
    ld = 2816;
    gain = (which ? P.ffn2_norm : P.ffn1_norm) + layer * 1024;
  } else if (j < 8) {
    int i = j - 4, layer = i >> 1, which = i & 1;
    p = (which ? P.ffn2_wd : P.ffn1_wd) + (size_t)layer * 2816 * 1024 + n;
    ld = 1024;
  } else if (j == 8) {
    int col = -1;
    if (n < 3072) col = n; else if (n < 3328) col = 3080 + headmap(n - 3072); else if (n < 3336) col = 3072 + (n - 3328);
    if (col >= 0) { p = P.a_w_in + col; ld = 3336; }
    gain = P.mix_norm;
  } else if (j == 9) { p = P.a_w_out + n; ld = 1024; }
  else if (j == 10) { p = P.b_w_q + (n & ~255) + headmap(n & 255); ld = 1024; gain = P.mix_norm + 1024; }
  else if (j == 11) { p = P.b_w_out + n; ld = 1024; }
  else if (j == 12) { int col = (n < 768) ? ((n & ~255) + headmap(n & 255)) : n; p = P.w_kv + col; ld = 1536; gain = P.kv_norm; }
  else { int l = j - 13; int col = (n < 256) ? headmap(n) : n; p = P.w_mem_kv + (size_t)l * 1024 * 512 + col; ld = 512; gain = P.mem_norm + l * 1024; }
}

__device__ __forceinline__ void wave_convert(const Params& P, int widx, int nwv, bool early) {
  bf16_t* W = (bf16_t*)(P.ws + OFF_W);
  const int lane = threadIdx.x & 63;
  int base = 0;
  for (int j = 0; j < 15; ++j) {
    const bool is_early = (j == 0 || j == 4 || j == 8 || j >= 13);
    if (is_early != early) continue;
    WJob wj = wjob(j);
    const int tk_cnt = wj.K >> 6, ntile = (wj.Nd >> 6) * tk_cnt;
    const int first = (widx + nwv - (base % nwv)) % nwv;
    for (int t = first; t < ntile; t += nwv) {
      const int tn = t / tk_cnt, tk = t - tn * tk_cnt, n = (tn << 6) + lane, k0 = tk << 6;
      const float* sp; int ld; const float* gain;
      wsrc(P, j, n, sp, ld, gain);
      float v[64];
#pragma unroll
      for (int k = 0; k < 64; ++k) v[k] = sp ? sp[(size_t)(k0 + k) * ld] : 0.f;
      if (gain) {
#pragma unroll
        for (int k4 = 0; k4 < 16; ++k4) {
          const float4 g4 = *(const float4*)(gain + k0 + k4 * 4);
          v[k4 * 4 + 0] *= g4.x; v[k4 * 4 + 1] *= g4.y; v[k4 * 4 + 2] *= g4.z; v[k4 * 4 + 3] *= g4.w;
        }
      }
      VMWAIT();
      bf16_t* dst = W + wj.dst + (size_t)n * wj.K + k0;
#pragma unroll
      for (int k8 = 0; k8 < 8; ++k8) {
        uint4 o;
        o.x = pack2(v[k8 * 8 + 0], v[k8 * 8 + 1]); o.y = pack2(v[k8 * 8 + 2], v[k8 * 8 + 3]);
        o.z = pack2(v[k8 * 8 + 4], v[k8 * 8 + 5]); o.w = pack2(v[k8 * 8 + 6], v[k8 * 8 + 7]);
        *(uint4*)(dst + k8 * 8) = o;
      }
    }
    base += ntile;
  }
}

__device__ __forceinline__ void phase_convert(const Params& P) {
  bf16_t* W = (bf16_t*)(P.ws + OFF_W);
  float* sT = (float*)smem;
  const int tid = threadIdx.x;
  wave_convert(P, (int)(blockIdx.x * NWAVE + (threadIdx.x >> 6)), (int)(gridDim.x * NWAVE), true);
  bf16_t* xb = (bf16_t*)(P.ws + OFF_XB);
  float* ssq = (float*)(P.ws + OFF_SSQ);
  bf16_t* memb = (bf16_t*)(P.ws + OFF_MEMB);
  float* ssqm = (float*)(P.ws + OFF_SSQM);
  const int lane = tid & 63, gw = blockIdx.x * NWAVE + (tid >> 6), nw = gridDim.x * NWAVE;
  for (int row0 = gw * 2; row0 < kT + 512; row0 += nw * 2) {
    float4 v[2][4];
#pragma unroll
    for (int e = 0; e < 2; ++e) {
      const int row = row0 + e;
      const float* src = (row < kT) ? (P.x + (size_t)row * 1024) : (P.mem + (size_t)(row - kT) * 1024);
#pragma unroll
      for (int i = 0; i < 4; ++i) v[e][i] = ((const float4*)src)[lane + 64 * i];
    }
    VMWAIT();
#pragma unroll
    for (int e = 0; e < 2; ++e) {
      const int row = row0 + e;
      bf16_t* dst = (row < kT) ? (xb + (size_t)row * 1024) : (memb + (size_t)(row - kT) * 1024);
      float* sq = (row < kT) ? (ssq + (size_t)row * 16) : (ssqm + (size_t)(row - kT) * 16);
      float ss = 0.f;
#pragma unroll
      for (int i = 0; i < 4; ++i) {
        ss += v[e][i].x * v[e][i].x + v[e][i].y * v[e][i].y + v[e][i].z * v[e][i].z + v[e][i].w * v[e][i].w;
        uint2 o; o.x = pack2(v[e][i].x, v[e][i].y); o.y = pack2(v[e][i].z, v[e][i].w);
        ((uint2*)dst)[lane + 64 * i] = o;
      }
      ss = wave_sum(ss);
      if (lane < 16) sq[lane] = (lane == 0) ? ss : 0.f;
    }
  }
}

constexpr int G8_BM = 256, G8_BK = 64, G8_HALF = 128, G8_HTB = G8_HALF * G8_BK * 2, G8_NXCD = 8, G8_WGM = 8;
__device__ __forceinline__ int lds_byte(int r, int c) { const int st = (r >> 4) * 2 + (c >> 5), rr = r & 15, cc = c & 31, ob = rr * 64 + cc * 2; return st * 1024 + (ob ^ (((ob >> 9) & 1) << 5)); }
__device__ __forceinline__ void stage_rc(int b, int& R, int& C) { const int st = b / 1024, sb = b % 1024, swz = sb ^ (((sb >> 9) & 1) << 5); R = (st >> 1) * 16 + swz / 64; C = (st & 1) * 32 + (swz % 64) / 2; }
__device__ __forceinline__ int perm32(int rho) { const int n = rho >> 4, i = rho & 15; return 8 * (i >> 2) + 4 * n + (i & 3); }
struct Unit { int pm, pn; };
struct StaticOrder {
  int nM, nN, nwg, G, c;
  __device__ void init(int M, int N, int G_, int c_) { nM = M / G8_BM; nN = N / G8_BM; nwg = nM * nN; G = G_; c = c_; }
  __device__ bool next(int i, Unit& u) const {
    const long L = (long)i * G + c; if (L >= nwg) return false;
    int wgid = (int)L; { const int q = nwg / G8_NXCD, r = nwg % G8_NXCD, xcd = wgid % G8_NXCD, off = wgid / G8_NXCD; wgid = (xcd < r ? xcd * (q + 1) : r * (q + 1) + (xcd - r) * q) + off; }
    const int nig = G8_WGM * nN, gid = wgid / nig, fm = gid * G8_WGM, gsz = (nM - fm) < G8_WGM ? (nM - fm) : G8_WGM;
    u.pm = fm + ((wgid % nig) % gsz); u.pn = (wgid % nig) / gsz; return true;
  }
};

__device__ __forceinline__ float rstd_row(const float* ssq, size_t row) {
  const float4* q = (const float4*)(ssq + row * 16);
  float4 a = q[0], b = q[1], c = q[2], d = q[3];
  float s = ((a.x + a.y) + (a.z + a.w)) + ((b.x + b.y) + (b.z + b.w)) + ((c.x + c.y) + (c.z + c.w)) + ((d.x + d.y) + (d.z + d.w));
  return rsqrtf(s * (1.f / 1024.f) + EPS);
}
template <class Epi>
__device__ __forceinline__ void gemm8(const bf16_t* gA, const bf16_t* gBt, int M, int N, int K, const Epi& E, int coff = 0) {
  LAS unsigned char* lds = (LAS unsigned char*)smem;
  StaticOrder S; S.init(M, N, (int)gridDim.x, (int)((blockIdx.x + coff) % gridDim.x));
  const int tid = threadIdx.x, wid = __builtin_amdgcn_readfirstlane(tid >> 6), lane = tid & 63, wr = wid >> 2, wc = wid & 3, fr = lane & 15, fq = lane >> 4;
  const int nt = K / G8_BK;
  unsigned voffA[2], voffB[2];
#pragma unroll
  for (int i = 0; i < 2; ++i) { int R, C; stage_rc(tid * 16 + i * 8192, R, C); const int Rb = Epi::PERM ? ((R & ~31) + perm32(R & 31)) : R;
    voffA[i] = (unsigned)(R * K + C) * 2u; voffB[i] = (unsigned)(Rb * K + C) * 2u; }
  const size_t kstep = (size_t)(G8_BK * 2);
  const size_t hstep = (size_t)G8_HALF * K * 2;
  const size_t tstep = 2 * hstep;
  const unsigned ldsw = (unsigned)wid * 1024u;
  const int aoff = lds_byte(wr * 64 + fr, fq * 8), boff = lds_byte(wc * 32 + fr, fq * 8);
#define PG8_SA(b, h) (((b) * 2 + (h)) * G8_HTB)
#define PG8_SB(b, h) ((4 + (b) * 2 + (h)) * G8_HTB)
#define PG8_STAGE(bufoff, gbase, voff) do { _Pragma("unroll") for (int _i = 0; _i < 2; ++_i) \
    __builtin_amdgcn_global_load_lds((const unsigned*)((const char*)(gbase) + (voff)[_i]), (LAS unsigned*)(lds + (bufoff) + ldsw + _i * 8192), 16, 0, 0); } while (0)
#define PG8_LDA(dst, b, h) do { _Pragma("unroll") for (int m = 0; m < 4; ++m) _Pragma("unroll") for (int k = 0; k < 2; ++k) dst[m][k] = *(const LAS bf16x8*)(lds + PG8_SA(b, h) + aoff + m * 2048 + k * 1024); } while (0)
#define PG8_LDB(dst, b, h) do { _Pragma("unroll") for (int n = 0; n < 2; ++n) _Pragma("unroll") for (int k = 0; k < 2; ++k) dst[n][k] = *(const LAS bf16x8*)(lds + PG8_SB(b, h) + boff + n * 2048 + k * 1024); } while (0)
#define PG8_MMA(ai, bj, At, Bt) do { __builtin_amdgcn_s_setprio(1); _Pragma("unroll") for (int m = 0; m < 4; ++m) _Pragma("unroll") for (int n = 0; n < 2; ++n) _Pragma("unroll") for (int k = 0; k < 2; ++k) \
    acc[ai][bj][m][n] = __builtin_amdgcn_mfma_f32_16x16x32_bf16(Bt[n][k], At[m][k], acc[ai][bj][m][n], 0, 0, 0); __builtin_amdgcn_s_setprio(0); } while (0)
#define PG8_WAIT_V(n) asm volatile("s_waitcnt vmcnt(" #n ")" ::: "memory")
#define PG8_WAIT_L(n) asm volatile("s_waitcnt lgkmcnt(" #n ")" ::: "memory")
#define PG8_BAR __builtin_amdgcn_s_barrier()
#define PG8_SCHED __builtin_amdgcn_sched_barrier(0)
  Unit cur, nxt; int ui = 0;
  if (E.ssq != nullptr) {
    float* sRs = (float*)(smem + 132096);
    Unit uu;
    for (int i = 0; S.next(i, uu); ++i)
      if (tid < 256) sRs[i * 256 + tid] = rstd_row(E.ssq, (size_t)uu.pm * 256 + tid);
    __syncthreads();
  }
  if (!S.next(0, cur)) return;
  f32x4 acc[2][2][4][2];
#pragma unroll
  for (int a = 0; a < 2; ++a)
#pragma unroll
    for (int b = 0; b < 2; ++b)
#pragma unroll
      for (int m = 0; m < 4; ++m)
#pragma unroll
        for (int n = 0; n < 2; ++n) acc[a][b][m][n] = (f32x4){0.f, 0.f, 0.f, 0.f};
  bf16x8 At[4][2], B0[2][2], B1[2][2];
  const char* cA = (const char*)gA + (size_t)cur.pm * tstep; const char* cB = (const char*)gBt + (size_t)cur.pn * tstep;
  PG8_STAGE(PG8_SB(0, 0), cB, voffB); PG8_STAGE(PG8_SA(0, 0), cA, voffA); PG8_STAGE(PG8_SB(0, 1), cB + hstep, voffB); PG8_STAGE(PG8_SA(0, 1), cA + hstep, voffA);
  if (wr == 1) PG8_BAR;
  PG8_WAIT_V(4); PG8_BAR;
  PG8_STAGE(PG8_SB(1, 0), cB + kstep, voffB); PG8_STAGE(PG8_SA(1, 0), cA + kstep, voffA); PG8_STAGE(PG8_SB(1, 1), cB + hstep + kstep, voffB);
  PG8_WAIT_V(6); PG8_BAR;
  for (;;) {
    const bool has_next = S.next(ui + 1, nxt);
    const char* nA = has_next ? (const char*)gA + (size_t)nxt.pm * tstep : cA; const char* nB = has_next ? (const char*)gBt + (size_t)nxt.pn * tstep : cB;
    for (int t = 0; t < nt; t += 2) {
      const bool last = (t == nt - 2);
      const char* a1 = cA + (size_t)(t + 1) * kstep;
      const char* a2 = last ? nA : cA + (size_t)(t + 2) * kstep; const char* b2 = last ? nB : cB + (size_t)(t + 2) * kstep;
      const char* a3 = a2 + kstep; const char* b3 = b2 + kstep;
      PG8_LDB(B0, 0, 0); PG8_SCHED; PG8_LDA(At, 0, 0); PG8_STAGE(PG8_SA(1, 1), a1 + hstep, voffA);
      PG8_WAIT_L(8); PG8_BAR; PG8_WAIT_L(0); PG8_MMA(0, 0, At, B0); PG8_BAR; PG8_SCHED;
      PG8_LDB(B1, 0, 1); PG8_STAGE(PG8_SB(0, 0), b2, voffB);
      PG8_BAR; PG8_WAIT_L(0); PG8_MMA(0, 1, At, B1); PG8_BAR;
      PG8_LDA(At, 0, 1); PG8_STAGE(PG8_SA(0, 0), a2, voffA);
      PG8_BAR; PG8_WAIT_L(0); PG8_MMA(1, 0, At, B0); PG8_BAR; PG8_SCHED;
      PG8_STAGE(PG8_SB(0, 1), b2 + hstep, voffB);
      PG8_WAIT_V(6); PG8_BAR; PG8_MMA(1, 1, At, B1); PG8_BAR;
      PG8_LDB(B0, 1, 0); PG8_SCHED; PG8_LDA(At, 1, 0); PG8_STAGE(PG8_SA(0, 1), a2 + hstep, voffA);
      PG8_WAIT_L(8); PG8_BAR; PG8_WAIT_L(0); PG8_MMA(0, 0, At, B0); PG8_BAR; PG8_SCHED;
      PG8_LDB(B1, 1, 1); PG8_STAGE(PG8_SB(1, 0), b3, voffB);
      PG8_BAR; PG8_WAIT_L(0); PG8_MMA(0, 1, At, B1); PG8_BAR;
      PG8_LDA(At, 1, 1); PG8_STAGE(PG8_SA(1, 0), a3, voffA);
      PG8_BAR; PG8_WAIT_L(0); PG8_MMA(1, 0, At, B0); PG8_BAR; PG8_SCHED;
      PG8_STAGE(PG8_SB(1, 1), b3 + hstep, voffB);
      PG8_WAIT_V(6); PG8_BAR; PG8_MMA(1, 1, At, B1); PG8_BAR;
    }
    E(acc, cur, ui, wr, wc, fr, fq);
    if (!has_next) break;
#pragma unroll
    for (int a = 0; a < 2; ++a)
#pragma unroll
      for (int b = 0; b < 2; ++b)
#pragma unroll
        for (int m = 0; m < 4; ++m)
#pragma unroll
          for (int n = 0; n < 2; ++n) acc[a][b][m][n] = (f32x4){0.f, 0.f, 0.f, 0.f};
    cur = nxt; cA = nA; cB = nB; ++ui;
  }
  PG8_WAIT_V(0);
  if (wr == 0) PG8_BAR;
  PG8_BAR;
#undef PG8_SA
#undef PG8_SB
#undef PG8_STAGE
#undef PG8_LDA
#undef PG8_LDB
#undef PG8_MMA
#undef PG8_WAIT_V
#undef PG8_WAIT_L
#undef PG8_BAR
#undef PG8_SCHED
}

typedef f32x4 Acc8[2][2][4][2];
__device__ __forceinline__ float sumq4(float v) {
  v += __shfl_xor(v, 16); v += __shfl_xor(v, 32);
  return v;
}
__device__ __forceinline__ void rstd8(int ui, int wr, int fr, float (&rs)[2][4]) {
  const float* sRs = (const float*)(smem + 132096) + ui * 256 + wr * 64 + fr;
#pragma unroll
  for (int ai = 0; ai < 2; ++ai)
#pragma unroll
    for (int m = 0; m < 4; ++m) rs[ai][m] = sRs[ai * 128 + m * 16];
}
__device__ __forceinline__ uint4 pack8(f32x4 a, f32x4 b) {
  uint4 o; o.x = pack2(a[0], a[1]); o.y = pack2(a[2], a[3]); o.z = pack2(b[0], b[1]); o.w = pack2(b[2], b[3]); return o;
}
__device__ __forceinline__ void epi8_swiglu(const Acc8& acc, const Unit& u, int ui, int wr, int wc, int fr, int fq, const float* ssq, bf16_t* H) {
  float rs8[2][4];
  rstd8(ui, wr, fr, rs8);
#pragma unroll
  for (int ai = 0; ai < 2; ++ai)
#pragma unroll
    for (int m = 0; m < 4; ++m) {
      const size_t row = (size_t)u.pm * 256 + ai * 128 + wr * 64 + m * 16 + fr;
      const float rs = rs8[ai][m];
      f32x4 h0, h1;
#pragma unroll
      for (int jj = 0; jj < 4; ++jj) {
        float g0 = acc[ai][0][m][0][jj] * rs, u0 = acc[ai][1][m][0][jj] * rs, g1 = acc[ai][0][m][1][jj] * rs, u1 = acc[ai][1][m][1][jj] * rs;
        h0[jj] = g0 * __builtin_amdgcn_rcpf(1.f + __expf(-g0)) * u0;
        h1[jj] = g1 * __builtin_amdgcn_rcpf(1.f + __expf(-g1)) * u1;
      }
      *(uint4*)(H + row * 2816 + u.pn * 128 + wc * 32 + fq * 8) = pack8(h0, h1);
    }
}
__device__ __forceinline__ void epi8_plain(const Acc8& acc, const Unit& u, int ui, int wr, int wc, int fr, int fq, const float* ssq, bf16_t* dst, int ld, int col0) {
  float rs8[2][4];
  rstd8(ui, wr, fr, rs8);
#pragma unroll
  for (int ai = 0; ai < 2; ++ai)
#pragma unroll
    for (int m = 0; m < 4; ++m) {
      const size_t row = (size_t)u.pm * 256 + ai * 128 + wr * 64 + m * 16 + fr;
      const float rs = rs8[ai][m];
#pragma unroll
      for (int bj = 0; bj < 2; ++bj)
        *(uint4*)(dst + row * ld + col0 + bj * 128 + wc * 32 + fq * 8) = pack8(acc[ai][bj][m][0] * rs, acc[ai][bj][m][1] * rs);
    }
}
__device__ __forceinline__ void epi8_headnorm(const Acc8& acc, const Unit& u, int ui, int wr, int wc, int fr, int fq, const float* ssq, const float* gain,
                                              float scale, bf16_t* dst, int ld, int colbase) {
  f32x4 gn[2][2];
#pragma unroll
  for (int bj = 0; bj < 2; ++bj)
#pragma unroll
    for (int n = 0; n < 2; ++n) gn[bj][n] = *(const f32x4*)(gain + bj * 32 + fq * 8 + n * 4) * scale;
  VMWAIT();
  float rs8[2][4];
  rstd8(ui, wr, fr, rs8);
#pragma unroll
  for (int ai = 0; ai < 2; ++ai)
#pragma unroll
    for (int m = 0; m < 4; ++m) {
      const size_t row = (size_t)u.pm * 256 + ai * 128 + wr * 64 + m * 16 + fr;
      const float rs = rs8[ai][m];
      float ss = 0.f;
#pragma unroll
      for (int bj = 0; bj < 2; ++bj)
#pragma unroll
        for (int n = 0; n < 2; ++n) {
          const f32x4 a = acc[ai][bj][m][n];
          ss += a[0] * a[0] + a[1] * a[1] + a[2] * a[2] + a[3] * a[3];
        }
      ss = sumq4(ss) * rs * rs;
      const float r2 = rsqrtf(ss * (1.f / 64.f) + EPS) * rs;
#pragma unroll
      for (int bj = 0; bj < 2; ++bj)
        *(uint4*)(dst + row * ld + colbase + wc * 64 + bj * 32 + fq * 8) = pack8(acc[ai][bj][m][0] * r2 * gn[bj][0], acc[ai][bj][m][1] * r2 * gn[bj][1]);
    }
}

struct Epi8Swiglu {
  static constexpr bool PERM = true;
  const float* ssq; bf16_t* H;
  __device__ __forceinline__ void operator()(const Acc8& acc, const Unit& u, int ui, int wr, int wc, int fr, int fq) const { epi8_swiglu(acc, u, ui, wr, wc, fr, fq, ssq, H); }
};
struct Epi8Resid {
  static constexpr bool PERM = false;
  static constexpr const float* ssq = nullptr;
  const float* xin; float* xout; bf16_t* xb; float* ssqo; float scale;
  __device__ __forceinline__ void operator()(const Acc8& acc, const Unit& u, int ui, int wr, int wc, int fr, int fq) const {
#pragma unroll
    for (int ai = 0; ai < 2; ++ai)
#pragma unroll
      for (int mh = 0; mh < 2; ++mh) {
        f32x4 xv[2][2][2];
#pragma unroll
        for (int m2 = 0; m2 < 2; ++m2)
#pragma unroll
          for (int bj = 0; bj < 2; ++bj)
#pragma unroll
            for (int n = 0; n < 2; ++n)
              xv[m2][bj][n] = *(const f32x4*)(xin + ((size_t)u.pm * 256 + ai * 128 + wr * 64 + (mh * 2 + m2) * 16 + fr) * 1024 + u.pn * 256 + bj * 128 + wc * 32 + n * 16 + fq * 4);
        VMWAIT();
#pragma unroll
        for (int m2 = 0; m2 < 2; ++m2) {
          const int m = mh * 2 + m2;
          const size_t row = (size_t)u.pm * 256 + ai * 128 + wr * 64 + m * 16 + fr;
          float ss = 0.f;
#pragma unroll
          for (int bj = 0; bj < 2; ++bj)
#pragma unroll
            for (int n = 0; n < 2; ++n) {
              const size_t idx = row * 1024 + u.pn * 256 + bj * 128 + wc * 32 + n * 16 + fq * 4;
              f32x4 v = xv[m2][bj][n] + acc[ai][bj][m][n] * scale;
              *(f32x4*)(xout + idx) = v;
              if (xb != nullptr) { uint2 o; o.x = pack2(v[0], v[1]); o.y = pack2(v[2], v[3]); *(uint2*)(xb + idx) = o; }
              ss += v[0] * v[0] + v[1] * v[1] + v[2] * v[2] + v[3] * v[3];
            }
          ss = sumq4(ss);
          if (fq == 0 && xb != nullptr) ssqo[row * 16 + u.pn * 4 + wc] = ss;
        }
      }
  }
};
struct Epi8InProj {
  static constexpr bool PERM = true;
  const float* ssq; bf16_t* Pbase; bf16_t* Cat; float* G; const float* mq_gain; const float* gate_bias;
  __device__ __forceinline__ void operator()(const Acc8& acc, const Unit& u, int ui, int wr, int wc, int fr, int fq) const {
    if (u.pn < 12) {
      const int arr = u.pn / 3, c0 = (u.pn - arr * 3) * 256;
      epi8_plain(acc, u, ui, wr, wc, fr, fq, ssq, Pbase + (size_t)arr * kT * 768, 768, c0);
    } else if (u.pn == 12) {
      epi8_headnorm(acc, u, ui, wr, wc, fr, fq, ssq, mq_gain, 0.125f, Cat, 1024, 768);
    } else if (wc == 0) {
      float rs8[2][4];
      rstd8(ui, wr, fr, rs8);
      if (fq == 0) {
#pragma unroll
        for (int ai = 0; ai < 2; ++ai)
#pragma unroll
          for (int m = 0; m < 4; ++m) {
            const size_t row = (size_t)u.pm * 256 + ai * 128 + wr * 64 + m * 16 + fr;
            *(f32x4*)(G + row * 8) = acc[ai][0][m][0] * rs8[ai][m];
            *(f32x4*)(G + row * 8 + 4) = acc[ai][0][m][1] * rs8[ai][m];
          }
      }
    }
  }
};
struct Epi8KvFfn {
  static constexpr bool PERM = true;
  const float* ssq; bf16_t* H; bf16_t* Ksh; bf16_t* Vtmp; const float* kgain;
  __device__ __forceinline__ void operator()(const Acc8& acc, const Unit& u, int ui, int wr, int wc, int fr, int fq) const {
    if (u.pn < 22) epi8_swiglu(acc, u, ui, wr, wc, fr, fq, ssq, H);
    else if (u.pn < 25) epi8_headnorm(acc, u, ui, wr, wc, fr, fq, ssq, kgain, 1.f, Ksh, 768, (u.pn - 22) * 256);
    else epi8_plain(acc, u, ui, wr, wc, fr, fq, ssq, Vtmp, 768, (u.pn - 25) * 256);
  }
};
struct Epi8QProj {
  static constexpr bool PERM = true;
  const float* ssq; bf16_t* Cat; const float* qgain; const float* mqgain;
  __device__ __forceinline__ void operator()(const Acc8& acc, const Unit& u, int ui, int wr, int wc, int fr, int fq) const {
    epi8_headnorm(acc, u, ui, wr, wc, fr, fq, ssq, (u.pn < 3) ? qgain : mqgain, 0.125f, Cat, 1024, u.pn * 256);
  }
};
struct Epi8MemKv {
  static constexpr bool PERM = true;
  const float* ssq; bf16_t* Kmem; bf16_t* Vtok; const float* kgain;
  __device__ __forceinline__ void operator()(const Acc8& acc, const Unit& u, int ui, int wr, int wc, int fr, int fq) const {
    if (u.pn == 0) epi8_headnorm(acc, u, ui, wr, wc, fr, fq, ssq, kgain, 1.f, Kmem, 256, 0);
    else epi8_plain(acc, u, ui, wr, wc, fr, fq, ssq, Vtok, 256, 0);
  }
};
__device__ __forceinline__ void memv_transpose(const bf16_t* Vtok, bf16_t* VmT) {
  for (int i = blockIdx.x * NTHR + threadIdx.x; i < 2 * 512 * 256; i += gridDim.x * NTHR) {
    const int mm = i & 255, e = (i >> 8) & 255, lb = i >> 16;
    VmT[i] = Vtok[((size_t)lb * 256 + mm) * 256 + e];
  }
}

__device__ __forceinline__ void phase_vtranspose(const bf16_t* Vtmp, bf16_t* VshT) {
  bf16_t* sT = (bf16_t*)smem;
  const int tid = threadIdx.x;
  for (int item = blockIdx.x; item < 256 * 12; item += gridDim.x) {
    const int head = item % 12, tt = item / 12, tokbase = tt * 128, b = tokbase / kS, pos0 = tokbase - b * kS;
    const int g = head >> 2, d = 1 << (2 * g);
    __syncthreads();
    for (int it = tid; it < 128 * 8; it += NTHR) {
      const int t = it >> 3, e8 = (it & 7) * 8;
      uint4 v = *(const uint4*)(Vtmp + (size_t)(tokbase + t) * 768 + head * 64 + e8);
      sT[(e8 + 0) * 138 + t] = (bf16_t)(v.x & 0xffff); sT[(e8 + 1) * 138 + t] = (bf16_t)(v.x >> 16);
      sT[(e8 + 2) * 138 + t] = (bf16_t)(v.y & 0xffff); sT[(e8 + 3) * 138 + t] = (bf16_t)(v.y >> 16);
      sT[(e8 + 4) * 138 + t] = (bf16_t)(v.z & 0xffff); sT[(e8 + 5) * 138 + t] = (bf16_t)(v.z >> 16);
      sT[(e8 + 6) * 138 + t] = (bf16_t)(v.w & 0xffff); sT[(e8 + 7) * 138 + t] = (bf16_t)(v.w >> 16);
    }
    __syncthreads();
    for (int pc = tid; pc < 64 * 16; pc += NTHR) {
      const int e = pc >> 4, piece = pc & 15;
      const int rr = (g == 0) ? 0 : (g == 1) ? (piece >> 2) : piece;
      const int s8 = (g == 0) ? piece : (g == 1) ? (piece & 3) : 0;
      const bf16_t* src = sT + e * 138 + rr;
      uint4 o;
      o.x = (uint32_t)src[(s8 * 8 + 0) * d] | ((uint32_t)src[(s8 * 8 + 1) * d] << 16);
      o.y = (uint32_t)src[(s8 * 8 + 2) * d] | ((uint32_t)src[(s8 * 8 + 3) * d] << 16);
      o.z = (uint32_t)src[(s8 * 8 + 4) * d] | ((uint32_t)src[(s8 * 8 + 5) * d] << 16);
      o.w = (uint32_t)src[(s8 * 8 + 6) * d] | ((uint32_t)src[(s8 * 8 + 7) * d] << 16);
      *(uint4*)(VshT + ((size_t)(b * 12 + head) * 64 + e) * kS + rr * (kS / d) + pos0 / d + s8 * 8) = o;
    }
  }
}

__device__ __forceinline__ bf16x8 u4_to_frag(uint4 v) { return __builtin_bit_cast(bf16x8, v); }
__device__ __forceinline__ uint4 mul_bf16x8(uint4 a, uint4 b) {
  uint4 o;
  o.x = pack2(bflo(a.x) * bflo(b.x), bfhi(a.x) * bfhi(b.x));
  o.y = pack2(bflo(a.y) * bflo(b.y), bfhi(a.y) * bfhi(b.y));
  o.z = pack2(bflo(a.z) * bflo(b.z), bfhi(a.z) * bfhi(b.z));
  o.w = pack2(bflo(a.w) * bflo(b.w), bfhi(a.w) * bfhi(b.w));
  return o;
}

__device__ __forceinline__ void phase_prep(const Params& P) {
  const bf16_t* Pk = (const bf16_t*)(P.ws + OFF_R1) + (size_t)kT * 768;
  const bf16_t* Pv = Pk + (size_t)kT * 768;
  bf16_t* kc = (bf16_t*)(P.ws + OFF_XB);
  bf16_t* kTt = (bf16_t*)(P.ws + OFF_R2);
  bf16_t* VT = kTt + (size_t)kT * 768;
  const float* G = (const float*)(P.ws + OFF_G);
  float* uArr = (float*)(P.ws + OFF_U);
  float* bArr = (float*)(P.ws + OFF_BC);
  bf16_t* eW = (bf16_t*)(P.ws + OFF_EW);
  float* umaxA = (float*)(P.ws + OFF_UMAX);
  float* blA = (float*)(P.ws + OFF_BL);
  bf16_t* sX = (bf16_t*)smem;
  float* sF = (float*)(smem + 51200);
  const int tid = threadIdx.x;
  const float kscale = 0.07216878364870322f;
  for (int item = blockIdx.x; item < 1024; item += gridDim.x) {
    const int bh = item >> 7, c = item & 127, b = bh >> 2, h = bh & 3;
    const size_t tok0 = (size_t)b * kS + (size_t)c * 128;
    __syncthreads();
    float ig = 0.f;
    if (tid < 128) {
      ig = G[(tok0 + tid) * 8 + h] + P.a_gate_bias[h];
      float fg = G[(tok0 + tid) * 8 + 4 + h] + P.a_gate_bias[4 + h];
      sF[tid] = fminf(fg, 0.f) - log1pf(__expf(-fabsf(fg)));
    }
    __syncthreads();
    float bt = 0.f;
    if (tid < 128) for (int s2 = 0; s2 <= tid; ++s2) bt += sF[s2];
    const float ut = ig - bt;
    __syncthreads();
    if (tid < 128) sF[tid] = ut;
    __syncthreads();
    float um = -3.0e38f;
    for (int s2 = 0; s2 < 128; ++s2) um = fmaxf(um, sF[s2]);
    if (tid < 128) {
      uArr[(size_t)item * 128 + tid] = ut;
      bArr[(size_t)item * 128 + tid] = bt;
      eW[(size_t)item * 128 + tid] = f2bf(__expf(ut - um));
      if (tid == 127) blA[item] = bt;
      if (tid == 0) umaxA[item] = um;
    }
    for (int it = tid; it < 128 * 24; it += NTHR) {
      const int t = it / 24, ch = (it - t * 24) * 8;
      const int spos = c * 128 + t;
      const bf16_t* src = Pk + (tok0 + t) * 768 + h * 192 + ch;
      uint4 xv[4];
      float4 w0[4], w1[4];
#pragma unroll
      for (int j = 0; j < 4; ++j) {
        xv[j] = make_uint4(0u, 0u, 0u, 0u);
        if (spos - 3 + j >= 0) xv[j] = *(const uint4*)(src - (ptrdiff_t)(3 - j) * 768);
        const float4* wp = (const float4*)(P.a_conv + j * 1536 + 768 + h * 192 + ch);
        w0[j] = wp[0]; w1[j] = wp[1];
      }
      VMWAIT();
      float a[8] = {0.f, 0.f, 0.f, 0.f, 0.f, 0.f, 0.f, 0.f};
#pragma unroll
      for (int j = 0; j < 4; ++j) {
        a[0] += w0[j].x * bflo(xv[j].x); a[1] += w0[j].y * bfhi(xv[j].x); a[2] += w0[j].z * bflo(xv[j].y); a[3] += w0[j].w * bfhi(xv[j].y);
        a[4] += w1[j].x * bflo(xv[j].z); a[5] += w1[j].y * bfhi(xv[j].z); a[6] += w1[j].z * bflo(xv[j].w); a[7] += w1[j].w * bfhi(xv[j].w);
      }
#pragma unroll
      for (int e = 0; e < 8; ++e) a[e] = a[e] / (1.f + __expf(-a[e])) * kscale;
      uint4 o; o.x = pack2(a[0], a[1]); o.y = pack2(a[2], a[3]); o.z = pack2(a[4], a[5]); o.w = pack2(a[6], a[7]);
      *(uint4*)(kc + (tok0 + t) * 768 + h * 192 + ch) = o;
      *(uint4*)(sX + t * 200 + ch) = o;
    }
    __syncthreads();
    for (int it = tid; it < 192 * 16; it += NTHR) {
      const int k = it >> 4, lg = it & 15;
      uint4 o;
      o.x = (uint32_t)sX[(lg * 8 + 0) * 200 + k] | ((uint32_t)sX[(lg * 8 + 1) * 200 + k] << 16);
      o.y = (uint32_t)sX[(lg * 8 + 2) * 200 + k] | ((uint32_t)sX[(lg * 8 + 3) * 200 + k] << 16);
      o.z = (uint32_t)sX[(lg * 8 + 4) * 200 + k] | ((uint32_t)sX[(lg * 8 + 5) * 200 + k] << 16);
      o.w = (uint32_t)sX[(lg * 8 + 6) * 200 + k] | ((uint32_t)sX[(lg * 8 + 7) * 200 + k] << 16);
      *(uint4*)(kTt + ((size_t)item * 192 + k) * 128 + lg * 8) = o;
    }
    __syncthreads();
    for (int it = tid; it < 128 * 24; it += NTHR) {
      const int t = it / 24, ch = (it - t * 24) * 8;
      uint4 v = *(const uint4*)(Pv + (tok0 + t) * 768 + h * 192 + ch);
      *(uint4*)(sX + t * 200 + ch) = v;
    }
    __syncthreads();
    for (int it = tid; it < 192 * 16; it += NTHR) {
      const int k = it >> 4, lg = it & 15;
      uint4 o;
      o.x = (uint32_t)sX[(lg * 8 + 0) * 200 + k] | ((uint32_t)sX[(lg * 8 + 1) * 200 + k] << 16);
      o.y = (uint32_t)sX[(lg * 8 + 2) * 200 + k] | ((uint32_t)sX[(lg * 8 + 3) * 200 + k] << 16);
      o.z = (uint32_t)sX[(lg * 8 + 4) * 200 + k] | ((uint32_t)sX[(lg * 8 + 5) * 200 + k] << 16);
      o.w = (uint32_t)sX[(lg * 8 + 6) * 200 + k] | ((uint32_t)sX[(lg * 8 + 7) * 200 + k] << 16);
      *(uint4*)(VT + ((size_t)item * 192 + k) * 128 + lg * 8) = o;
    }
  }
}

__device__ __forceinline__ void phase_scan(const Params& P) {
  const bf16_t* kTt = (const bf16_t*)(P.ws + OFF_R2);
  const bf16_t* VT = kTt + (size_t)kT * 768;
  const bf16_t* eW = (const bf16_t*)(P.ws + OFF_EW);
  const float* umaxA = (const float*)(P.ws + OFF_UMAX);
  const float* blA = (const float*)(P.ws + OFF_BL);
  float* m0A = (float*)(P.ws + OFF_M0);
  bf16_t* C0T = (bf16_t*)(P.ws + OFF_R1) + (size_t)kT * 768;
  const int lane = threadIdx.x & 63, wid = threadIdx.x >> 6, nw = gridDim.x * NWAVE;
  const int r = lane & 15, q = lane >> 4;
  for (int unit = wid * gridDim.x + blockIdx.x; unit < 416; unit += nw) {
    const int bh = unit / 52, rem = unit - bh * 52, mv = rem >> 2, nk = rem & 3;
    const bf16_t* vt_base = VT + ((size_t)bh * 128 * 192 + (mv < 12 ? mv : 0) * 16 + r) * 128 + q * 8;
    const bf16_t* kt_base = kTt + ((size_t)bh * 128 * 192 + nk * 48 + r) * 128 + q * 8;
    const bf16_t* ew_base = eW + (size_t)bh * 128 * 128 + q * 8;
    bf16_t* c0_base = C0T + ((size_t)bh * 128 * 208 + mv * 16 + q * 4) * 192 + nk * 48 + r;
    f32x4 acc[3];
#pragma unroll
    for (int n = 0; n < 3; ++n) acc[n] = (f32x4){0.f, 0.f, 0.f, 0.f};
    float m = 0.f;
    uint4 A[4], B[3][4], E[4];
    float bl, um;
#define SCAN_LOAD(A_, B_, E_, bl_, um_, cc)                                                            \
  do {                                                                                                 \
    _Pragma("unroll") for (int ks = 0; ks < 4; ++ks) {                                                 \
      A_[ks] = *(const uint4*)(vt_base + (size_t)(cc) * 192 * 128 + ks * 32);                          \
      E_[ks] = *(const uint4*)(ew_base + (size_t)(cc) * 128 + ks * 32);                                \
      _Pragma("unroll") for (int n = 0; n < 3; ++n)                                                    \
        B_[n][ks] = *(const uint4*)(kt_base + (size_t)(cc) * 192 * 128 + (size_t)n * 16 * 128 + ks * 32); \
    }                                                                                                  \
    bl_ = blA[bh * 128 + (cc)]; um_ = umaxA[bh * 128 + (cc)];                                          \
  } while (0)
    SCAN_LOAD(A, B, E, bl, um, 0);
    VMWAIT();
    for (int c = 0; c < 128; ++c) {
#pragma unroll
      for (int n = 0; n < 3; ++n)
#pragma unroll
        for (int j = 0; j < 4; ++j) c0_base[(size_t)c * 208 * 192 + j * 192 + n * 16] = f2bf(acc[n][j]);
      if (rem == 0 && lane == 0) m0A[bh * 128 + c] = m;
      uint4 nA[4], nB[3][4], nE[4];
      float nbl = 0.f, num = 0.f;
      const int cn = (c + 1 < 128) ? c + 1 : c;
      SCAN_LOAD(nA, nB, nE, nbl, num, cn);
      const float mn = fmaxf(bl + m, bl + um);
      const float decay = __expf(bl + m - mn), sc = __expf(um + bl - mn);
      m = mn;
      f32x4 U[3];
#pragma unroll
      for (int n = 0; n < 3; ++n) U[n] = (f32x4){0.f, 0.f, 0.f, 0.f};
#pragma unroll
      for (int ks = 0; ks < 4; ++ks) {
        uint4 af;
        if (mv < 12) af = mul_bf16x8(A[ks], E[ks]);
        else af = (r == 0) ? E[ks] : make_uint4(0u, 0u, 0u, 0u);
#pragma unroll
        for (int n = 0; n < 3; ++n)
          U[n] = __builtin_amdgcn_mfma_f32_16x16x32_bf16(u4_to_frag(af), u4_to_frag(B[n][ks]), U[n], 0, 0, 0);
      }
#pragma unroll
      for (int n = 0; n < 3; ++n)
#pragma unroll
        for (int j = 0; j < 4; ++j) acc[n][j] = acc[n][j] * decay + sc * U[n][j];
      VMWAIT();
#pragma unroll
      for (int ks = 0; ks < 4; ++ks) {
        A[ks] = nA[ks]; E[ks] = nE[ks];
#pragma unroll
        for (int n = 0; n < 3; ++n) B[n][ks] = nB[n][ks];
      }
      bl = nbl; um = num;
    }
#undef SCAN_LOAD
  }
}

__device__ __forceinline__ void phase_chunk(const Params& P) {
  const bf16_t* Pq = (const bf16_t*)(P.ws + OFF_R1);
  const bf16_t* Po = Pq + (size_t)3 * kT * 768;
  const bf16_t* C0T = Pq + (size_t)kT * 768;
  const bf16_t* kc = (const bf16_t*)(P.ws + OFF_XB);
  const bf16_t* VT = (const bf16_t*)(P.ws + OFF_R2) + (size_t)kT * 768;
  const float* uArr = (const float*)(P.ws + OFF_U);
  const float* bArr = (const float*)(P.ws + OFF_BC);
  const float* m0A = (const float*)(P.ws + OFF_M0);
  bf16_t* Cat = (bf16_t*)(P.ws + OFF_CAT);
  bf16_t* sQ = (bf16_t*)smem;
  float* sU = (float*)(smem + 51200);
  float* sMx = (float*)(smem + 51712);
  float* sBt = (float*)(smem + 52224);
  float* sCw = (float*)(smem + 52736);
  const int tid = threadIdx.x, lane = tid & 63, wid = tid >> 6, r = lane & 15, q = lane >> 4;
  bf16_t* sWw = (bf16_t*)(smem + 55808) + wid * (16 * 136);
  for (int item = blockIdx.x; item < 1024; item += gridDim.x) {
    const int bh = item >> 7, c = item & 127, b = bh >> 2, h = bh & 3;
    const size_t tok0 = (size_t)b * kS + (size_t)c * 128;
    __syncthreads();
    for (int i = tid; i < 768; i += NTHR) { int j = i / 192, ch = i - j * 192; sCw[i] = P.a_conv[j * 1536 + h * 192 + ch]; }
    if (tid < 128) { sU[tid] = uArr[(size_t)item * 128 + tid]; sBt[tid] = bArr[(size_t)item * 128 + tid]; }
    const float m0 = m0A[item];
    __syncthreads();
    if (tid < 128) {
      float mx = m0;
      for (int s2 = 0; s2 <= tid; ++s2) mx = fmaxf(mx, sU[s2]);
      sMx[tid] = mx;
    }
    for (int it = tid; it < 128 * 24; it += NTHR) {
      const int t = it / 24, ch = (it - t * 24) * 8;
      const int spos = c * 128 + t;
      const bf16_t* src = Pq + (tok0 + t) * 768 + h * 192 + ch;
      float a[8] = {0.f, 0.f, 0.f, 0.f, 0.f, 0.f, 0.f, 0.f};
#pragma unroll
      for (int j = 0; j < 4; ++j) {
        uint4 xv = make_uint4(0u, 0u, 0u, 0u);
        if (spos - 3 + j >= 0) xv = *(const uint4*)(src - (ptrdiff_t)(3 - j) * 768);
        const float* w = sCw + j * 192 + ch;
        a[0] += w[0] * bflo(xv.x); a[1] += w[1] * bfhi(xv.x); a[2] += w[2] * bflo(xv.y); a[3] += w[3] * bfhi(xv.y);
        a[4] += w[4] * bflo(xv.z); a[5] += w[5] * bfhi(xv.z); a[6] += w[6] * bflo(xv.w); a[7] += w[7] * bfhi(xv.w);
      }
#pragma unroll
      for (int e = 0; e < 8; ++e) a[e] = a[e] / (1.f + __expf(-a[e]));
      uint4 o; o.x = pack2(a[0], a[1]); o.y = pack2(a[2], a[3]); o.z = pack2(a[4], a[5]); o.w = pack2(a[6], a[7]);
      *(uint4*)(sQ + t * 200 + ch) = o;
    }
    __syncthreads();
    {
      const int t0 = wid * 16, nmax = t0 >> 4, ks2max = (t0 + 15) >> 5;
      {
        bf16x8 Qf[6];
#pragma unroll
        for (int ks = 0; ks < 6; ++ks) Qf[ks] = *(const bf16x8*)(sQ + (t0 + r) * 200 + ks * 32 + q * 8);
        float mxr[4];
#pragma unroll
        for (int j = 0; j < 4; ++j) mxr[j] = sMx[t0 + q * 4 + j];
#pragma unroll
        for (int n = 0; n < 8; ++n) {
          f32x4 sa = (f32x4){0.f, 0.f, 0.f, 0.f};
          if (n <= nmax) {
            uint4 Kf[6];
#pragma unroll
            for (int ks = 0; ks < 6; ++ks) Kf[ks] = *(const uint4*)(kc + (tok0 + n * 16 + r) * 768 + h * 192 + ks * 32 + q * 8);
#pragma unroll
            for (int ks = 0; ks < 6; ++ks) sa = __builtin_amdgcn_mfma_f32_16x16x32_bf16(Qf[ks], u4_to_frag(Kf[ks]), sa, 0, 0, 0);
          }
          const int scol = n * 16 + r;
          const float us = sU[scol];
#pragma unroll
          for (int j = 0; j < 4; ++j) {
            const int trow = t0 + q * 4 + j;
            float w = (n <= nmax && scol <= trow) ? __expf(us - mxr[j]) * sa[j] : 0.f;
            sWw[(q * 4 + j) * 136 + scol] = f2bf(w);
          }
        }
      }
      f32x4 acc[13];
#pragma unroll
      for (int nv = 0; nv < 13; ++nv) acc[nv] = (f32x4){0.f, 0.f, 0.f, 0.f};
#pragma unroll 1
      for (int ks = 0; ks < 6; ++ks) {
        const bf16x8 qf = *(const bf16x8*)(sQ + (t0 + r) * 200 + ks * 32 + q * 8);
        uint4 Bf[13];
#pragma unroll
        for (int nv = 0; nv < 13; ++nv) Bf[nv] = *(const uint4*)(C0T + ((size_t)item * 208 + nv * 16 + r) * 192 + ks * 32 + q * 8);
#pragma unroll
        for (int nv = 0; nv < 13; ++nv) acc[nv] = __builtin_amdgcn_mfma_f32_16x16x32_bf16(qf, u4_to_frag(Bf[nv]), acc[nv], 0, 0, 0);
      }
#pragma unroll
      for (int j = 0; j < 4; ++j) {
        const float inter = __expf(m0 - sMx[t0 + q * 4 + j]);
#pragma unroll
        for (int nv = 0; nv < 13; ++nv) acc[nv][j] *= inter;
      }
#pragma unroll 1
      for (int ks2 = 0; ks2 <= ks2max; ++ks2) {
        const bf16x8 wf = *(const bf16x8*)(sWw + r * 136 + ks2 * 32 + q * 8);
        uint4 Bf[12];
#pragma unroll
        for (int nv = 0; nv < 12; ++nv) Bf[nv] = *(const uint4*)(VT + ((size_t)item * 192 + nv * 16 + r) * 128 + ks2 * 32 + q * 8);
#pragma unroll
        for (int nv = 0; nv < 12; ++nv) acc[nv] = __builtin_amdgcn_mfma_f32_16x16x32_bf16(wf, u4_to_frag(Bf[nv]), acc[nv], 0, 0, 0);
        const uint32_t one2 = (r == 0) ? 0x3F803F80u : 0u;
        acc[12] = __builtin_amdgcn_mfma_f32_16x16x32_bf16(wf, u4_to_frag(make_uint4(one2, one2, one2, one2)), acc[12], 0, 0, 0);
      }
      float hg[12];
#pragma unroll
      for (int nv = 0; nv < 12; ++nv) hg[nv] = P.a_h_norm[h * 192 + nv * 16 + r];
#pragma unroll 1
      for (int j = 0; j < 4; ++j) {
        const int trow = t0 + q * 4 + j;
        const size_t tok = tok0 + trow;
        float og[12];
#pragma unroll
        for (int nv = 0; nv < 12; ++nv) og[nv] = bf2f(Po[tok * 768 + h * 192 + nv * 16 + r]);
        float accj[13];
#pragma unroll
        for (int nv = 0; nv < 13; ++nv) accj[nv] = (j == 0) ? acc[nv][0] : (j == 1) ? acc[nv][1] : (j == 2) ? acc[nv][2] : acc[nv][3];
        const float den = __shfl(accj[12], lane & 48);
        const float mt = sBt[trow] + sMx[trow];
        const float inv = 1.f / fmaxf(fabsf(den), __expf(-mt));
        float ss = 0.f;
#pragma unroll
        for (int nv = 0; nv < 12; ++nv) { accj[nv] *= inv; ss += accj[nv] * accj[nv]; }
        ss = sum16(ss);
        const float rstd = rsqrtf(ss * (1.f / 192.f) + EPS);
        VMWAIT();
#pragma unroll
        for (int nv = 0; nv < 12; ++nv)
          Cat[tok * 1024 + h * 192 + nv * 16 + r] = f2bf(accj[nv] * rstd * hg[nv] * sigmoidf_(og[nv]));
      }
    }
  }
}

__device__ __forceinline__ float t5_bias(const float* rel_bias, int dist, int head) {
  int bucket;
  if (dist < 16) bucket = dist;
  else {
    int large = 16 + (int)(logf((float)dist / 16.f) / 4.852030263919617f * 16.f);
    bucket = large < 31 ? large : 31;
  }
  return rel_bias[bucket * 12 + head];
}

__device__ __forceinline__ void memattn_mfma(const Params& P, int layer, int gw, int nw) {
  bf16_t* Cat = (bf16_t*)(P.ws + OFF_CAT);
  const bf16_t* Kmem = (const bf16_t*)(P.ws + OFF_KMEM) + (size_t)layer * 512 * 256;
  const bf16_t* VmT = (const bf16_t*)(P.ws + OFF_VMEM) + (size_t)layer * 512 * 256;
  const int lane = threadIdx.x & 63, wid = threadIdx.x >> 6, r = lane & 15, q = lane >> 4;
  bf16_t* sP = (bf16_t*)smem + wid * (16 * 264);
  if (gw < 0) return;
  for (int item = gw; item < (kT / 16) * 4; item += nw) {
    const int head = item & 3;
    const size_t tok0 = (size_t)(item >> 2) * 16;
    const int b = (int)(tok0 / kS);
    bf16_t* qbase = Cat + tok0 * 1024 + 768 + head * 64;
    const uint4 qf0 = *(const uint4*)(qbase + (size_t)r * 1024 + q * 8);
    const uint4 qf1 = *(const uint4*)(qbase + (size_t)r * 1024 + 32 + q * 8);
    const bf16_t* Kb = Kmem + (size_t)b * 256 * 256 + head * 64 + q * 8;
    f32x4 sa[16];
#pragma unroll
    for (int n = 0; n < 16; ++n) {
      const uint4 k0 = *(const uint4*)(Kb + (size_t)(n * 16 + r) * 256);
      const uint4 k1 = *(const uint4*)(Kb + (size_t)(n * 16 + r) * 256 + 32);
      sa[n] = __builtin_amdgcn_mfma_f32_16x16x32_bf16(u4_to_frag(qf0), u4_to_frag(k0), (f32x4){0.f, 0.f, 0.f, 0.f}, 0, 0, 0);
      sa[n] = __builtin_amdgcn_mfma_f32_16x16x32_bf16(u4_to_frag(qf1), u4_to_frag(k1), sa[n], 0, 0, 0);
      if ((n & 3) == 3) __builtin_amdgcn_sched_barrier(0);
    }
    float inv[4];
#pragma unroll
    for (int j = 0; j < 4; ++j) {
      float mx = sa[0][j];
#pragma unroll
      for (int n = 1; n < 16; ++n) mx = fmaxf(mx, sa[n][j]);
      mx = max16(mx);
      float sum = 0.f;
#pragma unroll
      for (int n = 0; n < 16; ++n) {
        float p = __expf(sa[n][j] - mx);
        sum += p;
        sP[(q * 4 + j) * 264 + n * 16 + r] = f2bf(p);
      }
      inv[j] = 1.f / sum16(sum);
    }
    f32x4 o[4];
#pragma unroll
    for (int ne = 0; ne < 4; ++ne) o[ne] = (f32x4){0.f, 0.f, 0.f, 0.f};
    const bf16_t* Vb = VmT + (size_t)(b * 4 + head) * 64 * 256 + q * 8;
#pragma unroll
    for (int ks = 0; ks < 8; ++ks) {
      const bf16x8 pf = *(const bf16x8*)(sP + r * 264 + ks * 32 + q * 8);
#pragma unroll
      for (int ne = 0; ne < 4; ++ne) {
        const uint4 vf = *(const uint4*)(Vb + (size_t)(ne * 16 + r) * 256 + ks * 32);
        o[ne] = __builtin_amdgcn_mfma_f32_16x16x32_bf16(pf, u4_to_frag(vf), o[ne], 0, 0, 0);
      }
      if (ks & 1) __builtin_amdgcn_sched_barrier(0);
    }
    VMWAIT();
#pragma unroll
    for (int ne = 0; ne < 4; ++ne)
#pragma unroll
      for (int j = 0; j < 4; ++j) qbase[(size_t)(q * 4 + j) * 1024 + ne * 16 + r] = f2bf(o[ne][j] * inv[j]);
  }
}

__device__ __forceinline__ void dilated_slab(const Params& P, int pass, int sidx, int b, int p0, int hg, const float* sBias,
                                             float* sLse, bf16_t* sP) {
  bf16_t* Cat = (bf16_t*)(P.ws + OFF_CAT);
  const bf16_t* Ksh = (const bf16_t*)(P.ws + OFF_R2);
  const bf16_t* VshT = Ksh + (size_t)kT * 768;
  const int lane = threadIdx.x & 63, r = lane & 15, q = lane >> 4;
  const int g = sidx >> 4, i = sidx & 15, d = 1 << (2 * g), head = g * 4 + hg;
  const int r_res = (g == 0) ? 0 : (g == 1) ? (i >> 2) : i;
  const int sig0 = (g == 0) ? (p0 + 16 * i) : (g == 1) ? ((p0 >> 2) + 16 * (i & 3)) : (p0 >> 4);
  const size_t tokq = (size_t)b * kS + (size_t)(sig0 + r) * d + r_res;
  const uint4 qf0 = *(const uint4*)(Cat + tokq * 1024 + head * 64 + q * 8);
  const uint4 qf1 = *(const uint4*)(Cat + tokq * 1024 + head * 64 + 32 + q * 8);
  f32x4 sa[10];
  sa[0] = (f32x4){0.f, 0.f, 0.f, 0.f};
#pragma unroll
  for (int n = 1; n < 10; ++n) {
    int sigk = sig0 - 144 + n * 16 + r;
    sigk = sigk < 0 ? 0 : sigk;
    const bf16_t* kp = Ksh + ((size_t)b * kS + (size_t)sigk * d + r_res) * 768 + head * 64 + q * 8;
    const uint4 k0 = *(const uint4*)kp;
    const uint4 k1 = *(const uint4*)(kp + 32);
    sa[n] = __builtin_amdgcn_mfma_f32_16x16x32_bf16(u4_to_frag(qf0), u4_to_frag(k0), (f32x4){0.f, 0.f, 0.f, 0.f}, 0, 0, 0);
    sa[n] = __builtin_amdgcn_mfma_f32_16x16x32_bf16(u4_to_frag(qf1), u4_to_frag(k1), sa[n], 0, 0, 0);
  }
  float scl[4];
#pragma unroll
  for (int j = 0; j < 4; ++j) {
    float mx = -1e30f;
#pragma unroll
    for (int n = 1; n < 10; ++n) {
      const int mo = 144 + q * 4 + j - n * 16 - r;
      const int sigk = sig0 - 144 + n * 16 + r;
      const bool ok = (mo >= 0) && (mo <= 128) && (sigk >= 0);
      const float sv = ok ? (sa[n][j] + sBias[g * 132 + (ok ? mo : 0)]) : -1e30f;
      sa[n][j] = sv;
      mx = fmaxf(mx, sv);
    }
    mx = max16(mx);
    float sum = 0.f;
#pragma unroll
    for (int n = 1; n < 10; ++n) {
      const float p = (sa[n][j] > -1e29f) ? __expf(sa[n][j] - mx) : 0.f;
      sa[n][j] = p;
      sum += p;
    }
    sum = sum16(sum);
    const float lse = mx + __logf(sum);
    const int pw = (sig0 + q * 4 + j) * d + r_res - p0;
    if (pass == 0) {
      if (r == 0) sLse[g * 256 + pw] = lse;
      scl[j] = 0.f;
    } else {
      const float l0 = sLse[pw], l1 = sLse[256 + pw], l2 = sLse[512 + pw];
      const float L = fmaxf(fmaxf(l0, l1), l2);
      const float den = __expf(l0 - L) + __expf(l1 - L) + __expf(l2 - L);
      scl[j] = __expf(lse - L) / (den * sum);
    }
  }
  if (pass == 0) return;
#pragma unroll
  for (int j = 0; j < 4; ++j) {
#pragma unroll
    for (int n = 0; n < 10; ++n) sP[(q * 4 + j) * 168 + n * 16 + r] = f2bf(sa[n][j]);
  }
  f32x4 o[4];
#pragma unroll
  for (int ne = 0; ne < 4; ++ne) o[ne] = (f32x4){0.f, 0.f, 0.f, 0.f};
  const bf16_t* Vb = VshT + ((size_t)(b * 12 + head) * 64 + r) * kS + (size_t)r_res * (kS / d);
#pragma unroll
  for (int ks = 0; ks < 5; ++ks) {
    const bf16x8 pf = *(const bf16x8*)(sP + r * 168 + ks * 32 + q * 8);
    int sk0 = sig0 - 144 + ks * 32 + q * 8;
    sk0 = sk0 < 0 ? 0 : sk0;
#pragma unroll
    for (int ne = 0; ne < 4; ++ne) {
      const uint4 vf = *(const uint4*)(Vb + (size_t)ne * 16 * kS + sk0);
      o[ne] = __builtin_amdgcn_mfma_f32_16x16x32_bf16(pf, u4_to_frag(vf), o[ne], 0, 0, 0);
    }
  }
  VMWAIT();
#pragma unroll
  for (int ne = 0; ne < 4; ++ne)
#pragma unroll
    for (int j = 0; j < 4; ++j) {
      const size_t tok = (size_t)b * kS + (size_t)(sig0 + q * 4 + j) * d + r_res;
      Cat[tok * 1024 + head * 64 + ne * 16 + r] = f2bf(o[ne][j] * scl[j]);
    }
}

__device__ __forceinline__ void phase_dilated_mfma(const Params& P) {
  float* sBias = (float*)smem;
  float* sLse = (float*)(smem + 1584);
  const int tid = threadIdx.x, wid = tid >> 6;
  bf16_t* sP = (bf16_t*)(smem + 4656) + wid * (16 * 168);
  for (int item = blockIdx.x; item < 512; item += gridDim.x) {
    const int hg = item & 3, win = item >> 2, b = win >> 6, p0 = (win & 63) * 256;
    __syncthreads();
    for (int i = tid; i < 3 * 129; i += NTHR) {
      const int g = i / 129, mo = i - g * 129;
      sBias[g * 132 + mo] = t5_bias(P.rel_bias, mo << (2 * g), g * 4 + hg);
    }
    __syncthreads();
#pragma unroll 1
    for (int pass = 0; pass < 2; ++pass) {
#pragma unroll 1
      for (int sidx = wid; sidx < 48; sidx += NWAVE) dilated_slab(P, pass, sidx, b, p0, hg, sBias, sLse, sP);
      VMWAIT();
      __syncthreads();
    }
  }
}

#define XB_TMO      128
#define XB_XCNT(j)  (256  + 64 * (j))
#define XB_XSUB(j)  (1280 + 64 * (j))
#define XB_XGEN(j)  (2304 + 64 * (j))
#define XB_TOP      3328
#define XB_TOPGEN   3392
#define XCD_BAR_WORDS 3456
#define XB_SPIN_CAP (1u << 23)
__device__ __forceinline__ unsigned xb_ld(unsigned* p) { return __hip_atomic_load(p, __ATOMIC_RELAXED, __HIP_MEMORY_SCOPE_AGENT); }
__device__ __forceinline__ unsigned xb_add(unsigned* p, unsigned v) { return __hip_atomic_fetch_add(p, v, __ATOMIC_RELAXED, __HIP_MEMORY_SCOPE_AGENT); }
__device__ __forceinline__ unsigned xb_xcc_id() { return (unsigned)__builtin_amdgcn_s_getreg((3 << 11) | 20) & 0xFu; }
#define XB_SPIN(cond, bar) do { unsigned _sp = 0; while (cond) { __builtin_amdgcn_s_sleep(1); \
    if ((++_sp & 255u) == 0u) { if (xb_ld(&(bar)[XB_TMO])) break; if (_sp > XB_SPIN_CAP) { atomicAdd(&(bar)[XB_TMO], 1u); break; } } } } while (0)
struct XcdBarrier { unsigned* bar; unsigned x; volatile LAS unsigned* st; };
__device__ __forceinline__ XcdBarrier xcd_barrier_post(unsigned* bar, volatile LAS unsigned* st) {
  XcdBarrier b; b.bar = bar; b.x = xb_xcc_id(); b.st = st;
  if (threadIdx.x == 0) (void)xb_add(&bar[XB_XCNT(b.x)], 1u);
  return b;
}
__device__ __forceinline__ void xcd_barrier_complete(unsigned* bar, unsigned x, unsigned& nloc, unsigned& nx) {
  const unsigned Gr = gridDim.x * gridDim.y * gridDim.z;
  unsigned sum, cnt, mine, sp = 0u;
  for (;;) {
    sum = 0u; cnt = 0u; mine = 0u;
#pragma unroll
    for (unsigned j = 0; j < 16; ++j) { const unsigned c = xb_ld(&bar[XB_XCNT(j)]); sum += c; cnt += (c > 0u) ? 1u : 0u; mine = (j == x) ? c : mine; }
    if (sum == Gr) break;
    __builtin_amdgcn_s_sleep(1);
    if ((++sp & 255u) == 0u) { if (xb_ld(&bar[XB_TMO])) break; if (sp > XB_SPIN_CAP) { atomicAdd(&bar[XB_TMO], 1u); break; } }
  }
  nloc = mine > 0u ? mine : 1u; nx = cnt > 0u ? cnt : 1u;
}
__device__ __forceinline__ void xcd_barrier(const XcdBarrier& b) {
  asm volatile("s_waitcnt vmcnt(0)" ::: "memory");
  __syncthreads();
  if (threadIdx.x == 0) {
    unsigned* bar = b.bar;
    __builtin_amdgcn_s_waitcnt(0);
    unsigned nloc = b.st[0], nx = b.st[1];
    if (nloc == 0u) { xcd_barrier_complete(bar, b.x, nloc, nx); b.st[0] = nloc; b.st[1] = nx; }
    const unsigned old = xb_add(&bar[XB_XSUB(b.x)], 1u);
    const unsigned gen = old / nloc;
    if (old + 1u == (gen + 1u) * nloc) {
      __builtin_amdgcn_fence(__ATOMIC_RELEASE, "agent");
      asm volatile("s_waitcnt vmcnt(0)" ::: "memory");
      const unsigned og = xb_add(&bar[XB_TOP], 1u);
      const unsigned tg = og / nx;
      if (og + 1u == (tg + 1u) * nx) xb_add(&bar[XB_TOPGEN], 1u);
      else XB_SPIN(xb_ld(&bar[XB_TOPGEN]) == tg, bar);
      __builtin_amdgcn_fence(__ATOMIC_ACQUIRE, "agent");
      xb_add(&bar[XB_XGEN(b.x)], 1u);
      asm volatile("s_waitcnt vmcnt(0)" ::: "memory");
    } else {
      XB_SPIN(xb_ld(&bar[XB_XGEN(b.x)]) == gen, bar);
      __builtin_amdgcn_fence(__ATOMIC_ACQUIRE, "agent");
      asm volatile("s_waitcnt vmcnt(0)" ::: "memory");
    }
  }
  __syncthreads();
}
#define grid_barrier() xcd_barrier(xbar_)

constexpr int NPHASE = 17;
#ifndef ONLY_PHASE
#define ONLY_PHASE -1
#endif
#ifndef SKIP12
#define SKIP12 0
#endif
#ifndef SKIP14
#define SKIP14 0
#endif
#define PH(n) (ONLY_PHASE < 0 || ONLY_PHASE == (n))

__device__ __forceinline__ char* launder(char* p) { asm volatile("" : "+s"(p)); return p; }
__global__ void __launch_bounds__(512, 2) fwd_megakernel(Params P, int pb, int pe) {
#define W ((bf16_t*)(wsl + OFF_W))
#define xb ((bf16_t*)(wsl + OFF_XB))
#define H ((bf16_t*)(wsl + OFF_R1))
#define Pbase ((bf16_t*)(wsl + OFF_R1))
#define Ksh ((bf16_t*)(wsl + OFF_R2))
#define Vsh (Ksh + (size_t)kT * 768)
#define Cat ((bf16_t*)(wsl + OFF_CAT))
#define ssq ((float*)(wsl + OFF_SSQ))
#define G ((float*)(wsl + OFF_G))
#define memb ((bf16_t*)(wsl + OFF_MEMB))
#define ssqm ((float*)(wsl + OFF_SSQM))
#define Kmem ((bf16_t*)(wsl + OFF_KMEM))
#define Vmem ((bf16_t*)(wsl + OFF_VMEM))
  if (pe < -12345) cg::this_grid().sync();
  volatile LAS unsigned* xst_ = (volatile LAS unsigned*)(smem + 131072);
  if (threadIdx.x == 0) { xst_[0] = 0u; xst_[1] = 0u; }
  __syncthreads();
  XcdBarrier xbar_;
  xbar_.bar = (unsigned*)(P.ws + OFF_BAR); xbar_.x = 0; xbar_.st = xst_;
  if (pe - pb > 1) xbar_ = xcd_barrier_post((unsigned*)(P.ws + OFF_BAR), xst_);
  if (pb == 100) {
    char* wsl = P.ws;
    for (size_t i = (size_t)blockIdx.x * NTHR + threadIdx.x; i < (size_t)kT * 1024; i += (size_t)gridDim.x * NTHR) P.out[i] = bf2f(Cat[i]);
    return;
  }
  {
    if (pb <= 0 && 0 < pe && PH(0)) { char* wsl = launder(P.ws); Params Q = P; Q.ws = wsl; (void)Q; phase_convert(Q); }
    if (pb <= 0 && 0 + 1 < pe) grid_barrier();
    if (pb <= 1 && 1 < pe && PH(1)) { char* wsl = launder(P.ws); Params Q = P; Q.ws = wsl; (void)Q; gemm8(xb, W + W_GU0, kT, 5632, 1024, Epi8Swiglu{ssq, H}); }
    if (pb <= 1 && 1 + 1 < pe) grid_barrier();
    if (pb <= 2 && 2 < pe && PH(2)) { char* wsl = launder(P.ws); Params Q = P; Q.ws = wsl; (void)Q; { gemm8(H, W + W_DN0, kT, 1024, 2816, Epi8Resid{P.x, P.out, xb, ssq, 0.5f});
      gemm8(memb, W + W_MKV0, 512, 512, 1024, Epi8MemKv{ssqm, Kmem, (bf16_t*)(wsl + OFF_VTOK), P.mem_k_norm}, 64);
      gemm8(memb, W + W_MKV1, 512, 512, 1024, Epi8MemKv{ssqm, Kmem + 512 * 256, (bf16_t*)(wsl + OFF_VTOK) + 512 * 256, P.mem_k_norm + 64}, 192);
    } }
    if (pb <= 2 && 2 + 1 < pe) grid_barrier();
    if (pb <= 3 && 3 < pe && PH(3)) { char* wsl = launder(P.ws); Params Q = P; Q.ws = wsl; (void)Q; {
      gemm8(xb, W + W_IN, kT, 3584, 1024, Epi8InProj{ssq, Pbase, Cat, G, P.mem_q_norm, P.a_gate_bias});
    } }
    if (pb <= 3 && 3 + 1 < pe) grid_barrier();
    if (pb <= 4 && 4 < pe && PH(4)) { char* wsl = launder(P.ws); Params Q = P; Q.ws = wsl; (void)Q; { memv_transpose((const bf16_t*)(wsl + OFF_VTOK), Vmem); phase_prep(Q); } }
    if (pb <= 4 && 4 + 1 < pe) grid_barrier();
    if (pb <= 5 && 5 < pe && PH(5)) { char* wsl = launder(P.ws); Params Q = P; Q.ws = wsl; (void)Q; phase_scan(Q); { const int wv = (int)(threadIdx.x >> 6) * (int)gridDim.x + (int)blockIdx.x, tot = (int)gridDim.x * NWAVE; if (tot > 416 + 64) { memattn_mfma(Q, 0, wv - 416, tot - 416); if (wv >= 416) wave_convert(Q, wv - 416, tot - 416, false); } else { memattn_mfma(Q, 0, wv, tot); wave_convert(Q, wv, tot, false); } } }
    if (pb <= 5 && 5 + 1 < pe) grid_barrier();
    if (pb <= 6 && 6 < pe && PH(6)) { char* wsl = launder(P.ws); Params Q = P; Q.ws = wsl; (void)Q; phase_chunk(Q); }
    if (pb <= 6 && 6 + 1 < pe) grid_barrier();
    if (pb <= 7 && 7 < pe && PH(7)) { char* wsl = launder(P.ws); Params Q = P; Q.ws = wsl; (void)Q; gemm8(Cat, W + W_AOUT, kT, 1024, 1024, Epi8Resid{P.out, P.out, xb, ssq, 1.f}); }
    if (pb <= 7 && 7 + 1 < pe) grid_barrier();
    if (pb <= 8 && 8 < pe && PH(8)) { char* wsl = launder(P.ws); Params Q = P; Q.ws = wsl; (void)Q; gemm8(xb, W + W_GU1, kT, 5632, 1024, Epi8Swiglu{ssq, H}); }
    if (pb <= 8 && 8 + 1 < pe) grid_barrier();
    if (pb <= 9 && 9 < pe && PH(9)) { char* wsl = launder(P.ws); Params Q = P; Q.ws = wsl; (void)Q; gemm8(H, W + W_DN1, kT, 1024, 2816, Epi8Resid{P.out, P.out, xb, ssq, 0.5f}); }
    if (pb <= 9 && 9 + 1 < pe) grid_barrier();
    if (pb <= 10 && 10 < pe && PH(10)) { char* wsl = launder(P.ws); Params Q = P; Q.ws = wsl; (void)Q; gemm8(xb, W + W_GU2, kT, 7168, 1024, Epi8KvFfn{ssq, H, Ksh, Cat, P.kv_k_norm}); }
    if (pb <= 10 && 10 + 1 < pe) grid_barrier();
    if (pb <= 11 && 11 < pe && PH(11)) { char* wsl = launder(P.ws); Params Q = P; Q.ws = wsl; (void)Q; { gemm8(H, W + W_DN2, kT, 1024, 2816, Epi8Resid{P.out, P.out, xb, ssq, 0.5f}); phase_vtranspose(Cat, Vsh); } }
    if (pb <= 11 && 11 + 1 < pe) grid_barrier();
    if (pb <= 12 && 12 < pe && PH(12) && !SKIP12) { char* wsl = launder(P.ws); Params Q = P; Q.ws = wsl; (void)Q; gemm8(xb, W + W_BQ, kT, 1024, 1024, Epi8QProj{ssq, Cat, P.b_q_norm, P.mem_q_norm + 64}); }
    if (pb <= 12 && 12 + 1 < pe) grid_barrier();
    if (pb <= 13 && 13 < pe && PH(13)) { char* wsl = launder(P.ws); Params Q = P; Q.ws = wsl; (void)Q; { phase_dilated_mfma(Q); memattn_mfma(Q, 1, (int)blockIdx.x * NWAVE + (int)(threadIdx.x >> 6), (int)gridDim.x * NWAVE); } }
    if (pb <= 13 && 13 + 1 < pe) grid_barrier();
    if (pb <= 14 && 14 < pe && PH(14) && !SKIP14) { char* wsl = launder(P.ws); Params Q = P; Q.ws = wsl; (void)Q; gemm8(Cat, W + W_BOUT, kT, 1024, 1024, Epi8Resid{P.out, P.out, xb, ssq, 1.f}); }
    if (pb <= 14 && 14 + 1 < pe) grid_barrier();
    if (pb <= 15 && 15 < pe && PH(15)) { char* wsl = launder(P.ws); Params Q = P; Q.ws = wsl; (void)Q; gemm8(xb, W + W_GU3, kT, 5632, 1024, Epi8Swiglu{ssq, H}); }
    if (pb <= 15 && 15 + 1 < pe) grid_barrier();
    if (pb <= 16 && 16 < pe && PH(16)) { char* wsl = launder(P.ws); Params Q = P; Q.ws = wsl; (void)Q; gemm8(H, W + W_DN3, kT, 1024, 2816, Epi8Resid{P.out, P.out, nullptr, ssq, 0.5f}); }
  }
}
#undef W
#undef xb
#undef H
#undef Pbase
#undef Ksh
#undef Vsh
#undef Cat
#undef ssq
#undef G
#undef memb
#undef ssqm
#undef Kmem
#undef Vmem

extern "C" void kernel_launch(void* const* d_in, const int* in_sizes, int n_in, void* d_out, int out_size, void* d_ws,
                              size_t ws_size, hipStream_t stream) {
  (void)in_sizes; (void)n_in; (void)out_size;
  static int grid_blocks = 0;
  if (!grid_blocks) {
    int dev = 0, cus = 0, per_cu = 0;
    hipGetDevice(&dev);
    hipDeviceGetAttribute(&cus, hipDeviceAttributeMultiprocessorCount, dev);
    hipOccupancyMaxActiveBlocksPerMultiprocessor(&per_cu, fwd_megakernel, NTHR, 0);
    if (per_cu > 1) per_cu = 1;
    grid_blocks = cus * per_cu;
    if (ws_size < OFF_END) fprintf(stderr, "workspace too small: %zu < %zu\n", ws_size, (size_t)OFF_END);
  }
  Params p{};
  const float** pf = (const float**)&p;
  for (int i = 0; i < 27; ++i) pf[i] = (const float*)d_in[i];
  p.out = (float*)d_out;
  p.ws = (char*)d_ws;
#ifndef RUN_PE
#define RUN_PE NPHASE
#endif
#ifdef MULTI_LAUNCH
  hipError_t e = hipSuccess;
  for (int ph = 0; ph < RUN_PE; ++ph) {
    int pb = ph, pe = ph + 1;
    hipLaunchKernelGGL(fwd_megakernel, dim3(grid_blocks), dim3(NTHR), 0, stream, p, pb, pe);
  }
#else
  hipMemsetAsync((char*)d_ws + OFF_BAR, 0, 16384, stream);
  int pb = 0, pe = RUN_PE;
  void* args[] = {&p, &pb, &pe};
  hipError_t e = hipLaunchCooperativeKernel((void*)fwd_megakernel, dim3(grid_blocks), dim3(NTHR), args, 0, stream);
#endif
  if (e != hipSuccess) fprintf(stderr, "cooperative launch failed: %s (grid %d)\n", hipGetErrorString(e), grid_blocks);
}
```

```cpp
#include <hip/hip_runtime.h>
#include <hip/hip_cooperative_groups.h>
#include <stdint.h>
#include <stdio.h>
namespace cg = cooperative_groups;

typedef unsigned short bf16_t;
typedef __attribute__((ext_vector_type(8))) short bf16x8;
typedef __attribute__((ext_vector_type(4))) float f32x4;
#define LAS __attribute__((address_space(3)))
#define VMWAIT() asm volatile("s_waitcnt vmcnt(0)" ::: "memory")

constexpr int kT = 32768, kS = 16384;
constexpr int NTHR = 512, NWAVE = 8;
constexpr float EPS = 1e-6f;

constexpr size_t GU_SZ = 5632ull * 1024, DN_SZ = 1024ull * 2816, KV_SZ = 1536ull * 1024, IN_SZ = 3584ull * 1024,
                 SQ_SZ = 1024ull * 1024, MKV_SZ = 512ull * 1024;
constexpr size_t W_GU0 = 0, W_GU1 = GU_SZ, W_GU2 = 2 * GU_SZ, W_KV = 3 * GU_SZ, W_GU3 = W_KV + KV_SZ,
                 W_DN0 = W_GU3 + GU_SZ, W_DN1 = W_DN0 + DN_SZ, W_DN2 = W_DN1 + DN_SZ, W_DN3 = W_DN2 + DN_SZ,
                 W_IN = W_DN3 + DN_SZ, W_AOUT = W_IN + IN_SZ, W_BQ = W_AOUT + SQ_SZ, W_BOUT = W_BQ + SQ_SZ,
                 W_MKV0 = W_BOUT + SQ_SZ, W_MKV1 = W_MKV0 + MKV_SZ, W_END = W_MKV1 + MKV_SZ;
constexpr size_t PSZ = (size_t)kT * 768 * 2;
constexpr size_t OFF_W = 0;
constexpr size_t OFF_XB = (W_END * 2 + 255) / 256 * 256;
constexpr size_t OFF_R1 = OFF_XB + (size_t)kT * 1024 * 2;
constexpr size_t OFF_R2 = OFF_R1 + 4 * PSZ;
constexpr size_t OFF_CAT = OFF_R2 + 2 * PSZ;
constexpr size_t OFF_SSQ = OFF_CAT + (size_t)kT * 1024 * 2;
constexpr size_t OFF_G = OFF_SSQ + (size_t)kT * 16 * 4;
constexpr size_t OFF_MEMB = OFF_G + (size_t)kT * 8 * 4;
constexpr size_t OFF_SSQM = OFF_MEMB + 512ull * 1024 * 2;
constexpr size_t OFF_KMEM = OFF_SSQM + 512ull * 16 * 4;
constexpr size_t OFF_VMEM = OFF_KMEM + 2ull * 512 * 256 * 2;
constexpr size_t OFF_U = OFF_VMEM + 2ull * 512 * 256 * 2;
constexpr size_t OFF_BC = OFF_U + 1024ull * 128 * 4;
constexpr size_t OFF_EW = OFF_BC + 1024ull * 128 * 4;
constexpr size_t OFF_UMAX = OFF_EW + 1024ull * 128 * 2;
constexpr size_t OFF_BL = OFF_UMAX + 4096;
constexpr size_t OFF_M0 = OFF_BL + 4096;
constexpr size_t OFF_BAR = OFF_M0 + 4096;
constexpr size_t OFF_VTOK = OFF_BAR + 16384;
constexpr size_t OFF_END = OFF_VTOK + 2ull * 512 * 256 * 2;

struct Params {
  const float *x, *mem, *ffn1_norm, *ffn1_wg, *ffn1_wu, *ffn1_wd, *ffn2_norm, *ffn2_wg, *ffn2_wu, *ffn2_wd, *mix_norm,
      *mem_norm, *w_mem_kv, *mem_q_norm, *mem_k_norm, *a_w_in, *a_conv, *a_gate_bias, *a_h_norm, *a_w_out, *b_w_q,
      *b_q_norm, *b_w_out, *kv_norm, *w_kv, *kv_k_norm, *rel_bias;
  float* out;
  char* ws;
};

__shared__ __attribute__((aligned(16))) char smem[146432];

__device__ __forceinline__ bf16_t f2bf(float f) {
  uint32_t u = __float_as_uint(f);
  u += 0x7fffu + ((u >> 16) & 1u);
  return (bf16_t)(u >> 16);
}
__device__ __forceinline__ float bf2f(bf16_t h) { return __uint_as_float(((uint32_t)h) << 16); }
__device__ __forceinline__ float bflo(uint32_t u) { return __uint_as_float(u << 16); }
__device__ __forceinline__ float bfhi(uint32_t u) { return __uint_as_float(u & 0xffff0000u); }
__device__ __forceinline__ uint32_t pack2(float a, float b) { uint32_t r; asm("v_cvt_pk_bf16_f32 %0, %1, %2" : "=v"(r) : "v"(a), "v"(b)); return r; }
__device__ __forceinline__ float dot8(uint4 a, uint4 b) {
  return bflo(a.x) * bflo(b.x) + bfhi(a.x) * bfhi(b.x) + bflo(a.y) * bflo(b.y) + bfhi(a.y) * bfhi(b.y) +
         bflo(a.z) * bflo(b.z) + bfhi(a.z) * bfhi(b.z) + bflo(a.w) * bflo(b.w) + bfhi(a.w) * bfhi(b.w);
}
__device__ __forceinline__ float wave_sum(float v) {
  for (int o = 32; o > 0; o >>= 1) v += __shfl_xor(v, o);
  return v;
}
__device__ __forceinline__ float wave_max(float v) {
  for (int o = 32; o > 0; o >>= 1) v = fmaxf(v, __shfl_xor(v, o));
  return v;
}
__device__ __forceinline__ float dpp_ror_(float v, int) { return v; }
#define DPP_ROR_ADD(v, ctrl) v += __builtin_bit_cast(float, __builtin_amdgcn_update_dpp(0, __builtin_bit_cast(int, v), ctrl, 0xf, 0xf, false))
__device__ __forceinline__ float sum16(float v) {
  DPP_ROR_ADD(v, 0x128); DPP_ROR_ADD(v, 0x124); DPP_ROR_ADD(v, 0x122); DPP_ROR_ADD(v, 0x121);
  return v;
}
#define DPP_ROR_MAX(v, ctrl) v = fmaxf(v, __builtin_bit_cast(float, __builtin_amdgcn_update_dpp(0, __builtin_bit_cast(int, v), ctrl, 0xf, 0xf, false)))
__device__ __forceinline__ float max16(float v) {
  DPP_ROR_MAX(v, 0x128); DPP_ROR_MAX(v, 0x124); DPP_ROR_MAX(v, 0x122); DPP_ROR_MAX(v, 0x121);
  return v;
}
__device__ __forceinline__ float sigmoidf_(float x) { return __builtin_amdgcn_rcpf(1.f + __expf(-x)); }

struct WJob { size_t dst; int Nd, K; };
__device__ __forceinline__ WJob wjob(int j) {
  switch (j) {
    case 0: return {W_GU0, 5632, 1024};
    case 1: return {W_GU1, 5632, 1024};
    case 2: return {W_GU2, 5632, 1024};
    case 3: return {W_GU3, 5632, 1024};
    case 4: return {W_DN0, 1024, 2816};
    case 5: return {W_DN1, 1024, 2816};
    case 6: return {W_DN2, 1024, 2816};
    case 7: return {W_DN3, 1024, 2816};
    case 8: return {W_IN, 3584, 1024};
    case 9: return {W_AOUT, 1024, 1024};
    case 10: return {W_BQ, 1024, 1024};
    case 11: return {W_BOUT, 1024, 1024};
    case 12: return {W_KV, 1536, 1024};
    case 13: return {W_MKV0, 512, 1024};
    default: return {W_MKV1, 512, 1024};
  }
}
__device__ __forceinline__ int headmap(int r256) { const int bj = r256 >> 7, hh = (r256 & 127) >> 5, i = r256 & 31; return hh * 64 + bj * 32 + i; }
__device__ __forceinline__ void wsrc(const Params& P, int j, int n, const float*& p, int& ld, const float*& gain) {
  p = nullptr; ld = 0; gain = nullptr;
  if (j < 4) {
    int layer = j >> 1, which = j & 1;
    int pn = n >> 8, r = n & 255, bj = r >> 7, col = pn * 128 + (r & 127);
    const float* wg = which ? P.ffn2_wg : P.ffn1_wg;
    const float* wu = which ? P.ffn2_wu : P.ffn1_wu;
    p = (bj ? wu : wg) + (size_t)layer * 1024 * 2816 + col;
    ld = 2816;
    gain = (which ? P.ffn2_norm : P.ffn1_norm) + layer * 1024;
  } else if (j < 8) {
    int i = j - 4, layer = i >> 1, which = i & 1;
    p = (which ? P.ffn2_wd : P.ffn1_wd) + (size_t)layer * 2816 * 1024 + n;
    ld = 1024;
  } else if (j == 8) {
    int col = -1;
    if (n < 3072) col = n; else if (n < 3328) col = 3080 + headmap(n - 3072); else if (n < 3336) col = 3072 + (n - 3328);
    if (col >= 0) { p = P.a_w_in + col; ld = 3336; }
    gain = P.mix_norm;
  } else if (j == 9) { p = P.a_w_out + n; ld = 1024; }
  else if (j == 10) { p = P.b_w_q + (n & ~255) + headmap(n & 255); ld = 1024; gain = P.mix_norm + 1024; }
  else if (j == 11) { p = P.b_w_out + n; ld = 1024; }
  else if (j == 12) { int col = (n < 768) ? ((n & ~255) + headmap(n & 255)) : n; p = P.w_kv + col; ld = 1536; gain = P.kv_norm; }
  else { int l = j - 13; int col = (n < 256) ? headmap(n) : n; p = P.w_mem_kv + (size_t)l * 1024 * 512 + col; ld = 512; gain = P.mem_norm + l * 1024; }
}

__device__ __forceinline__ void wave_convert(const Params& P, int widx, int nwv, bool early) {
  bf16_t* W = (bf16_t*)(P.ws + OFF_W);
  const int lane = threadIdx.x & 63;
  int base = 0;
  for (int j = 0; j < 15; ++j) {
    const bool is_early = (j == 0 || j == 4 || j == 8 || j >= 13);
    if (is_early != early) continue;
    WJob wj = wjob(j);
    const int tk_cnt = wj.K >> 6, ntile = (wj.Nd >> 6) * tk_cnt;
    const int first = (widx + nwv - (base % nwv)) % nwv;
    for (int t = first; t < ntile; t += nwv) {
      const int tn = t / tk_cnt, tk = t - tn * tk_cnt, n = (tn << 6) + lane, k0 = tk << 6;
      const float* sp; int ld; const float* gain;
      wsrc(P, j, n, sp, ld, gain);
      float v[64];
#pragma unroll
      for (int k = 0; k < 64; ++k) v[k] = sp ? sp[(size_t)(k0 + k) * ld] : 0.f;
      if (gain) {
#pragma unroll
        for (int k4 = 0; k4 < 16; ++k4) {
          const float4 g4 = *(const float4*)(gain + k0 + k4 * 4);
          v[k4 * 4 + 0] *= g4.x; v[k4 * 4 + 1] *= g4.y; v[k4 * 4 + 2] *= g4.z; v[k4 * 4 + 3] *= g4.w;
        }
      }
      VMWAIT();
      bf16_t* dst = W + wj.dst + (size_t)n * wj.K + k0;
#pragma unroll
      for (int k8 = 0; k8 < 8; ++k8) {
        uint4 o;
        o.x = pack2(v[k8 * 8 + 0], v[k8 * 8 + 1]); o.y = pack2(v[k8 * 8 + 2], v[k8 * 8 + 3]);
        o.z = pack2(v[k8 * 8 + 4], v[k8 * 8 + 5]); o.w = pack2(v[k8 * 8 + 6], v[k8 * 8 + 7]);
        *(uint4*)(dst + k8 * 8) = o;
      }
    }
    base += ntile;
  }
}

__device__ __forceinline__ void phase_convert(const Params& P) {
  bf16_t* W = (bf16_t*)(P.ws + OFF_W);
  float* sT = (float*)smem;
  const int tid = threadIdx.x;
  wave_convert(P, (int)(blockIdx.x * NWAVE + (threadIdx.x >> 6)), (int)(gridDim.x * NWAVE), true);
  bf16_t* xb = (bf16_t*)(P.ws + OFF_XB);
  float* ssq = (float*)(P.ws + OFF_SSQ);
  bf16_t* memb = (bf16_t*)(P.ws + OFF_MEMB);
  float* ssqm = (float*)(P.ws + OFF_SSQM);
  const int lane = tid & 63, gw = blockIdx.x * NWAVE + (tid >> 6), nw = gridDim.x * NWAVE;
  for (int row = gw; row < kT + 512; row += nw) {
    const float* src = (row < kT) ? (P.x + (size_t)row * 1024) : (P.mem + (size_t)(row - kT) * 1024);
    bf16_t* dst = (row < kT) ? (xb + (size_t)row * 1024) : (memb + (size_t)(row - kT) * 1024);
    float* sq = (row < kT) ? (ssq + (size_t)row * 16) : (ssqm + (size_t)(row - kT) * 16);
    float ss = 0.f;
#pragma unroll
    for (int i = 0; i < 4; ++i) {
      float4 v = ((const float4*)src)[lane + 64 * i];
      ss += v.x * v.x + v.y * v.y + v.z * v.z + v.w * v.w;
      uint2 o; o.x = pack2(v.x, v.y); o.y = pack2(v.z, v.w);
      ((uint2*)dst)[lane + 64 * i] = o;
    }
    ss = wave_sum(ss);
    if (lane < 16) sq[lane] = (lane == 0) ? ss : 0.f;
  }
}

constexpr int G8_BM = 256, G8_BK = 64, G8_HALF = 128, G8_HTB = G8_HALF * G8_BK * 2, G8_NXCD = 8, G8_WGM = 8;
__device__ __forceinline__ int lds_byte(int r, int c) { const int st = (r >> 4) * 2 + (c >> 5), rr = r & 15, cc = c & 31, ob = rr * 64 + cc * 2; return st * 1024 + (ob ^ (((ob >> 9) & 1) << 5)); }
__device__ __forceinline__ void stage_rc(int b, int& R, int& C) { const int st = b / 1024, sb = b % 1024, swz = sb ^ (((sb >> 9) & 1) << 5); R = (st >> 1) * 16 + swz / 64; C = (st & 1) * 32 + (swz % 64) / 2; }
__device__ __forceinline__ int perm32(int rho) { const int n = rho >> 4, i = rho & 15; return 8 * (i >> 2) + 4 * n + (i & 3); }
struct Unit { int pm, pn; };
struct StaticOrder {
  int nM, nN, nwg, G, c;
  __device__ void init(int M, int N, int G_, int c_) { nM = M / G8_BM; nN = N / G8_BM; nwg = nM * nN; G = G_; c = c_; }
  __device__ bool next(int i, Unit& u) const {
    const long L = (long)i * G + c; if (L >= nwg) return false;
    int wgid = (int)L; { const int q = nwg / G8_NXCD, r = nwg % G8_NXCD, xcd = wgid % G8_NXCD, off = wgid / G8_NXCD; wgid = (xcd < r ? xcd * (q + 1) : r * (q + 1) + (xcd - r) * q) + off; }
    const int nig = G8_WGM * nN, gid = wgid / nig, fm = gid * G8_WGM, gsz = (nM - fm) < G8_WGM ? (nM - fm) : G8_WGM;
    u.pm = fm + ((wgid % nig) % gsz); u.pn = (wgid % nig) / gsz; return true;
  }
};

__device__ __forceinline__ float rstd_row(const float* ssq, size_t row) {
  const float4* q = (const float4*)(ssq + row * 16);
  float4 a = q[0], b = q[1], c = q[2], d = q[3];
  float s = ((a.x + a.y) + (a.z + a.w)) + ((b.x + b.y) + (b.z + b.w)) + ((c.x + c.y) + (c.z + c.w)) + ((d.x + d.y) + (d.z + d.w));
  return rsqrtf(s * (1.f / 1024.f) + EPS);
}
template <class Epi>
__device__ __forceinline__ void gemm8(const bf16_t* gA, const bf16_t* gBt, int M, int N, int K, const Epi& E, int coff = 0) {
  LAS unsigned char* lds = (LAS unsigned char*)smem;
  StaticOrder S; S.init(M, N, (int)gridDim.x, (int)((blockIdx.x + coff) % gridDim.x));
  const int tid = threadIdx.x, wid = __builtin_amdgcn_readfirstlane(tid >> 6), lane = tid & 63, wr = wid >> 2, wc = wid & 3, fr = lane & 15, fq = lane >> 4;
  const int nt = K / G8_BK;
  unsigned voffA[2], voffB[2];
#pragma unroll
  for (int i = 0; i < 2; ++i) { int R, C; stage_rc(tid * 16 + i * 8192, R, C); const int Rb = Epi::PERM ? ((R & ~31) + perm32(R & 31)) : R;
    voffA[i] = (unsigned)(R * K + C) * 2u; voffB[i] = (unsigned)(Rb * K + C) * 2u; }
  const size_t kstep = (size_t)(G8_BK * 2);
  const size_t hstep = (size_t)G8_HALF * K * 2;
  const size_t tstep = 2 * hstep;
  const unsigned ldsw = (unsigned)wid * 1024u;
  const int aoff = lds_byte(wr * 64 + fr, fq * 8), boff = lds_byte(wc * 32 + fr, fq * 8);
#define PG8_SA(b, h) (((b) * 2 + (h)) * G8_HTB)
#define PG8_SB(b, h) ((4 + (b) * 2 + (h)) * G8_HTB)
#define PG8_STAGE(bufoff, gbase, voff) do { _Pragma("unroll") for (int _i = 0; _i < 2; ++_i) \
    __builtin_amdgcn_global_load_lds((const unsigned*)((const char*)(gbase) + (voff)[_i]), (LAS unsigned*)(lds + (bufoff) + ldsw + _i * 8192), 16, 0, 0); } while (0)
#define PG8_LDA(dst, b, h) do { _Pragma("unroll") for (int m = 0; m < 4; ++m) _Pragma("unroll") for (int k = 0; k < 2; ++k) dst[m][k] = *(const LAS bf16x8*)(lds + PG8_SA(b, h) + aoff + m * 2048 + k * 1024); } while (0)
#define PG8_LDB(dst, b, h) do { _Pragma("unroll") for (int n = 0; n < 2; ++n) _Pragma("unroll") for (int k = 0; k < 2; ++k) dst[n][k] = *(const LAS bf16x8*)(lds + PG8_SB(b, h) + boff + n * 2048 + k * 1024); } while (0)
#define PG8_MMA(ai, bj, At, Bt) do { __builtin_amdgcn_s_setprio(1); _Pragma("unroll") for (int m = 0; m < 4; ++m) _Pragma("unroll") for (int n = 0; n < 2; ++n) _Pragma("unroll") for (int k = 0; k < 2; ++k) \
    acc[ai][bj][m][n] = __builtin_amdgcn_mfma_f32_16x16x32_bf16(Bt[n][k], At[m][k], acc[ai][bj][m][n], 0, 0, 0); __builtin_amdgcn_s_setprio(0); } while (0)
#define PG8_WAIT_V(n) asm volatile("s_waitcnt vmcnt(" #n ")" ::: "memory")
#define PG8_WAIT_L(n) asm volatile("s_waitcnt lgkmcnt(" #n ")" ::: "memory")
#define PG8_BAR __builtin_amdgcn_s_barrier()
#define PG8_SCHED __builtin_amdgcn_sched_barrier(0)
  Unit cur, nxt; int ui = 0;
  if (E.ssq != nullptr) {
    float* sRs = (float*)(smem + 132096);
    Unit uu;
    for (int i = 0; S.next(i, uu); ++i)
      if (tid < 256) sRs[i * 256 + tid] = rstd_row(E.ssq, (size_t)uu.pm * 256 + tid);
    __syncthreads();
  }
  if (!S.next(0, cur)) return;
  f32x4 acc[2][2][4][2];
#pragma unroll
  for (int a = 0; a < 2; ++a)
#pragma unroll
    for (int b = 0; b < 2; ++b)
#pragma unroll
      for (int m = 0; m < 4; ++m)
#pragma unroll
        for (int n = 0; n < 2; ++n) acc[a][b][m][n] = (f32x4){0.f, 0.f, 0.f, 0.f};
  bf16x8 At[4][2], B0[2][2], B1[2][2];
  const char* cA = (const char*)gA + (size_t)cur.pm * tstep; const char* cB = (const char*)gBt + (size_t)cur.pn * tstep;
  PG8_STAGE(PG8_SB(0, 0), cB, voffB); PG8_STAGE(PG8_SA(0, 0), cA, voffA); PG8_STAGE(PG8_SB(0, 1), cB + hstep, voffB); PG8_STAGE(PG8_SA(0, 1), cA + hstep, voffA);
  if (wr == 1) PG8_BAR;
  PG8_WAIT_V(4); PG8_BAR;
  PG8_STAGE(PG8_SB(1, 0), cB + kstep, voffB); PG8_STAGE(PG8_SA(1, 0), cA + kstep, voffA); PG8_STAGE(PG8_SB(1, 1), cB + hstep + kstep, voffB);
  PG8_WAIT_V(6); PG8_BAR;
  for (;;) {
    const bool has_next = S.next(ui + 1, nxt);
    const char* nA = has_next ? (const char*)gA + (size_t)nxt.pm * tstep : cA; const char* nB = has_next ? (const char*)gBt + (size_t)nxt.pn * tstep : cB;
    for (int t = 0; t < nt; t += 2) {
      const bool last = (t == nt - 2);
      const char* a1 = cA + (size_t)(t + 1) * kstep;
      const char* a2 = last ? nA : cA + (size_t)(t + 2) * kstep; const char* b2 = last ? nB : cB + (size_t)(t + 2) * kstep;
      const char* a3 = a2 + kstep; const char* b3 = b2 + kstep;
      PG8_LDB(B0, 0, 0); PG8_SCHED; PG8_LDA(At, 0, 0); PG8_STAGE(PG8_SA(1, 1), a1 + hstep, voffA);
      PG8_WAIT_L(8); PG8_BAR; PG8_WAIT_L(0); PG8_MMA(0, 0, At, B0); PG8_BAR; PG8_SCHED;
      PG8_LDB(B1, 0, 1); PG8_STAGE(PG8_SB(0, 0), b2, voffB);
      PG8_BAR; PG8_WAIT_L(0); PG8_MMA(0, 1, At, B1); PG8_BAR;
      PG8_LDA(At, 0, 1); PG8_STAGE(PG8_SA(0, 0), a2, voffA);
      PG8_BAR; PG8_WAIT_L(0); PG8_MMA(1, 0, At, B0); PG8_BAR; PG8_SCHED;
      PG8_STAGE(PG8_SB(0, 1), b2 + hstep, voffB);
      PG8_WAIT_V(6); PG8_BAR; PG8_MMA(1, 1, At, B1); PG8_BAR;
      PG8_LDB(B0, 1, 0); PG8_SCHED; PG8_LDA(At, 1, 0); PG8_STAGE(PG8_SA(0, 1), a2 + hstep, voffA);
      PG8_WAIT_L(8); PG8_BAR; PG8_WAIT_L(0); PG8_MMA(0, 0, At, B0); PG8_BAR; PG8_SCHED;
      PG8_LDB(B1, 1, 1); PG8_STAGE(PG8_SB(1, 0), b3, voffB);
      PG8_BAR; PG8_WAIT_L(0); PG8_MMA(0, 1, At, B1); PG8_BAR;
      PG8_LDA(At, 1, 1); PG8_STAGE(PG8_SA(1, 0), a3, voffA);
      PG8_BAR; PG8_WAIT_L(0); PG8_MMA(1, 0, At, B0); PG8_BAR; PG8_SCHED;
      PG8_STAGE(PG8_SB(1, 1), b3 + hstep, voffB);
      PG8_WAIT_V(6); PG8_BAR; PG8_MMA(1, 1, At, B1); PG8_BAR;
    }
    E(acc, cur, ui, wr, wc, fr, fq);
    if (!has_next) break;
#pragma unroll
    for (int a = 0; a < 2; ++a)
#pragma unroll
      for (int b = 0; b < 2; ++b)
#pragma unroll
        for (int m = 0; m < 4; ++m)
#pragma unroll
          for (int n = 0; n < 2; ++n) acc[a][b][m][n] = (f32x4){0.f, 0.f, 0.f, 0.f};
    cur = nxt; cA = nA; cB = nB; ++ui;
  }
  PG8_WAIT_V(0);
  if (wr == 0) PG8_BAR;
  PG8_BAR;
#undef PG8_SA
#undef PG8_SB
#undef PG8_STAGE
#undef PG8_LDA
#undef PG8_LDB
#undef PG8_MMA
#undef PG8_WAIT_V
#undef PG8_WAIT_L
#undef PG8_BAR
#undef PG8_SCHED
}

typedef f32x4 Acc8[2][2][4][2];
__device__ __forceinline__ float sumq4(float v) {
  v += __shfl_xor(v, 16); v += __shfl_xor(v, 32);
  return v;
}
__device__ __forceinline__ void rstd8(int ui, int wr, int fr, float (&rs)[2][4]) {
  const float* sRs = (const float*)(smem + 132096) + ui * 256 + wr * 64 + fr;
#pragma unroll
  for (int ai = 0; ai < 2; ++ai)
#pragma unroll
    for (int m = 0; m < 4; ++m) rs[ai][m] = sRs[ai * 128 + m * 16];
}
__device__ __forceinline__ uint4 pack8(f32x4 a, f32x4 b) {
  uint4 o; o.x = pack2(a[0], a[1]); o.y = pack2(a[2], a[3]); o.z = pack2(b[0], b[1]); o.w = pack2(b[2], b[3]); return o;
}
__device__ __forceinline__ void epi8_swiglu(const Acc8& acc, const Unit& u, int ui, int wr, int wc, int fr, int fq, const float* ssq, bf16_t* H) {
  float rs8[2][4];
  rstd8(ui, wr, fr, rs8);
#pragma unroll
  for (int ai = 0; ai < 2; ++ai)
#pragma unroll
    for (int m = 0; m < 4; ++m) {
      const size_t row = (size_t)u.pm * 256 + ai * 128 + wr * 64 + m * 16 + fr;
      const float rs = rs8[ai][m];
      f32x4 h0, h1;
#pragma unroll
      for (int jj = 0; jj < 4; ++jj) {
        float g0 = acc[ai][0][m][0][jj] * rs, u0 = acc[ai][1][m][0][jj] * rs, g1 = acc[ai][0][m][1][jj] * rs, u1 = acc[ai][1][m][1][jj] * rs;
        h0[jj] = g0 * __builtin_amdgcn_rcpf(1.f + __expf(-g0)) * u0;
        h1[jj] = g1 * __builtin_amdgcn_rcpf(1.f + __expf(-g1)) * u1;
      }
      *(uint4*)(H + row * 2816 + u.pn * 128 + wc * 32 + fq * 8) = pack8(h0, h1);
    }
}
__device__ __forceinline__ void epi8_plain(const Acc8& acc, const Unit& u, int ui, int wr, int wc, int fr, int fq, const float* ssq, bf16_t* dst, int ld, int col0) {
  float rs8[2][4];
  rstd8(ui, wr, fr, rs8);
#pragma unroll
  for (int ai = 0; ai < 2; ++ai)
#pragma unroll
    for (int m = 0; m < 4; ++m) {
      const size_t row = (size_t)u.pm * 256 + ai * 128 + wr * 64 + m * 16 + fr;
      const float rs = rs8[ai][m];
#pragma unroll
      for (int bj = 0; bj < 2; ++bj)
        *(uint4*)(dst + row * ld + col0 + bj * 128 + wc * 32 + fq * 8) = pack8(acc[ai][bj][m][0] * rs, acc[ai][bj][m][1] * rs);
    }
}
__device__ __forceinline__ void epi8_headnorm(const Acc8& acc, const Unit& u, int ui, int wr, int wc, int fr, int fq, const float* ssq, const float* gain,
                                              float scale, bf16_t* dst, int ld, int colbase) {
  f32x4 gn[2][2];
#pragma unroll
  for (int bj = 0; bj < 2; ++bj)
#pragma unroll
    for (int n = 0; n < 2; ++n) gn[bj][n] = *(const f32x4*)(gain + bj * 32 + fq * 8 + n * 4) * scale;
  VMWAIT();
  float rs8[2][4];
  rstd8(ui, wr, fr, rs8);
#pragma unroll
  for (int ai = 0; ai < 2; ++ai)
#pragma unroll
    for (int m = 0; m < 4; ++m) {
      const size_t row = (size_t)u.pm * 256 + ai * 128 + wr * 64 + m * 16 + fr;
      const float rs = rs8[ai][m];
      float ss = 0.f;
#pragma unroll
      for (int bj = 0; bj < 2; ++bj)
#pragma unroll
        for (int n = 0; n < 2; ++n) {
          const f32x4 a = acc[ai][bj][m][n];
          ss += a[0] * a[0] + a[1] * a[1] + a[2] * a[2] + a[3] * a[3];
        }
      ss = sumq4(ss) * rs * rs;
      const float r2 = rsqrtf(ss * (1.f / 64.f) + EPS) * rs;
#pragma unroll
      for (int bj = 0; bj < 2; ++bj)
        *(uint4*)(dst + row * ld + colbase + wc * 64 + bj * 32 + fq * 8) = pack8(acc[ai][bj][m][0] * r2 * gn[bj][0], acc[ai][bj][m][1] * r2 * gn[bj][1]);
    }
}

struct Epi8Swiglu {
  static constexpr bool PERM = true;
  const float* ssq; bf16_t* H;
  __device__ __forceinline__ void operator()(const Acc8& acc, const Unit& u, int ui, int wr, int wc, int fr, int fq) const { epi8_swiglu(acc, u, ui, wr, wc, fr, fq, ssq, H); }
};
struct Epi8Resid {
  static constexpr bool PERM = false;
  static constexpr const float* ssq = nullptr;
  const float* xin; float* xout; bf16_t* xb; float* ssqo; float scale;
  __device__ __forceinline__ void operator()(const Acc8& acc, const Unit& u, int ui, int wr, int wc, int fr, int fq) const {
#pragma unroll
    for (int ai = 0; ai < 2; ++ai)
#pragma unroll
      for (int mh = 0; mh < 2; ++mh) {
        f32x4 xv[2][2][2];
#pragma unroll
        for (int m2 = 0; m2 < 2; ++m2)
#pragma unroll
          for (int bj = 0; bj < 2; ++bj)
#pragma unroll
            for (int n = 0; n < 2; ++n)
              xv[m2][bj][n] = *(const f32x4*)(xin + ((size_t)u.pm * 256 + ai * 128 + wr * 64 + (mh * 2 + m2) * 16 + fr) * 1024 + u.pn * 256 + bj * 128 + wc * 32 + n * 16 + fq * 4);
        VMWAIT();
#pragma unroll
        for (int m2 = 0; m2 < 2; ++m2) {
          const int m = mh * 2 + m2;
          const size_t row = (size_t)u.pm * 256 + ai * 128 + wr * 64 + m * 16 + fr;
          float ss = 0.f;
#pragma unroll
          for (int bj = 0; bj < 2; ++bj)
#pragma unroll
            for (int n = 0; n < 2; ++n) {
              const size_t idx = row * 1024 + u.pn * 256 + bj * 128 + wc * 32 + n * 16 + fq * 4;
              f32x4 v = xv[m2][bj][n] + acc[ai][bj][m][n] * scale;
              *(f32x4*)(xout + idx) = v;
              if (xb != nullptr) { uint2 o; o.x = pack2(v[0], v[1]); o.y = pack2(v[2], v[3]); *(uint2*)(xb + idx) = o; }
              ss += v[0] * v[0] + v[1] * v[1] + v[2] * v[2] + v[3] * v[3];
            }
          ss = sumq4(ss);
          if (fq == 0 && xb != nullptr) ssqo[row * 16 + u.pn * 4 + wc] = ss;
        }
      }
  }
};
struct Epi8InProj {
  static constexpr bool PERM = true;
  const float* ssq; bf16_t* Pbase; bf16_t* Cat; float* G; const float* mq_gain; const float* gate_bias;
  __device__ __forceinline__ void operator()(const Acc8& acc, const Unit& u, int ui, int wr, int wc, int fr, int fq) const {
    if (u.pn < 12) {
      const int arr = u.pn / 3, c0 = (u.pn - arr * 3) * 256;
      epi8_plain(acc, u, ui, wr, wc, fr, fq, ssq, Pbase + (size_t)arr * kT * 768, 768, c0);
    } else if (u.pn == 12) {
      epi8_headnorm(acc, u, ui, wr, wc, fr, fq, ssq, mq_gain, 0.125f, Cat, 1024, 768);
    } else if (wc == 0) {
      float rs8[2][4];
      rstd8(ui, wr, fr, rs8);
      if (fq == 0) {
#pragma unroll
        for (int ai = 0; ai < 2; ++ai)
#pragma unroll
          for (int m = 0; m < 4; ++m) {
            const size_t row = (size_t)u.pm * 256 + ai * 128 + wr * 64 + m * 16 + fr;
            *(f32x4*)(G + row * 8) = acc[ai][0][m][0] * rs8[ai][m];
            *(f32x4*)(G + row * 8 + 4) = acc[ai][0][m][1] * rs8[ai][m];
          }
      }
    }
  }
};
struct Epi8KvFfn {
  static constexpr bool PERM = true;
  const float* ssq; bf16_t* H; bf16_t* Ksh; bf16_t* Vtmp; const float* kgain;
  __device__ __forceinline__ void operator()(const Acc8& acc, const Unit& u, int ui, int wr, int wc, int fr, int fq) const {
    if (u.pn < 22) epi8_swiglu(acc, u, ui, wr, wc, fr, fq, ssq, H);
    else if (u.pn < 25) epi8_headnorm(acc, u, ui, wr, wc, fr, fq, ssq, kgain, 1.f, Ksh, 768, (u.pn - 22) * 256);
    else epi8_plain(acc, u, ui, wr, wc, fr, fq, ssq, Vtmp, 768, (u.pn - 25) * 256);
  }
};
struct Epi8QProj {
  static constexpr bool PERM = true;
  const float* ssq; bf16_t* Cat; const float* qgain; const float* mqgain;
  __device__ __forceinline__ void operator()(const Acc8& acc, const Unit& u, int ui, int wr, int wc, int fr, int fq) const {
    epi8_headnorm(acc, u, ui, wr, wc, fr, fq, ssq, (u.pn < 3) ? qgain : mqgain, 0.125f, Cat, 1024, u.pn * 256);
  }
};
struct Epi8MemKv {
  static constexpr bool PERM = true;
  const float* ssq; bf16_t* Kmem; bf16_t* Vtok; const float* kgain;
  __device__ __forceinline__ void operator()(const Acc8& acc, const Unit& u, int ui, int wr, int wc, int fr, int fq) const {
    if (u.pn == 0) epi8_headnorm(acc, u, ui, wr, wc, fr, fq, ssq, kgain, 1.f, Kmem, 256, 0);
    else epi8_plain(acc, u, ui, wr, wc, fr, fq, ssq, Vtok, 256, 0);
  }
};
__device__ __forceinline__ void memv_transpose(const bf16_t* Vtok, bf16_t* VmT) {
  for (int i = blockIdx.x * NTHR + threadIdx.x; i < 2 * 512 * 256; i += gridDim.x * NTHR) {
    const int mm = i & 255, e = (i >> 8) & 255, lb = i >> 16;
    VmT[i] = Vtok[((size_t)lb * 256 + mm) * 256 + e];
  }
}

__device__ __forceinline__ void phase_vtranspose(const bf16_t* Vtmp, bf16_t* VshT) {
  bf16_t* sT = (bf16_t*)smem;
  const int tid = threadIdx.x;
  for (int item = blockIdx.x; item < 256 * 12; item += gridDim.x) {
    const int head = item % 12, tt = item / 12, tokbase = tt * 128, b = tokbase / kS, pos0 = tokbase - b * kS;
    const int g = head >> 2, d = 1 << (2 * g);
    __syncthreads();
    for (int it = tid; it < 128 * 8; it += NTHR) {
      const int t = it >> 3, e8 = (it & 7) * 8;
      uint4 v = *(const uint4*)(Vtmp + (size_t)(tokbase + t) * 768 + head * 64 + e8);
      sT[(e8 + 0) * 136 + t] = (bf16_t)(v.x & 0xffff); sT[(e8 + 1) * 136 + t] = (bf16_t)(v.x >> 16);
      sT[(e8 + 2) * 136 + t] = (bf16_t)(v.y & 0xffff); sT[(e8 + 3) * 136 + t] = (bf16_t)(v.y >> 16);
      sT[(e8 + 4) * 136 + t] = (bf16_t)(v.z & 0xffff); sT[(e8 + 5) * 136 + t] = (bf16_t)(v.z >> 16);
      sT[(e8 + 6) * 136 + t] = (bf16_t)(v.w & 0xffff); sT[(e8 + 7) * 136 + t] = (bf16_t)(v.w >> 16);
    }
    __syncthreads();
    for (int pc = tid; pc < 64 * 16; pc += NTHR) {
      const int e = pc >> 4, piece = pc & 15;
      const int rr = (g == 0) ? 0 : (g == 1) ? (piece >> 2) : piece;
      const int s8 = (g == 0) ? piece : (g == 1) ? (piece & 3) : 0;
      const bf16_t* src = sT + e * 136 + rr;
      uint4 o;
      o.x = (uint32_t)src[(s8 * 8 + 0) * d] | ((uint32_t)src[(s8 * 8 + 1) * d] << 16);
      o.y = (uint32_t)src[(s8 * 8 + 2) * d] | ((uint32_t)src[(s8 * 8 + 3) * d] << 16);
      o.z = (uint32_t)src[(s8 * 8 + 4) * d] | ((uint32_t)src[(s8 * 8 + 5) * d] << 16);
      o.w = (uint32_t)src[(s8 * 8 + 6) * d] | ((uint32_t)src[(s8 * 8 + 7) * d] << 16);
      *(uint4*)(VshT + ((size_t)(b * 12 + head) * 64 + e) * kS + rr * (kS / d) + pos0 / d + s8 * 8) = o;
    }
  }
}

__device__ __forceinline__ bf16x8 u4_to_frag(uint4 v) { return __builtin_bit_cast(bf16x8, v); }
__device__ __forceinline__ uint4 mul_bf16x8(uint4 a, uint4 b) {
  uint4 o;
  o.x = pack2(bflo(a.x) * bflo(b.x), bfhi(a.x) * bfhi(b.x));
  o.y = pack2(bflo(a.y) * bflo(b.y), bfhi(a.y) * bfhi(b.y));
  o.z = pack2(bflo(a.z) * bflo(b.z), bfhi(a.z) * bfhi(b.z));
  o.w = pack2(bflo(a.w) * bflo(b.w), bfhi(a.w) * bfhi(b.w));
  return o;
}

__device__ __forceinline__ void phase_prep(const Params& P) {
  const bf16_t* Pk = (const bf16_t*)(P.ws + OFF_R1) + (size_t)kT * 768;
  const bf16_t* Pv = Pk + (size_t)kT * 768;
  bf16_t* kc = (bf16_t*)(P.ws + OFF_XB);
  bf16_t* kTt = (bf16_t*)(P.ws + OFF_R2);
  bf16_t* VT = kTt + (size_t)kT * 768;
  const float* G = (const float*)(P.ws + OFF_G);
  float* uArr = (float*)(P.ws + OFF_U);
  float* bArr = (float*)(P.ws + OFF_BC);
  bf16_t* eW = (bf16_t*)(P.ws + OFF_EW);
  float* umaxA = (float*)(P.ws + OFF_UMAX);
  float* blA = (float*)(P.ws + OFF_BL);
  bf16_t* sX = (bf16_t*)smem;
  float* sF = (float*)(smem + 51200);
  const int tid = threadIdx.x;
  const float kscale = 0.07216878364870322f;
  for (int item = blockIdx.x; item < 1024; item += gridDim.x) {
    const int bh = item >> 7, c = item & 127, b = bh >> 2, h = bh & 3;
    const size_t tok0 = (size_t)b * kS + (size_t)c * 128;
    __syncthreads();
    float ig = 0.f;
    if (tid < 128) {
      ig = G[(tok0 + tid) * 8 + h] + P.a_gate_bias[h];
      float fg = G[(tok0 + tid) * 8 + 4 + h] + P.a_gate_bias[4 + h];
      sF[tid] = fminf(fg, 0.f) - log1pf(__expf(-fabsf(fg)));
    }
    __syncthreads();
    float bt = 0.f;
    if (tid < 128) for (int s2 = 0; s2 <= tid; ++s2) bt += sF[s2];
    const float ut = ig - bt;
    __syncthreads();
    if (tid < 128) sF[tid] = ut;
    __syncthreads();
    float um = -3.0e38f;
    for (int s2 = 0; s2 < 128; ++s2) um = fmaxf(um, sF[s2]);
    if (tid < 128) {
      uArr[(size_t)item * 128 + tid] = ut;
      bArr[(size_t)item * 128 + tid] = bt;
      eW[(size_t)item * 128 + tid] = f2bf(__expf(ut - um));
      if (tid == 127) blA[item] = bt;
      if (tid == 0) umaxA[item] = um;
    }
    for (int it = tid; it < 128 * 24; it += NTHR) {
      const int t = it / 24, ch = (it - t * 24) * 8;
      const int spos = c * 128 + t;
      const bf16_t* src = Pk + (tok0 + t) * 768 + h * 192 + ch;
      uint4 xv[4];
      float4 w0[4], w1[4];
#pragma unroll
      for (int j = 0; j < 4; ++j) {
        xv[j] = make_uint4(0u, 0u, 0u, 0u);
        if (spos - 3 + j >= 0) xv[j] = *(const uint4*)(src - (ptrdiff_t)(3 - j) * 768);
        const float4* wp = (const float4*)(P.a_conv + j * 1536 + 768 + h * 192 + ch);
        w0[j] = wp[0]; w1[j] = wp[1];
      }
      VMWAIT();
      float a[8] = {0.f, 0.f, 0.f, 0.f, 0.f, 0.f, 0.f, 0.f};
#pragma unroll
      for (int j = 0; j < 4; ++j) {
        a[0] += w0[j].x * bflo(xv[j].x); a[1] += w0[j].y * bfhi(xv[j].x); a[2] += w0[j].z * bflo(xv[j].y); a[3] += w0[j].w * bfhi(xv[j].y);
        a[4] += w1[j].x * bflo(xv[j].z); a[5] += w1[j].y * bfhi(xv[j].z); a[6] += w1[j].z * bflo(xv[j].w); a[7] += w1[j].w * bfhi(xv[j].w);
      }
#pragma unroll
      for (int e = 0; e < 8; ++e) a[e] = a[e] / (1.f + __expf(-a[e])) * kscale;
      uint4 o; o.x = pack2(a[0], a[1]); o.y = pack2(a[2], a[3]); o.z = pack2(a[4], a[5]); o.w = pack2(a[6], a[7]);
      *(uint4*)(kc + (tok0 + t) * 768 + h * 192 + ch) = o;
      *(uint4*)(sX + t * 200 + ch) = o;
    }
    __syncthreads();
    for (int it = tid; it < 192 * 16; it += NTHR) {
      const int k = it >> 4, lg = it & 15;
      uint4 o;
      o.x = (uint32_t)sX[(lg * 8 + 0) * 200 + k] | ((uint32_t)sX[(lg * 8 + 1) * 200 + k] << 16);
      o.y = (uint32_t)sX[(lg * 8 + 2) * 200 + k] | ((uint32_t)sX[(lg * 8 + 3) * 200 + k] << 16);
      o.z = (uint32_t)sX[(lg * 8 + 4) * 200 + k] | ((uint32_t)sX[(lg * 8 + 5) * 200 + k] << 16);
      o.w = (uint32_t)sX[(lg * 8 + 6) * 200 + k] | ((uint32_t)sX[(lg * 8 + 7) * 200 + k] << 16);
      *(uint4*)(kTt + ((size_t)item * 192 + k) * 128 + lg * 8) = o;
    }
    __syncthreads();
    for (int it = tid; it < 128 * 24; it += NTHR) {
      const int t = it / 24, ch = (it - t * 24) * 8;
      uint4 v = *(const uint4*)(Pv + (tok0 + t) * 768 + h * 192 + ch);
      *(uint4*)(sX + t * 200 + ch) = v;
    }
    __syncthreads();
    for (int it = tid; it < 192 * 16; it += NTHR) {
      const int k = it >> 4, lg = it & 15;
      uint4 o;
      o.x = (uint32_t)sX[(lg * 8 + 0) * 200 + k] | ((uint32_t)sX[(lg * 8 + 1) * 200 + k] << 16);
      o.y = (uint32_t)sX[(lg * 8 + 2) * 200 + k] | ((uint32_t)sX[(lg * 8 + 3) * 200 + k] << 16);
      o.z = (uint32_t)sX[(lg * 8 + 4) * 200 + k] | ((uint32_t)sX[(lg * 8 + 5) * 200 + k] << 16);
      o.w = (uint32_t)sX[(lg * 8 + 6) * 200 + k] | ((uint32_t)sX[(lg * 8 + 7) * 200 + k] << 16);
      *(uint4*)(VT + ((size_t)item * 192 + k) * 128 + lg * 8) = o;
    }
  }
}

__device__ __forceinline__ void phase_scan(const Params& P) {
  const bf16_t* kTt = (const bf16_t*)(P.ws + OFF_R2);
  const bf16_t* VT = kTt + (size_t)kT * 768;
  const bf16_t* eW = (const bf16_t*)(P.ws + OFF_EW);
  const float* umaxA = (const float*)(P.ws + OFF_UMAX);
  const float* blA = (const float*)(P.ws + OFF_BL);
  float* m0A = (float*)(P.ws + OFF_M0);
  bf16_t* C0T = (bf16_t*)(P.ws + OFF_R1) + (size_t)kT * 768;
  const int lane = threadIdx.x & 63, wid = threadIdx.x >> 6, nw = gridDim.x * NWAVE;
  const int r = lane & 15, q = lane >> 4;
  for (int unit = wid * gridDim.x + blockIdx.x; unit < 416; unit += nw) {
    const int bh = unit / 52, rem = unit - bh * 52, mv = rem >> 2, nk = rem & 3;
    const bf16_t* vt_base = VT + ((size_t)bh * 128 * 192 + (mv < 12 ? mv : 0) * 16 + r) * 128 + q * 8;
    const bf16_t* kt_base = kTt + ((size_t)bh * 128 * 192 + nk * 48 + r) * 128 + q * 8;
    const bf16_t* ew_base = eW + (size_t)bh * 128 * 128 + q * 8;
    bf16_t* c0_base = C0T + ((size_t)bh * 128 * 208 + mv * 16 + q * 4) * 192 + nk * 48 + r;
    f32x4 acc[3];
#pragma unroll
    for (int n = 0; n < 3; ++n) acc[n] = (f32x4){0.f, 0.f, 0.f, 0.f};
    float m = 0.f;
    uint4 A[4], B[3][4], E[4];
    float bl, um;
#define SCAN_LOAD(A_, B_, E_, bl_, um_, cc)                                                            \
  do {                                                                                                 \
    _Pragma("unroll") for (int ks = 0; ks < 4; ++ks) {                                                 \
      A_[ks] = *(const uint4*)(vt_base + (size_t)(cc) * 192 * 128 + ks * 32);                          \
      E_[ks] = *(const uint4*)(ew_base + (size_t)(cc) * 128 + ks * 32);                                \
      _Pragma("unroll") for (int n = 0; n < 3; ++n)                                                    \
        B_[n][ks] = *(const uint4*)(kt_base + (size_t)(cc) * 192 * 128 + (size_t)n * 16 * 128 + ks * 32); \
    }                                                                                                  \
    bl_ = blA[bh * 128 + (cc)]; um_ = umaxA[bh * 128 + (cc)];                                          \
  } while (0)
    SCAN_LOAD(A, B, E, bl, um, 0);
    VMWAIT();
    for (int c = 0; c < 128; ++c) {
#pragma unroll
      for (int n = 0; n < 3; ++n)
#pragma unroll
        for (int j = 0; j < 4; ++j) c0_base[(size_t)c * 208 * 192 + j * 192 + n * 16] = f2bf(acc[n][j]);
      if (rem == 0 && lane == 0) m0A[bh * 128 + c] = m;
      uint4 nA[4], nB[3][4], nE[4];
      float nbl = 0.f, num = 0.f;
      const int cn = (c + 1 < 128) ? c + 1 : c;
      SCAN_LOAD(nA, nB, nE, nbl, num, cn);
      const float mn = fmaxf(bl + m, bl + um);
      const float decay = __expf(bl + m - mn), sc = __expf(um + bl - mn);
      m = mn;
      f32x4 U[3];
#pragma unroll
      for (int n = 0; n < 3; ++n) U[n] = (f32x4){0.f, 0.f, 0.f, 0.f};
#pragma unroll
      for (int ks = 0; ks < 4; ++ks) {
        uint4 af;
        if (mv < 12) af = mul_bf16x8(A[ks], E[ks]);
        else af = (r == 0) ? E[ks] : make_uint4(0u, 0u, 0u, 0u);
#pragma unroll
        for (int n = 0; n < 3; ++n)
          U[n] = __builtin_amdgcn_mfma_f32_16x16x32_bf16(u4_to_frag(af), u4_to_frag(B[n][ks]), U[n], 0, 0, 0);
      }
#pragma unroll
      for (int n = 0; n < 3; ++n)
#pragma unroll
        for (int j = 0; j < 4; ++j) acc[n][j] = acc[n][j] * decay + sc * U[n][j];
      VMWAIT();
#pragma unroll
      for (int ks = 0; ks < 4; ++ks) {
        A[ks] = nA[ks]; E[ks] = nE[ks];
#pragma unroll
        for (int n = 0; n < 3; ++n) B[n][ks] = nB[n][ks];
      }
      bl = nbl; um = num;
    }
#undef SCAN_LOAD
  }
}

__device__ __forceinline__ void phase_chunk(const Params& P) {
  const bf16_t* Pq = (const bf16_t*)(P.ws + OFF_R1);
  const bf16_t* Po = Pq + (size_t)3 * kT * 768;
  const bf16_t* C0T = Pq + (size_t)kT * 768;
  const bf16_t* kc = (const bf16_t*)(P.ws + OFF_XB);
  const bf16_t* VT = (const bf16_t*)(P.ws + OFF_R2) + (size_t)kT * 768;
  const float* uArr = (const float*)(P.ws + OFF_U);
  const float* bArr = (const float*)(P.ws + OFF_BC);
  const float* m0A = (const float*)(P.ws + OFF_M0);
  bf16_t* Cat = (bf16_t*)(P.ws + OFF_CAT);
  bf16_t* sQ = (bf16_t*)smem;
  float* sU = (float*)(smem + 51200);
  float* sMx = (float*)(smem + 51712);
  float* sBt = (float*)(smem + 52224);
  float* sCw = (float*)(smem + 52736);
  const int tid = threadIdx.x, lane = tid & 63, wid = tid >> 6, r = lane & 15, q = lane >> 4;
  bf16_t* sWw = (bf16_t*)(smem + 55808) + wid * (16 * 136);
  for (int item = blockIdx.x; item < 1024; item += gridDim.x) {
    const int bh = item >> 7, c = item & 127, b = bh >> 2, h = bh & 3;
    const size_t tok0 = (size_t)b * kS + (size_t)c * 128;
    __syncthreads();
    for (int i = tid; i < 768; i += NTHR) { int j = i / 192, ch = i - j * 192; sCw[i] = P.a_conv[j * 1536 + h * 192 + ch]; }
    if (tid < 128) { sU[tid] = uArr[(size_t)item * 128 + tid]; sBt[tid] = bArr[(size_t)item * 128 + tid]; }
    const float m0 = m0A[item];
    __syncthreads();
    if (tid < 128) {
      float mx = m0;
      for (int s2 = 0; s2 <= tid; ++s2) mx = fmaxf(mx, sU[s2]);
      sMx[tid] = mx;
    }
    for (int it = tid; it < 128 * 24; it += NTHR) {
      const int t = it / 24, ch = (it - t * 24) * 8;
      const int spos = c * 128 + t;
      const bf16_t* src = Pq + (tok0 + t) * 768 + h * 192 + ch;
      float a[8] = {0.f, 0.f, 0.f, 0.f, 0.f, 0.f, 0.f, 0.f};
#pragma unroll
      for (int j = 0; j < 4; ++j) {
        uint4 xv = make_uint4(0u, 0u, 0u, 0u);
        if (spos - 3 + j >= 0) xv = *(const uint4*)(src - (ptrdiff_t)(3 - j) * 768);
        const float* w = sCw + j * 192 + ch;
        a[0] += w[0] * bflo(xv.x); a[1] += w[1] * bfhi(xv.x); a[2] += w[2] * bflo(xv.y); a[3] += w[3] * bfhi(xv.y);
        a[4] += w[4] * bflo(xv.z); a[5] += w[5] * bfhi(xv.z); a[6] += w[6] * bflo(xv.w); a[7] += w[7] * bfhi(xv.w);
      }
#pragma unroll
      for (int e = 0; e < 8; ++e) a[e] = a[e] / (1.f + __expf(-a[e]));
      uint4 o; o.x = pack2(a[0], a[1]); o.y = pack2(a[2], a[3]); o.z = pack2(a[4], a[5]); o.w = pack2(a[6], a[7]);
      *(uint4*)(sQ + t * 200 + ch) = o;
    }
    __syncthreads();
    {
      const int t0 = wid * 16, nmax = t0 >> 4, ks2max = (t0 + 15) >> 5;
      {
        bf16x8 Qf[6];
#pragma unroll
        for (int ks = 0; ks < 6; ++ks) Qf[ks] = *(const bf16x8*)(sQ + (t0 + r) * 200 + ks * 32 + q * 8);
        float mxr[4];
#pragma unroll
        for (int j = 0; j < 4; ++j) mxr[j] = sMx[t0 + q * 4 + j];
#pragma unroll
        for (int n = 0; n < 8; ++n) {
          f32x4 sa = (f32x4){0.f, 0.f, 0.f, 0.f};
          if (n <= nmax) {
            uint4 Kf[6];
#pragma unroll
            for (int ks = 0; ks < 6; ++ks) Kf[ks] = *(const uint4*)(kc + (tok0 + n * 16 + r) * 768 + h * 192 + ks * 32 + q * 8);
#pragma unroll
            for (int ks = 0; ks < 6; ++ks) sa = __builtin_amdgcn_mfma_f32_16x16x32_bf16(Qf[ks], u4_to_frag(Kf[ks]), sa, 0, 0, 0);
          }
          const int scol = n * 16 + r;
          const float us = sU[scol];
#pragma unroll
          for (int j = 0; j < 4; ++j) {
            const int trow = t0 + q * 4 + j;
            float w = (n <= nmax && scol <= trow) ? __expf(us - mxr[j]) * sa[j] : 0.f;
            sWw[(q * 4 + j) * 136 + scol] = f2bf(w);
          }
        }
      }
      f32x4 acc[13];
#pragma unroll
      for (int nv = 0; nv < 13; ++nv) acc[nv] = (f32x4){0.f, 0.f, 0.f, 0.f};
      bf16_t* sB = (bf16_t*)(smem + 90624);
#pragma unroll 1
      for (int kp = 0; kp < 3; ++kp) {
        __syncthreads();
        for (int i = tid; i < 208 * 8; i += NTHR) {
          const int row = i >> 3, c8 = (i & 7) * 8;
          *(uint4*)(sB + row * 72 + c8) = *(const uint4*)(C0T + ((size_t)item * 208 + row) * 192 + kp * 64 + c8);
        }
        __syncthreads();
#pragma unroll
        for (int e = 0; e < 2; ++e) {
          const bf16x8 qf = *(const bf16x8*)(sQ + (t0 + r) * 200 + (kp * 2 + e) * 32 + q * 8);
#pragma unroll
          for (int nv = 0; nv < 13; ++nv)
            acc[nv] = __builtin_amdgcn_mfma_f32_16x16x32_bf16(qf, *(const bf16x8*)(sB + (nv * 16 + r) * 72 + e * 32 + q * 8), acc[nv], 0, 0, 0);
        }
      }
#pragma unroll
      for (int j = 0; j < 4; ++j) {
        const float inter = __expf(m0 - sMx[t0 + q * 4 + j]);
#pragma unroll
        for (int nv = 0; nv < 13; ++nv) acc[nv][j] *= inter;
      }
#pragma unroll 1
      for (int sp = 0; sp < 2; ++sp) {
        __syncthreads();
        for (int i = tid; i < 192 * 8; i += NTHR) {
          const int row = i >> 3, c8 = (i & 7) * 8;
          *(uint4*)(sB + row * 72 + c8) = *(const uint4*)(VT + ((size_t)item * 192 + row) * 128 + sp * 64 + c8);
        }
        __syncthreads();
        if (sp * 2 <= ks2max) {
          const uint32_t one2 = (r == 0) ? 0x3F803F80u : 0u;
          const bf16x8 onef = u4_to_frag(make_uint4(one2, one2, one2, one2));
#pragma unroll
          for (int e = 0; e < 2; ++e) {
            const bf16x8 wf = *(const bf16x8*)(sWw + r * 136 + (sp * 2 + e) * 32 + q * 8);
#pragma unroll
            for (int nv = 0; nv < 12; ++nv)
              acc[nv] = __builtin_amdgcn_mfma_f32_16x16x32_bf16(wf, *(const bf16x8*)(sB + (nv * 16 + r) * 72 + e * 32 + q * 8), acc[nv], 0, 0, 0);
            acc[12] = __builtin_amdgcn_mfma_f32_16x16x32_bf16(wf, onef, acc[12], 0, 0, 0);
          }
        }
      }
      float hg[12];
#pragma unroll
      for (int nv = 0; nv < 12; ++nv) hg[nv] = P.a_h_norm[h * 192 + nv * 16 + r];
#pragma unroll 1
      for (int j = 0; j < 4; ++j) {
        const int trow = t0 + q * 4 + j;
        const size_t tok = tok0 + trow;
        float og[12];
#pragma unroll
        for (int nv = 0; nv < 12; ++nv) og[nv] = bf2f(Po[tok * 768 + h * 192 + nv * 16 + r]);
        float accj[13];
#pragma unroll
        for (int nv = 0; nv < 13; ++nv) accj[nv] = (j == 0) ? acc[nv][0] : (j == 1) ? acc[nv][1] : (j == 2) ? acc[nv][2] : acc[nv][3];
        const float den = __shfl(accj[12], lane & 48);
        const float mt = sBt[trow] + sMx[trow];
        const float inv = 1.f / fmaxf(fabsf(den), __expf(-mt));
        float ss = 0.f;
#pragma unroll
        for (int nv = 0; nv < 12; ++nv) { accj[nv] *= inv; ss += accj[nv] * accj[nv]; }
        ss = sum16(ss);
        const float rstd = rsqrtf(ss * (1.f / 192.f) + EPS);
        VMWAIT();
#pragma unroll
        for (int nv = 0; nv < 12; ++nv)
          Cat[tok * 1024 + h * 192 + nv * 16 + r] = f2bf(accj[nv] * rstd * hg[nv] * sigmoidf_(og[nv]));
      }
    }
  }
}

__device__ __forceinline__ float t5_bias(const float* rel_bias, int dist, int head) {
  int bucket;
  if (dist < 16) bucket = dist;
  else {
    int large = 16 + (int)(logf((float)dist / 16.f) / 4.852030263919617f * 16.f);
    bucket = large < 31 ? large : 31;
  }
  return rel_bias[bucket * 12 + head];
}

__device__ __forceinline__ void memattn_mfma(const Params& P, int layer, int gw, int nw) {
  bf16_t* Cat = (bf16_t*)(P.ws + OFF_CAT);
  const bf16_t* Kmem = (const bf16_t*)(P.ws + OFF_KMEM) + (size_t)layer * 512 * 256;
  const bf16_t* VmT = (const bf16_t*)(P.ws + OFF_VMEM) + (size_t)layer * 512 * 256;
  const int lane = threadIdx.x & 63, wid = threadIdx.x >> 6, r = lane & 15, q = lane >> 4;
  bf16_t* sP = (bf16_t*)smem + wid * (16 * 264);
  if (gw < 0) return;
  for (int item = gw; item < (kT / 16) * 4; item += nw) {
    const int head = item & 3;
    const size_t tok0 = (size_t)(item >> 2) * 16;
    const int b = (int)(tok0 / kS);
    bf16_t* qbase = Cat + tok0 * 1024 + 768 + head * 64;
    const uint4 qf0 = *(const uint4*)(qbase + (size_t)r * 1024 + q * 8);
    const uint4 qf1 = *(const uint4*)(qbase + (size_t)r * 1024 + 32 + q * 8);
    const bf16_t* Kb = Kmem + (size_t)b * 256 * 256 + head * 64 + q * 8;
    f32x4 sa[16];
#pragma unroll
    for (int n = 0; n < 16; ++n) {
      const uint4 k0 = *(const uint4*)(Kb + (size_t)(n * 16 + r) * 256);
      const uint4 k1 = *(const uint4*)(Kb + (size_t)(n * 16 + r) * 256 + 32);
      sa[n] = __builtin_amdgcn_mfma_f32_16x16x32_bf16(u4_to_frag(qf0), u4_to_frag(k0), (f32x4){0.f, 0.f, 0.f, 0.f}, 0, 0, 0);
      sa[n] = __builtin_amdgcn_mfma_f32_16x16x32_bf16(u4_to_frag(qf1), u4_to_frag(k1), sa[n], 0, 0, 0);
      if ((n & 3) == 3) __builtin_amdgcn_sched_barrier(0);
    }
    float inv[4];
#pragma unroll
    for (int j = 0; j < 4; ++j) {
      float mx = sa[0][j];
#pragma unroll
      for (int n = 1; n < 16; ++n) mx = fmaxf(mx, sa[n][j]);
      mx = max16(mx);
      float sum = 0.f;
#pragma unroll
      for (int n = 0; n < 16; ++n) {
        float p = __expf(sa[n][j] - mx);
        sum += p;
        sP[(q * 4 + j) * 264 + n * 16 + r] = f2bf(p);
      }
      inv[j] = 1.f / sum16(sum);
    }
    f32x4 o[4];
#pragma unroll
    for (int ne = 0; ne < 4; ++ne) o[ne] = (f32x4){0.f, 0.f, 0.f, 0.f};
    const bf16_t* Vb = VmT + (size_t)(b * 4 + head) * 64 * 256 + q * 8;
#pragma unroll
    for (int ks = 0; ks < 8; ++ks) {
      const bf16x8 pf = *(const bf16x8*)(sP + r * 264 + ks * 32 + q * 8);
#pragma unroll
      for (int ne = 0; ne < 4; ++ne) {
        const uint4 vf = *(const uint4*)(Vb + (size_t)(ne * 16 + r) * 256 + ks * 32);
        o[ne] = __builtin_amdgcn_mfma_f32_16x16x32_bf16(pf, u4_to_frag(vf), o[ne], 0, 0, 0);
      }
      if (ks & 1) __builtin_amdgcn_sched_barrier(0);
    }
    VMWAIT();
#pragma unroll
    for (int ne = 0; ne < 4; ++ne)
#pragma unroll
      for (int j = 0; j < 4; ++j) qbase[(size_t)(q * 4 + j) * 1024 + ne * 16 + r] = f2bf(o[ne][j] * inv[j]);
  }
}

__device__ __forceinline__ void dilated_slab(const Params& P, int pass, int sidx, int b, int p0, int hg, const float* sBias,
                                             float* sLse, bf16_t* sP) {
  bf16_t* Cat = (bf16_t*)(P.ws + OFF_CAT);
  const bf16_t* Ksh = (const bf16_t*)(P.ws + OFF_R2);
  const bf16_t* VshT = Ksh + (size_t)kT * 768;
  const int lane = threadIdx.x & 63, r = lane & 15, q = lane >> 4;
  const int g = sidx >> 4, i = sidx & 15, d = 1 << (2 * g), head = g * 4 + hg;
  const int r_res = (g == 0) ? 0 : (g == 1) ? (i >> 2) : i;
  const int sig0 = (g == 0) ? (p0 + 16 * i) : (g == 1) ? ((p0 >> 2) + 16 * (i & 3)) : (p0 >> 4);
  const size_t tokq = (size_t)b * kS + (size_t)(sig0 + r) * d + r_res;
  const uint4 qf0 = *(const uint4*)(Cat + tokq * 1024 + head * 64 + q * 8);
  const uint4 qf1 = *(const uint4*)(Cat + tokq * 1024 + head * 64 + 32 + q * 8);
  f32x4 sa[10];
  sa[0] = (f32x4){0.f, 0.f, 0.f, 0.f};
#pragma unroll
  for (int n = 1; n < 10; ++n) {
    int sigk = sig0 - 144 + n * 16 + r;
    sigk = sigk < 0 ? 0 : sigk;
    const bf16_t* kp = Ksh + ((size_t)b * kS + (size_t)sigk * d + r_res) * 768 + head * 64 + q * 8;
    const uint4 k0 = *(const uint4*)kp;
    const uint4 k1 = *(const uint4*)(kp + 32);
    sa[n] = __builtin_amdgcn_mfma_f32_16x16x32_bf16(u4_to_frag(qf0), u4_to_frag(k0), (f32x4){0.f, 0.f, 0.f, 0.f}, 0, 0, 0);
    sa[n] = __builtin_amdgcn_mfma_f32_16x16x32_bf16(u4_to_frag(qf1), u4_to_frag(k1), sa[n], 0, 0, 0);
  }
  float scl[4];
#pragma unroll
  for (int j = 0; j < 4; ++j) {
    float mx = -1e30f;
#pragma unroll
    for (int n = 1; n < 10; ++n) {
      const int mo = 144 + q * 4 + j - n * 16 - r;
      const int sigk = sig0 - 144 + n * 16 + r;
      const bool ok = (mo >= 0) && (mo <= 128) && (sigk >= 0);
      const float sv = ok ? (sa[n][j] + sBias[g * 132 + (ok ? mo : 0)]) : -1e30f;
      sa[n][j] = sv;
      mx = fmaxf(mx, sv);
    }
    mx = max16(mx);
    float sum = 0.f;
#pragma unroll
    for (int n = 1; n < 10; ++n) {
      const float p = (sa[n][j] > -1e29f) ? __expf(sa[n][j] - mx) : 0.f;
      sa[n][j] = p;
      sum += p;
    }
    sum = sum16(sum);
    const float lse = mx + __logf(sum);
    const int pw = (sig0 + q * 4 + j) * d + r_res - p0;
    if (pass == 0) {
      if (r == 0) sLse[g * 256 + pw] = lse;
      scl[j] = 0.f;
    } else {
      const float l0 = sLse[pw], l1 = sLse[256 + pw], l2 = sLse[512 + pw];
      const float L = fmaxf(fmaxf(l0, l1), l2);
      const float den = __expf(l0 - L) + __expf(l1 - L) + __expf(l2 - L);
      scl[j] = __expf(lse - L) / (den * sum);
    }
  }
  if (pass == 0) return;
#pragma unroll
  for (int j = 0; j < 4; ++j) {
#pragma unroll
    for (int n = 0; n < 10; ++n) sP[(q * 4 + j) * 168 + n * 16 + r] = f2bf(sa[n][j]);
  }
  f32x4 o[4];
#pragma unroll
  for (int ne = 0; ne < 4; ++ne) o[ne] = (f32x4){0.f, 0.f, 0.f, 0.f};
  const bf16_t* Vb = VshT + ((size_t)(b * 12 + head) * 64 + r) * kS + (size_t)r_res * (kS / d);
#pragma unroll
  for (int ks = 0; ks < 5; ++ks) {
    const bf16x8 pf = *(const bf16x8*)(sP + r * 168 + ks * 32 + q * 8);
    int sk0 = sig0 - 144 + ks * 32 + q * 8;
    sk0 = sk0 < 0 ? 0 : sk0;
#pragma unroll
    for (int ne = 0; ne < 4; ++ne) {
      const uint4 vf = *(const uint4*)(Vb + (size_t)ne * 16 * kS + sk0);
      o[ne] = __builtin_amdgcn_mfma_f32_16x16x32_bf16(pf, u4_to_frag(vf), o[ne], 0, 0, 0);
    }
  }
  VMWAIT();
#pragma unroll
  for (int ne = 0; ne < 4; ++ne)
#pragma unroll
    for (int j = 0; j < 4; ++j) {
      const size_t tok = (size_t)b * kS + (size_t)(sig0 + q * 4 + j) * d + r_res;
      Cat[tok * 1024 + head * 64 + ne * 16 + r] = f2bf(o[ne][j] * scl[j]);
    }
}

__device__ __forceinline__ void phase_dilated_mfma(const Params& P) {
  float* sBias = (float*)smem;
  float* sLse = (float*)(smem + 1584);
  const int tid = threadIdx.x, wid = tid >> 6;
  bf16_t* sP = (bf16_t*)(smem + 4656) + wid * (16 * 168);
  for (int item = blockIdx.x; item < 512; item += gridDim.x) {
    const int hg = item & 3, win = item >> 2, b = win >> 6, p0 = (win & 63) * 256;
    __syncthreads();
    for (int i = tid; i < 3 * 129; i += NTHR) {
      const int g = i / 129, mo = i - g * 129;
      sBias[g * 132 + mo] = t5_bias(P.rel_bias, mo << (2 * g), g * 4 + hg);
    }
    __syncthreads();
#pragma unroll 1
    for (int pass = 0; pass < 2; ++pass) {
#pragma unroll 1
      for (int sidx = wid; sidx < 48; sidx += NWAVE) dilated_slab(P, pass, sidx, b, p0, hg, sBias, sLse, sP);
      VMWAIT();
      __syncthreads();
    }
  }
}

#define XB_TMO      128
#define XB_XCNT(j)  (256  + 64 * (j))
#define XB_XSUB(j)  (1280 + 64 * (j))
#define XB_XGEN(j)  (2304 + 64 * (j))
#define XB_TOP      3328
#define XB_TOPGEN   3392
#define XCD_BAR_WORDS 3456
#define XB_SPIN_CAP (1u << 23)
__device__ __forceinline__ unsigned xb_ld(unsigned* p) { return __hip_atomic_load(p, __ATOMIC_RELAXED, __HIP_MEMORY_SCOPE_AGENT); }
__device__ __forceinline__ unsigned xb_add(unsigned* p, unsigned v) { return __hip_atomic_fetch_add(p, v, __ATOMIC_RELAXED, __HIP_MEMORY_SCOPE_AGENT); }
__device__ __forceinline__ unsigned xb_xcc_id() { return (unsigned)__builtin_amdgcn_s_getreg((3 << 11) | 20) & 0xFu; }
#define XB_SPIN(cond, bar) do { unsigned _sp = 0; while (cond) { __builtin_amdgcn_s_sleep(1); \
    if ((++_sp & 255u) == 0u) { if (xb_ld(&(bar)[XB_TMO])) break; if (_sp > XB_SPIN_CAP) { atomicAdd(&(bar)[XB_TMO], 1u); break; } } } } while (0)
struct XcdBarrier { unsigned* bar; unsigned x; volatile LAS unsigned* st; };
__device__ __forceinline__ XcdBarrier xcd_barrier_post(unsigned* bar, volatile LAS unsigned* st) {
  XcdBarrier b; b.bar = bar; b.x = xb_xcc_id(); b.st = st;
  if (threadIdx.x == 0) (void)xb_add(&bar[XB_XCNT(b.x)], 1u);
  return b;
}
__device__ __forceinline__ void xcd_barrier_complete(unsigned* bar, unsigned x, unsigned& nloc, unsigned& nx) {
  const unsigned Gr = gridDim.x * gridDim.y * gridDim.z;
  unsigned sum, cnt, mine, sp = 0u;
  for (;;) {
    sum = 0u; cnt = 0u; mine = 0u;
#pragma unroll
    for (unsigned j = 0; j < 16; ++j) { const unsigned c = xb_ld(&bar[XB_XCNT(j)]); sum += c; cnt += (c > 0u) ? 1u : 0u; mine = (j == x) ? c : mine; }
    if (sum == Gr) break;
    __builtin_amdgcn_s_sleep(1);
    if ((++sp & 255u) == 0u) { if (xb_ld(&bar[XB_TMO])) break; if (sp > XB_SPIN_CAP) { atomicAdd(&bar[XB_TMO], 1u); break; } }
  }
  nloc = mine > 0u ? mine : 1u; nx = cnt > 0u ? cnt : 1u;
}
__device__ __forceinline__ void xcd_barrier(const XcdBarrier& b) {
  asm volatile("s_waitcnt vmcnt(0)" ::: "memory");
  __syncthreads();
  if (threadIdx.x == 0) {
    unsigned* bar = b.bar;
    __builtin_amdgcn_s_waitcnt(0);
    unsigned nloc = b.st[0], nx = b.st[1];
    if (nloc == 0u) { xcd_barrier_complete(bar, b.x, nloc, nx); b.st[0] = nloc; b.st[1] = nx; }
    const unsigned old = xb_add(&bar[XB_XSUB(b.x)], 1u);
    const unsigned gen = old / nloc;
    if (old + 1u == (gen + 1u) * nloc) {
      __builtin_amdgcn_fence(__ATOMIC_RELEASE, "agent");
      asm volatile("s_waitcnt vmcnt(0)" ::: "memory");
      const unsigned og = xb_add(&bar[XB_TOP], 1u);
      const unsigned tg = og / nx;
      if (og + 1u == (tg + 1u) * nx) xb_add(&bar[XB_TOPGEN], 1u);
      else XB_SPIN(xb_ld(&bar[XB_TOPGEN]) == tg, bar);
      __builtin_amdgcn_fence(__ATOMIC_ACQUIRE, "agent");
      xb_add(&bar[XB_XGEN(b.x)], 1u);
      asm volatile("s_waitcnt vmcnt(0)" ::: "memory");
    } else {
      XB_SPIN(xb_ld(&bar[XB_XGEN(b.x)]) == gen, bar);
      __builtin_amdgcn_fence(__ATOMIC_ACQUIRE, "agent");
      asm volatile("s_waitcnt vmcnt(0)" ::: "memory");
    }
  }
  __syncthreads();
}
#define grid_barrier() xcd_barrier(xbar_)

constexpr int NPHASE = 17;
#ifndef ONLY_PHASE
#define ONLY_PHASE -1
#endif
#ifndef SKIP12
#define SKIP12 0
#endif
#ifndef SKIP14
#define SKIP14 0
#endif
#define PH(n) (ONLY_PHASE < 0 || ONLY_PHASE == (n))

__device__ __forceinline__ char* launder(char* p) { asm volatile("" : "+s"(p)); return p; }
__global__ void __launch_bounds__(512, 2) fwd_megakernel(Params P, int pb, int pe) {
#define W ((bf16_t*)(wsl + OFF_W))
#define xb ((bf16_t*)(wsl + OFF_XB))
#define H ((bf16_t*)(wsl + OFF_R1))
#define Pbase ((bf16_t*)(wsl + OFF_R1))
#define Ksh ((bf16_t*)(wsl + OFF_R2))
#define Vsh (Ksh + (size_t)kT * 768)
#define Cat ((bf16_t*)(wsl + OFF_CAT))
#define ssq ((float*)(wsl + OFF_SSQ))
#define G ((float*)(wsl + OFF_G))
#define memb ((bf16_t*)(wsl + OFF_MEMB))
#define ssqm ((float*)(wsl + OFF_SSQM))
#define Kmem ((bf16_t*)(wsl + OFF_KMEM))
#define Vmem ((bf16_t*)(wsl + OFF_VMEM))
  if (pe < -12345) cg::this_grid().sync();
  volatile LAS unsigned* xst_ = (volatile LAS unsigned*)(smem + 131072);
  if (threadIdx.x == 0) { xst_[0] = 0u; xst_[1] = 0u; }
  __syncthreads();
  XcdBarrier xbar_;
  xbar_.bar = (unsigned*)(P.ws + OFF_BAR); xbar_.x = 0; xbar_.st = xst_;
  if (pe - pb > 1) xbar_ = xcd_barrier_post((unsigned*)(P.ws + OFF_BAR), xst_);
  if (pb == 100) {
    char* wsl = P.ws;
    for (size_t i = (size_t)blockIdx.x * NTHR + threadIdx.x; i < (size_t)kT * 1024; i += (size_t)gridDim.x * NTHR) P.out[i] = bf2f(Cat[i]);
    return;
  }
  {
    if (pb <= 0 && 0 < pe && PH(0)) { char* wsl = launder(P.ws); Params Q = P; Q.ws = wsl; (void)Q; phase_convert(Q); }
    if (pb <= 0 && 0 + 1 < pe) grid_barrier();
    if (pb <= 1 && 1 < pe && PH(1)) { char* wsl = launder(P.ws); Params Q = P; Q.ws = wsl; (void)Q; gemm8(xb, W + W_GU0, kT, 5632, 1024, Epi8Swiglu{ssq, H}); }
    if (pb <= 1 && 1 + 1 < pe) grid_barrier();
    if (pb <= 2 && 2 < pe && PH(2)) { char* wsl = launder(P.ws); Params Q = P; Q.ws = wsl; (void)Q; { gemm8(H, W + W_DN0, kT, 1024, 2816, Epi8Resid{P.x, P.out, xb, ssq, 0.5f});
      gemm8(memb, W + W_MKV0, 512, 512, 1024, Epi8MemKv{ssqm, Kmem, (bf16_t*)(wsl + OFF_VTOK), P.mem_k_norm}, 64);
      gemm8(memb, W + W_MKV1, 512, 512, 1024, Epi8MemKv{ssqm, Kmem + 512 * 256, (bf16_t*)(wsl + OFF_VTOK) + 512 * 256, P.mem_k_norm + 64}, 192);
    } }
    if (pb <= 2 && 2 + 1 < pe) grid_barrier();
    if (pb <= 3 && 3 < pe && PH(3)) { char* wsl = launder(P.ws); Params Q = P; Q.ws = wsl; (void)Q; {
      gemm8(xb, W + W_IN, kT, 3584, 1024, Epi8InProj{ssq, Pbase, Cat, G, P.mem_q_norm, P.a_gate_bias});
    } }
    if (pb <= 3 && 3 + 1 < pe) grid_barrier();
    if (pb <= 4 && 4 < pe && PH(4)) { char* wsl = launder(P.ws); Params Q = P; Q.ws = wsl; (void)Q; { memv_transpose((const bf16_t*)(wsl + OFF_VTOK), Vmem); phase_prep(Q); } }
    if (pb <= 4 && 4 + 1 < pe) grid_barrier();
    if (pb <= 5 && 5 < pe && PH(5)) { char* wsl = launder(P.ws); Params Q = P; Q.ws = wsl; (void)Q; phase_scan(Q); { const int wv = (int)(threadIdx.x >> 6) * (int)gridDim.x + (int)blockIdx.x, tot = (int)gridDim.x * NWAVE; if (tot > 416 + 64) { memattn_mfma(Q, 0, wv - 416, tot - 416); if (wv >= 416) wave_convert(Q, wv - 416, tot - 416, false); } else { memattn_mfma(Q, 0, wv, tot); wave_convert(Q, wv, tot, false); } } }
    if (pb <= 5 && 5 + 1 < pe) grid_barrier();
    if (pb <= 6 && 6 < pe && PH(6)) { char* wsl = launder(P.ws); Params Q = P; Q.ws = wsl; (void)Q; phase_chunk(Q); }
    if (pb <= 6 && 6 + 1 < pe) grid_barrier();
    if (pb <= 7 && 7 < pe && PH(7)) { char* wsl = launder(P.ws); Params Q = P; Q.ws = wsl; (void)Q; gemm8(Cat, W + W_AOUT, kT, 1024, 1024, Epi8Resid{P.out, P.out, xb, ssq, 1.f}); }
    if (pb <= 7 && 7 + 1 < pe) grid_barrier();
    if (pb <= 8 && 8 < pe && PH(8)) { char* wsl = launder(P.ws); Params Q = P; Q.ws = wsl; (void)Q; gemm8(xb, W + W_GU1, kT, 5632, 1024, Epi8Swiglu{ssq, H}); }
    if (pb <= 8 && 8 + 1 < pe) grid_barrier();
    if (pb <= 9 && 9 < pe && PH(9)) { char* wsl = launder(P.ws); Params Q = P; Q.ws = wsl; (void)Q; gemm8(H, W + W_DN1, kT, 1024, 2816, Epi8Resid{P.out, P.out, xb, ssq, 0.5f}); }
    if (pb <= 9 && 9 + 1 < pe) grid_barrier();
    if (pb <= 10 && 10 < pe && PH(10)) { char* wsl = launder(P.ws); Params Q = P; Q.ws = wsl; (void)Q; gemm8(xb, W + W_GU2, kT, 7168, 1024, Epi8KvFfn{ssq, H, Ksh, Cat, P.kv_k_norm}); }
    if (pb <= 10 && 10 + 1 < pe) grid_barrier();
    if (pb <= 11 && 11 < pe && PH(11)) { char* wsl = launder(P.ws); Params Q = P; Q.ws = wsl; (void)Q; { gemm8(H, W + W_DN2, kT, 1024, 2816, Epi8Resid{P.out, P.out, xb, ssq, 0.5f}); phase_vtranspose(Cat, Vsh); } }
    if (pb <= 11 && 11 + 1 < pe) grid_barrier();
    if (pb <= 12 && 12 < pe && PH(12) && !SKIP12) { char* wsl = launder(P.ws); Params Q = P; Q.ws = wsl; (void)Q; gemm8(xb, W + W_BQ, kT, 1024, 1024, Epi8QProj{ssq, Cat, P.b_q_norm, P.mem_q_norm + 64}); }
    if (pb <= 12 && 12 + 1 < pe) grid_barrier();
    if (pb <= 13 && 13 < pe && PH(13)) { char* wsl = launder(P.ws); Params Q = P; Q.ws = wsl; (void)Q; { phase_dilated_mfma(Q); memattn_mfma(Q, 1, (int)blockIdx.x * NWAVE + (int)(threadIdx.x >> 6), (int)gridDim.x * NWAVE); } }
    if (pb <= 13 && 13 + 1 < pe) grid_barrier();
    if (pb <= 14 && 14 < pe && PH(14) && !SKIP14) { char* wsl = launder(P.ws); Params Q = P; Q.ws = wsl; (void)Q; gemm8(Cat, W + W_BOUT, kT, 1024, 1024, Epi8Resid{P.out, P.out, xb, ssq, 1.f}); }
    if (pb <= 14 && 14 + 1 < pe) grid_barrier();
    if (pb <= 15 && 15 < pe && PH(15)) { char* wsl = launder(P.ws); Params Q = P; Q.ws = wsl; (void)Q; gemm8(xb, W + W_GU3, kT, 5632, 1024, Epi8Swiglu{ssq, H}); }
    if (pb <= 15 && 15 + 1 < pe) grid_barrier();
    if (pb <= 16 && 16 < pe && PH(16)) { char* wsl = launder(P.ws); Params Q = P; Q.ws = wsl; (void)Q; gemm8(H, W + W_DN3, kT, 1024, 2816, Epi8Resid{P.out, P.out, nullptr, ssq, 0.5f}); }
  }
}
#undef W
#undef xb
#undef H
#undef Pbase
#undef Ksh
#undef Vsh
#undef Cat
#undef ssq
#undef G
#undef memb
#undef ssqm
#undef Kmem
#undef Vmem

extern "C" void kernel_launch(void* const* d_in, const int* in_sizes, int n_in, void* d_out, int out_size, void* d_ws,
                              size_t ws_size, hipStream_t stream) {
  (void)in_sizes; (void)n_in; (void)out_size;
  static int grid_blocks = 0;
  if (!grid_blocks) {
    int dev = 0, cus = 0, per_cu = 0;
    hipGetDevice(&dev);
    hipDeviceGetAttribute(&cus, hipDeviceAttributeMultiprocessorCount, dev);
    hipOccupancyMaxActiveBlocksPerMultiprocessor(&per_cu, fwd_megakernel, NTHR, 0);
    if (per_cu > 1) per_cu = 1;
    grid_blocks = cus * per_cu;
    if (ws_size < OFF_END) fprintf(stderr, "workspace too small: %zu < %zu\n", ws_size, (size_t)OFF_END);
  }
  Params p{};
  const float** pf = (const float**)&p;
  for (int i = 0; i < 27; ++i) pf[i] = (const float*)d_in[i];
  p.out = (float*)d_out;
  p.ws = (char*)d_ws;
#ifndef RUN_PE
#define RUN_PE NPHASE
#endif
#ifdef MULTI_LAUNCH
  hipError_t e = hipSuccess;
  for (int ph = 0; ph < RUN_PE; ++ph) {
    int pb = ph, pe = ph + 1;
    hipLaunchKernelGGL(fwd_megakernel, dim3(grid_blocks), dim3(NTHR), 0, stream, p, pb, pe);
  }
#else
  hipMemsetAsync((char*)d_ws + OFF_BAR, 0, 16384, stream);
  int pb = 0, pe = RUN_PE;
  void* args[] = {&p, &pb, &pe};
  hipError_t e = hipLaunchCooperativeKernel((void*)fwd_megakernel, dim3(grid_blocks), dim3(NTHR), args, 0, stream);
#endif
  if (e != hipSuccess) fprintf(stderr, "cooperative launch failed: %s (grid %d)\n", hipGetErrorString(e), grid_blocks);
}
```

```cpp
#include <hip/hip_runtime.h>
#include <hip/hip_cooperative_groups.h>
#include <stdint.h>
#include <stdio.h>
namespace cg = cooperative_groups;

typedef unsigned short bf16_t;
typedef __attribute__((ext_vector_type(8))) short bf16x8;
typedef __attribute__((ext_vector_type(4))) float f32x4;
#define LAS __attribute__((address_space(3)))
#define VMWAIT() asm volatile("s_waitcnt vmcnt(0)" ::: "memory")

constexpr int kT = 32768, kS = 16384;
constexpr int NTHR = 512, NWAVE = 8;
constexpr float EPS = 1e-6f;

constexpr size_t GU_SZ = 5632ull * 1024, DN_SZ = 1024ull * 2816, KV_SZ = 1536ull * 1024, IN_SZ = 3584ull * 1024,
                 SQ_SZ = 1024ull * 1024, MKV_SZ = 512ull * 1024;
constexpr size_t W_GU0 = 0, W_GU1 = GU_SZ, W_GU2 = 2 * GU_SZ, W_KV = 3 * GU_SZ, W_GU3 = W_KV + KV_SZ,
                 W_DN0 = W_GU3 + GU_SZ, W_DN1 = W_DN0 + DN_SZ, W_DN2 = W_DN1 + DN_SZ, W_DN3 = W_DN2 + DN_SZ,
                 W_IN = W_DN3 + DN_SZ, W_AOUT = W_IN + IN_SZ, W_BQ = W_AOUT + SQ_SZ, W_BOUT = W_BQ + SQ_SZ,
                 W_MKV0 = W_BOUT + SQ_SZ, W_MKV1 = W_MKV0 + MKV_SZ, W_END = W_MKV1 + MKV_SZ;
constexpr size_t PSZ = (size_t)kT * 768 * 2;
constexpr size_t OFF_W = 0;
constexpr size_t OFF_XB = (W_END * 2 + 255) / 256 * 256;
constexpr size_t OFF_R1 = OFF_XB + (size_t)kT * 1024 * 2;
constexpr size_t OFF_R2 = OFF_R1 + 4 * PSZ;
constexpr size_t OFF_CAT = OFF_R2 + 2 * PSZ;
constexpr size_t OFF_SSQ = OFF_CAT + (size_t)kT * 1024 * 2;
constexpr size_t OFF_G = OFF_SSQ + (size_t)kT * 16 * 4;
constexpr size_t OFF_MEMB = OFF_G + (size_t)kT * 8 * 4;
constexpr size_t OFF_SSQM = OFF_MEMB + 512ull * 1024 * 2;
constexpr size_t OFF_KMEM = OFF_SSQM + 512ull * 16 * 4;
constexpr size_t OFF_VMEM = OFF_KMEM + 2ull * 512 * 256 * 2;
constexpr size_t OFF_U = OFF_VMEM + 2ull * 512 * 256 * 2;
constexpr size_t OFF_BC = OFF_U + 1024ull * 128 * 4;
constexpr size_t OFF_EW = OFF_BC + 1024ull * 128 * 4;
constexpr size_t OFF_UMAX = OFF_EW + 1024ull * 128 * 2;
constexpr size_t OFF_BL = OFF_UMAX + 4096;
constexpr size_t OFF_M0 = OFF_BL + 4096;
constexpr size_t OFF_BAR = OFF_M0 + 4096;
constexpr size_t OFF_VTOK = OFF_BAR + 16384;
constexpr size_t OFF_END = OFF_VTOK + 2ull * 512 * 256 * 2;

struct Params {
  const float *x, *mem, *ffn1_norm, *ffn1_wg, *ffn1_wu, *ffn1_wd, *ffn2_norm, *ffn2_wg, *ffn2_wu, *ffn2_wd, *mix_norm,
      *mem_norm, *w_mem_kv, *mem_q_norm, *mem_k_norm, *a_w_in, *a_conv, *a_gate_bias, *a_h_norm, *a_w_out, *b_w_q,
      *b_q_norm, *b_w_out, *kv_norm, *w_kv, *kv_k_norm, *rel_bias;
  float* out;
  char* ws;
};

__shared__ __attribute__((aligned(16))) char smem[146448];

__device__ __forceinline__ bf16_t f2bf(float f) {
  uint32_t u = __float_as_uint(f);
  u += 0x7fffu + ((u >> 16) & 1u);
  return (bf16_t)(u >> 16);
}
__device__ __forceinline__ float bf2f(bf16_t h) { return __uint_as_float(((uint32_t)h) << 16); }
__device__ __forceinline__ float bflo(uint32_t u) { return __uint_as_float(u << 16); }
__device__ __forceinline__ float bfhi(uint32_t u) { return __uint_as_float(u & 0xffff0000u); }
__device__ __forceinline__ uint32_t pack2(float a, float b) { uint32_t r; asm("v_cvt_pk_bf16_f32 %0, %1, %2" : "=v"(r) : "v"(a), "v"(b)); return r; }
__device__ __forceinline__ float dot8(uint4 a, uint4 b) {
  return bflo(a.x) * bflo(b.x) + bfhi(a.x) * bfhi(b.x) + bflo(a.y) * bflo(b.y) + bfhi(a.y) * bfhi(b.y) +
         bflo(a.z) * bflo(b.z) + bfhi(a.z) * bfhi(b.z) + bflo(a.w) * bflo(b.w) + bfhi(a.w) * bfhi(b.w);
}
__device__ __forceinline__ float wave_sum(float v) {
  for (int o = 32; o > 0; o >>= 1) v += __shfl_xor(v, o);
  return v;
}
__device__ __forceinline__ float wave_max(float v) {
  for (int o = 32; o > 0; o >>= 1) v = fmaxf(v, __shfl_xor(v, o));
  return v;
}
__device__ __forceinline__ float dpp_ror_(float v, int) { return v; }
#define DPP_ROR_ADD(v, ctrl) v += __builtin_bit_cast(float, __builtin_amdgcn_update_dpp(0, __builtin_bit_cast(int, v), ctrl, 0xf, 0xf, false))
__device__ __forceinline__ float sum16(float v) {
  DPP_ROR_ADD(v, 0x128); DPP_ROR_ADD(v, 0x124); DPP_ROR_ADD(v, 0x122); DPP_ROR_ADD(v, 0x121);
  return v;
}
#define DPP_ROR_MAX(v, ctrl) v = fmaxf(v, __builtin_bit_cast(float, __builtin_amdgcn_update_dpp(0, __builtin_bit_cast(int, v), ctrl, 0xf, 0xf, false)))
__device__ __forceinline__ float max16(float v) {
  DPP_ROR_MAX(v, 0x128); DPP_ROR_MAX(v, 0x124); DPP_ROR_MAX(v, 0x122); DPP_ROR_MAX(v, 0x121);
  return v;
}
__device__ __forceinline__ float sigmoidf_(float x) { return __builtin_amdgcn_rcpf(1.f + __expf(-x)); }

struct WJob { size_t dst; int Nd, K; };
__device__ __forceinline__ WJob wjob(int j) {
  switch (j) {
    case 0: return {W_GU0, 5632, 1024};
    case 1: return {W_GU1, 5632, 1024};
    case 2: return {W_GU2, 5632, 1024};
    case 3: return {W_GU3, 5632, 1024};
    case 4: return {W_DN0, 1024, 2816};
    case 5: return {W_DN1, 1024, 2816};
    case 6: return {W_DN2, 1024, 2816};
    case 7: return {W_DN3, 1024, 2816};
    case 8: return {W_IN, 3584, 1024};
    case 9: return {W_AOUT, 1024, 1024};
    case 10: return {W_BQ, 1024, 1024};
    case 11: return {W_BOUT, 1024, 1024};
    case 12: return {W_KV, 1536, 1024};
    case 13: return {W_MKV0, 512, 1024};
    default: return {W_MKV1, 512, 1024};
  }
}
__device__ __forceinline__ int headmap(int r256) { const int bj = r256 >> 7, hh = (r256 & 127) >> 5, i = r256 & 31; return hh * 64 + bj * 32 + i; }
__device__ __forceinline__ void wsrc(const Params& P, int j, int n, const float*& p, int& ld, const float*& gain) {
  p = nullptr; ld = 0; gain = nullptr;
  if (j < 4) {
    int layer = j >> 1, which = j & 1;
    int pn = n >> 8, r = n & 255, bj = r >> 7, col = pn * 128 + (r & 127);
    const float* wg = which ? P.ffn2_wg : P.ffn1_wg;
    const float* wu = which ? P.ffn2_wu : P.ffn1_wu;
    p = (bj ? wu : wg) + (size_t)layer * 1024 * 2816 + col;
    ld = 2816;
    gain = (which ? P.ffn2_norm : P.ffn1_norm) + layer * 1024;
  } else if (j < 8) {
    int i = j - 4, layer = i >> 1, which = i & 1;
    p = (which ? P.ffn2_wd : P.ffn1_wd) + (size_t)layer * 2816 * 1024 + n;
    ld = 1024;
  } else if (j == 8) {
    int col = -1;
    if (n < 3072) col = n; else if (n < 3328) col = 3080 + headmap(n - 3072); else if (n < 3336) col = 3072 + (n - 3328);
    if (col >= 0) { p = P.a_w_in + col; ld = 3336; }
    gain = P.mix_norm;
  } else if (j == 9) { p = P.a_w_out + n; ld = 1024; }
  else if (j == 10) { p = P.b_w_q + (n & ~255) + headmap(n & 255); ld = 1024; gain = P.mix_norm + 1024; }
  else if (j == 11) { p = P.b_w_out + n; ld = 1024; }
  else if (j == 12) { int col = (n < 768) ? ((n & ~255) + headmap(n & 255)) : n; p = P.w_kv + col; ld = 1536; gain = P.kv_norm; }
  else { int l = j - 13; int col = (n < 256) ? headmap(n) : n; p = P.w_mem_kv + (size_t)l * 1024 * 512 + col; ld = 512; gain = P.mem_norm + l * 1024; }
}

__device__ __forceinline__ void wave_convert(const Params& P, int widx, int nwv, bool early) {
  bf16_t* W = (bf16_t*)(P.ws + OFF_W);
  const int lane = threadIdx.x & 63;
  int base = 0;
  for (int j = 0; j < 15; ++j) {
    const bool is_early = (j == 0 || j == 4 || j == 8 || j >= 13);
    if (is_early != early) continue;
    WJob wj = wjob(j);
    const int tk_cnt = wj.K >> 6, ntile = (wj.Nd >> 6) * tk_cnt;
    const int first = (widx + nwv - (base % nwv)) % nwv;
    for (int t = first; t < ntile; t += nwv) {
      const int tn = t / tk_cnt, tk = t - tn * tk_cnt, n = (tn << 6) + lane, k0 = tk << 6;
      const float* sp; int ld; const float* gain;
      wsrc(P, j, n, sp, ld, gain);
      float v[64];
#pragma unroll
      for (int k = 0; k < 64; ++k) v[k] = sp ? sp[(size_t)(k0 + k) * ld] : 0.f;
      if (gain) {
#pragma unroll
        for (int k4 = 0; k4 < 16; ++k4) {
          const float4 g4 = *(const float4*)(gain + k0 + k4 * 4);
          v[k4 * 4 + 0] *= g4.x; v[k4 * 4 + 1] *= g4.y; v[k4 * 4 + 2] *= g4.z; v[k4 * 4 + 3] *= g4.w;
        }
      }
      VMWAIT();
      bf16_t* dst = W + wj.dst + (size_t)n * wj.K + k0;
#pragma unroll
      for (int k8 = 0; k8 < 8; ++k8) {
        uint4 o;
        o.x = pack2(v[k8 * 8 + 0], v[k8 * 8 + 1]); o.y = pack2(v[k8 * 8 + 2], v[k8 * 8 + 3]);
        o.z = pack2(v[k8 * 8 + 4], v[k8 * 8 + 5]); o.w = pack2(v[k8 * 8 + 6], v[k8 * 8 + 7]);
        *(uint4*)(dst + k8 * 8) = o;
      }
    }
    base += ntile;
  }
}

__device__ __forceinline__ void phase_convert(const Params& P) {
  bf16_t* W = (bf16_t*)(P.ws + OFF_W);
  float* sT = (float*)smem;
  const int tid = threadIdx.x;
  wave_convert(P, (int)(blockIdx.x * NWAVE + (threadIdx.x >> 6)), (int)(gridDim.x * NWAVE), true);
  bf16_t* xb = (bf16_t*)(P.ws + OFF_XB);
  float* ssq = (float*)(P.ws + OFF_SSQ);
  bf16_t* memb = (bf16_t*)(P.ws + OFF_MEMB);
  float* ssqm = (float*)(P.ws + OFF_SSQM);
  const int lane = tid & 63, gw = blockIdx.x * NWAVE + (tid >> 6), nw = gridDim.x * NWAVE;
  for (int row = gw; row < kT + 512; row += nw) {
    const float* src = (row < kT) ? (P.x + (size_t)row * 1024) : (P.mem + (size_t)(row - kT) * 1024);
    bf16_t* dst = (row < kT) ? (xb + (size_t)row * 1024) : (memb + (size_t)(row - kT) * 1024);
    float* sq = (row < kT) ? (ssq + (size_t)row * 16) : (ssqm + (size_t)(row - kT) * 16);
    float ss = 0.f;
#pragma unroll
    for (int i = 0; i < 4; ++i) {
      float4 v = ((const float4*)src)[lane + 64 * i];
      ss += v.x * v.x + v.y * v.y + v.z * v.z + v.w * v.w;
      uint2 o; o.x = pack2(v.x, v.y); o.y = pack2(v.z, v.w);
      ((uint2*)dst)[lane + 64 * i] = o;
    }
    ss = wave_sum(ss);
    if (lane < 16) sq[lane] = (lane == 0) ? ss : 0.f;
  }
}

constexpr int G8_BM = 256, G8_BK = 64, G8_HALF = 128, G8_HTB = G8_HALF * G8_BK * 2, G8_NXCD = 8, G8_WGM = 8;
__device__ __forceinline__ int lds_byte(int r, int c) { const int st = (r >> 4) * 2 + (c >> 5), rr = r & 15, cc = c & 31, ob = rr * 64 + cc * 2; return st * 1024 + (ob ^ (((ob >> 9) & 1) << 5)); }
__device__ __forceinline__ void stage_rc(int b, int& R, int& C) { const int st = b / 1024, sb = b % 1024, swz = sb ^ (((sb >> 9) & 1) << 5); R = (st >> 1) * 16 + swz / 64; C = (st & 1) * 32 + (swz % 64) / 2; }
__device__ __forceinline__ int perm32(int rho) { const int n = rho >> 4, i = rho & 15; return 8 * (i >> 2) + 4 * n + (i & 3); }
struct Unit { int pm, pn; };
struct StaticOrder {
  int nM, nN, nwg, G, c;
  __device__ void init(int M, int N, int G_, int c_) { nM = M / G8_BM; nN = N / G8_BM; nwg = nM * nN; G = G_; c = c_; }
  __device__ bool next(int i, Unit& u) const {
    const long L = (long)i * G + c; if (L >= nwg) return false;
    int wgid = (int)L; { const int q = nwg / G8_NXCD, r = nwg % G8_NXCD, xcd = wgid % G8_NXCD, off = wgid / G8_NXCD; wgid = (xcd < r ? xcd * (q + 1) : r * (q + 1) + (xcd - r) * q) + off; }
    const int nig = G8_WGM * nN, gid = wgid / nig, fm = gid * G8_WGM, gsz = (nM - fm) < G8_WGM ? (nM - fm) : G8_WGM;
    u.pm = fm + ((wgid % nig) % gsz); u.pn = (wgid % nig) / gsz; return true;
  }
};

__device__ __forceinline__ float rstd_row(const float* ssq, size_t row) {
  const float4* q = (const float4*)(ssq + row * 16);
  float4 a = q[0], b = q[1], c = q[2], d = q[3];
  float s = ((a.x + a.y) + (a.z + a.w)) + ((b.x + b.y) + (b.z + b.w)) + ((c.x + c.y) + (c.z + c.w)) + ((d.x + d.y) + (d.z + d.w));
  return rsqrtf(s * (1.f / 1024.f) + EPS);
}
template <class Epi>
__device__ __forceinline__ void gemm8(const bf16_t* gA, const bf16_t* gBt, int M, int N, int K, const Epi& E, int coff = 0) {
  LAS unsigned char* lds = (LAS unsigned char*)smem;
  StaticOrder S; S.init(M, N, (int)gridDim.x, (int)((blockIdx.x + coff) % gridDim.x));
  const int tid = threadIdx.x, wid = __builtin_amdgcn_readfirstlane(tid >> 6), lane = tid & 63, wr = wid >> 2, wc = wid & 3, fr = lane & 15, fq = lane >> 4;
  const int nt = K / G8_BK;
  unsigned voffA[2], voffB[2];
#pragma unroll
  for (int i = 0; i < 2; ++i) { int R, C; stage_rc(tid * 16 + i * 8192, R, C); const int Rb = Epi::PERM ? ((R & ~31) + perm32(R & 31)) : R;
    voffA[i] = (unsigned)(R * K + C) * 2u; voffB[i] = (unsigned)(Rb * K + C) * 2u; }
  const size_t kstep = (size_t)(G8_BK * 2);
  const size_t hstep = (size_t)G8_HALF * K * 2;
  const size_t tstep = 2 * hstep;
  const unsigned ldsw = (unsigned)wid * 1024u;
  const int aoff = lds_byte(wr * 64 + fr, fq * 8), boff = lds_byte(wc * 32 + fr, fq * 8);
#define PG8_SA(b, h) (((b) * 2 + (h)) * G8_HTB)
#define PG8_SB(b, h) ((4 + (b) * 2 + (h)) * G8_HTB)
#define PG8_STAGE(bufoff, gbase, voff) do { _Pragma("unroll") for (int _i = 0; _i < 2; ++_i) \
    __builtin_amdgcn_global_load_lds((const unsigned*)((const char*)(gbase) + (voff)[_i]), (LAS unsigned*)(lds + (bufoff) + ldsw + _i * 8192), 16, 0, 0); } while (0)
#define PG8_LDA(dst, b, h) do { _Pragma("unroll") for (int m = 0; m < 4; ++m) _Pragma("unroll") for (int k = 0; k < 2; ++k) dst[m][k] = *(const LAS bf16x8*)(lds + PG8_SA(b, h) + aoff + m * 2048 + k * 1024); } while (0)
#define PG8_LDB(dst, b, h) do { _Pragma("unroll") for (int n = 0; n < 2; ++n) _Pragma("unroll") for (int k = 0; k < 2; ++k) dst[n][k] = *(const LAS bf16x8*)(lds + PG8_SB(b, h) + boff + n * 2048 + k * 1024); } while (0)
#define PG8_MMA(ai, bj, At, Bt) do { __builtin_amdgcn_s_setprio(1); _Pragma("unroll") for (int m = 0; m < 4; ++m) _Pragma("unroll") for (int n = 0; n < 2; ++n) _Pragma("unroll") for (int k = 0; k < 2; ++k) \
    acc[ai][bj][m][n] = __builtin_amdgcn_mfma_f32_16x16x32_bf16(Bt[n][k], At[m][k], acc[ai][bj][m][n], 0, 0, 0); __builtin_amdgcn_s_setprio(0); } while (0)
#define PG8_WAIT_V(n) asm volatile("s_waitcnt vmcnt(" #n ")" ::: "memory")
#define PG8_WAIT_L(n) asm volatile("s_waitcnt lgkmcnt(" #n ")" ::: "memory")
#define PG8_BAR __builtin_amdgcn_s_barrier()
#define PG8_SCHED __builtin_amdgcn_sched_barrier(0)
  Unit cur, nxt; int ui = 0;
  if (E.ssq != nullptr) {
    float* sRs = (float*)(smem + 132096);
    Unit uu;
    for (int i = 0; S.next(i, uu); ++i)
      if (tid < 256) sRs[i * 256 + tid] = rstd_row(E.ssq, (size_t)uu.pm * 256 + tid);
    __syncthreads();
  }
  if (!S.next(0, cur)) return;
  f32x4 acc[2][2][4][2];
#pragma unroll
  for (int a = 0; a < 2; ++a)
#pragma unroll
    for (int b = 0; b < 2; ++b)
#pragma unroll
      for (int m = 0; m < 4; ++m)
#pragma unroll
        for (int n = 0; n < 2; ++n) acc[a][b][m][n] = (f32x4){0.f, 0.f, 0.f, 0.f};
  bf16x8 At[4][2], B0[2][2], B1[2][2];
  const char* cA = (const char*)gA + (size_t)cur.pm * tstep; const char* cB = (const char*)gBt + (size_t)cur.pn * tstep;
  PG8_STAGE(PG8_SB(0, 0), cB, voffB); PG8_STAGE(PG8_SA(0, 0), cA, voffA); PG8_STAGE(PG8_SB(0, 1), cB + hstep, voffB); PG8_STAGE(PG8_SA(0, 1), cA + hstep, voffA);
  if (wr == 1) PG8_BAR;
  PG8_WAIT_V(4); PG8_BAR;
  PG8_STAGE(PG8_SB(1, 0), cB + kstep, voffB); PG8_STAGE(PG8_SA(1, 0), cA + kstep, voffA); PG8_STAGE(PG8_SB(1, 1), cB + hstep + kstep, voffB);
  PG8_WAIT_V(6); PG8_BAR;
  for (;;) {
    const bool has_next = S.next(ui + 1, nxt);
    const char* nA = has_next ? (const char*)gA + (size_t)nxt.pm * tstep : cA; const char* nB = has_next ? (const char*)gBt + (size_t)nxt.pn * tstep : cB;
    for (int t = 0; t < nt; t += 2) {
      const bool last = (t == nt - 2);
      const char* a1 = cA + (size_t)(t + 1) * kstep;
      const char* a2 = last ? nA : cA + (size_t)(t + 2) * kstep; const char* b2 = last ? nB : cB + (size_t)(t + 2) * kstep;
      const char* a3 = a2 + kstep; const char* b3 = b2 + kstep;
      PG8_LDB(B0, 0, 0); PG8_SCHED; PG8_LDA(At, 0, 0); PG8_STAGE(PG8_SA(1, 1), a1 + hstep, voffA);
      PG8_WAIT_L(8); PG8_BAR; PG8_WAIT_L(0); PG8_MMA(0, 0, At, B0); PG8_BAR; PG8_SCHED;
      PG8_LDB(B1, 0, 1); PG8_STAGE(PG8_SB(0, 0), b2, voffB);
      PG8_BAR; PG8_WAIT_L(0); PG8_MMA(0, 1, At, B1); PG8_BAR;
      PG8_LDA(At, 0, 1); PG8_STAGE(PG8_SA(0, 0), a2, voffA);
      PG8_BAR; PG8_WAIT_L(0); PG8_MMA(1, 0, At, B0); PG8_BAR; PG8_SCHED;
      PG8_STAGE(PG8_SB(0, 1), b2 + hstep, voffB);
      PG8_WAIT_V(6); PG8_BAR; PG8_MMA(1, 1, At, B1); PG8_BAR;
      PG8_LDB(B0, 1, 0); PG8_SCHED; PG8_LDA(At, 1, 0); PG8_STAGE(PG8_SA(0, 1), a2 + hstep, voffA);
      PG8_WAIT_L(8); PG8_BAR; PG8_WAIT_L(0); PG8_MMA(0, 0, At, B0); PG8_BAR; PG8_SCHED;
      PG8_LDB(B1, 1, 1); PG8_STAGE(PG8_SB(1, 0), b3, voffB);
      PG8_BAR; PG8_WAIT_L(0); PG8_MMA(0, 1, At, B1); PG8_BAR;
      PG8_LDA(At, 1, 1); PG8_STAGE(PG8_SA(1, 0), a3, voffA);
      PG8_BAR; PG8_WAIT_L(0); PG8_MMA(1, 0, At, B0); PG8_BAR; PG8_SCHED;
      PG8_STAGE(PG8_SB(1, 1), b3 + hstep, voffB);
      PG8_WAIT_V(6); PG8_BAR; PG8_MMA(1, 1, At, B1); PG8_BAR;
    }
    E(acc, cur, ui, wr, wc, fr, fq);
    if (!has_next) break;
#pragma unroll
    for (int a = 0; a < 2; ++a)
#pragma unroll
      for (int b = 0; b < 2; ++b)
#pragma unroll
        for (int m = 0; m < 4; ++m)
#pragma unroll
          for (int n = 0; n < 2; ++n) acc[a][b][m][n] = (f32x4){0.f, 0.f, 0.f, 0.f};
    cur = nxt; cA = nA; cB = nB; ++ui;
  }
  PG8_WAIT_V(0);
  if (wr == 0) PG8_BAR;
  PG8_BAR;
#undef PG8_SA
#undef PG8_SB
#undef PG8_STAGE
#undef PG8_LDA
#undef PG8_LDB
#undef PG8_MMA
#undef PG8_WAIT_V
#undef PG8_WAIT_L
#undef PG8_BAR
#undef PG8_SCHED
}

typedef f32x4 Acc8[2][2][4][2];
__device__ __forceinline__ float sumq4(float v) {
  v += __shfl_xor(v, 16); v += __shfl_xor(v, 32);
  return v;
}
__device__ __forceinline__ void rstd8(int ui, int wr, int fr, float (&rs)[2][4]) {
  const float* sRs = (const float*)(smem + 132096) + ui * 256 + wr * 64 + fr;
#pragma unroll
  for (int ai = 0; ai < 2; ++ai)
#pragma unroll
    for (int m = 0; m < 4; ++m) rs[ai][m] = sRs[ai * 128 + m * 16];
}
__device__ __forceinline__ uint4 pack8(f32x4 a, f32x4 b) {
  uint4 o; o.x = pack2(a[0], a[1]); o.y = pack2(a[2], a[3]); o.z = pack2(b[0], b[1]); o.w = pack2(b[2], b[3]); return o;
}
__device__ __forceinline__ void epi8_swiglu(const Acc8& acc, const Unit& u, int ui, int wr, int wc, int fr, int fq, const float* ssq, bf16_t* H) {
  float rs8[2][4];
  rstd8(ui, wr, fr, rs8);
#pragma unroll
  for (int ai = 0; ai < 2; ++ai)
#pragma unroll
    for (int m = 0; m < 4; ++m) {
      const size_t row = (size_t)u.pm * 256 + ai * 128 + wr * 64 + m * 16 + fr;
      const float rs = rs8[ai][m];
      f32x4 h0, h1;
#pragma unroll
      for (int jj = 0; jj < 4; ++jj) {
        float g0 = acc[ai][0][m][0][jj] * rs, u0 = acc[ai][1][m][0][jj] * rs, g1 = acc[ai][0][m][1][jj] * rs, u1 = acc[ai][1][m][1][jj] * rs;
        h0[jj] = g0 * __builtin_amdgcn_rcpf(1.f + __expf(-g0)) * u0;
        h1[jj] = g1 * __builtin_amdgcn_rcpf(1.f + __expf(-g1)) * u1;
      }
      *(uint4*)(H + row * 2816 + u.pn * 128 + wc * 32 + fq * 8) = pack8(h0, h1);
    }
}
__device__ __forceinline__ void epi8_plain(const Acc8& acc, const Unit& u, int ui, int wr, int wc, int fr, int fq, const float* ssq, bf16_t* dst, int ld, int col0) {
  float rs8[2][4];
  rstd8(ui, wr, fr, rs8);
#pragma unroll
  for (int ai = 0; ai < 2; ++ai)
#pragma unroll
    for (int m = 0; m < 4; ++m) {
      const size_t row = (size_t)u.pm * 256 + ai * 128 + wr * 64 + m * 16 + fr;
      const float rs = rs8[ai][m];
#pragma unroll
      for (int bj = 0; bj < 2; ++bj)
        *(uint4*)(dst + row * ld + col0 + bj * 128 + wc * 32 + fq * 8) = pack8(acc[ai][bj][m][0] * rs, acc[ai][bj][m][1] * rs);
    }
}
__device__ __forceinline__ void epi8_headnorm(const Acc8& acc, const Unit& u, int ui, int wr, int wc, int fr, int fq, const float* ssq, const float* gain,
                                              float scale, bf16_t* dst, int ld, int colbase) {
  f32x4 gn[2][2];
#pragma unroll
  for (int bj = 0; bj < 2; ++bj)
#pragma unroll
    for (int n = 0; n < 2; ++n) gn[bj][n] = *(const f32x4*)(gain + bj * 32 + fq * 8 + n * 4) * scale;
  VMWAIT();
  float rs8[2][4];
  rstd8(ui, wr, fr, rs8);
#pragma unroll
  for (int ai = 0; ai < 2; ++ai)
#pragma unroll
    for (int m = 0; m < 4; ++m) {
      const size_t row = (size_t)u.pm * 256 + ai * 128 + wr * 64 + m * 16 + fr;
      const float rs = rs8[ai][m];
      float ss = 0.f;
#pragma unroll
      for (int bj = 0; bj < 2; ++bj)
#pragma unroll
        for (int n = 0; n < 2; ++n) {
          const f32x4 a = acc[ai][bj][m][n];
          ss += a[0] * a[0] + a[1] * a[1] + a[2] * a[2] + a[3] * a[3];
        }
      ss = sumq4(ss) * rs * rs;
      const float r2 = rsqrtf(ss * (1.f / 64.f) + EPS) * rs;
#pragma unroll
      for (int bj = 0; bj < 2; ++bj)
        *(uint4*)(dst + row * ld + colbase + wc * 64 + bj * 32 + fq * 8) = pack8(acc[ai][bj][m][0] * r2 * gn[bj][0], acc[ai][bj][m][1] * r2 * gn[bj][1]);
    }
}

struct Epi8Swiglu {
  static constexpr bool PERM = true;
  const float* ssq; bf16_t* H;
  __device__ __forceinline__ void operator()(const Acc8& acc, const Unit& u, int ui, int wr, int wc, int fr, int fq) const { epi8_swiglu(acc, u, ui, wr, wc, fr, fq, ssq, H); }
};
struct Epi8Resid {
  static constexpr bool PERM = false;
  static constexpr const float* ssq = nullptr;
  const float* xin; float* xout; bf16_t* xb; float* ssqo; float scale;
  __device__ __forceinline__ void operator()(const Acc8& acc, const Unit& u, int ui, int wr, int wc, int fr, int fq) const {
#pragma unroll
    for (int ai = 0; ai < 2; ++ai)
#pragma unroll
      for (int mh = 0; mh < 2; ++mh) {
        f32x4 xv[2][2][2];
#pragma unroll
        for (int m2 = 0; m2 < 2; ++m2)
#pragma unroll
          for (int bj = 0; bj < 2; ++bj)
#pragma unroll
            for (int n = 0; n < 2; ++n)
              xv[m2][bj][n] = *(const f32x4*)(xin + ((size_t)u.pm * 256 + ai * 128 + wr * 64 + (mh * 2 + m2) * 16 + fr) * 1024 + u.pn * 256 + bj * 128 + wc * 32 + n * 16 + fq * 4);
        VMWAIT();
#pragma unroll
        for (int m2 = 0; m2 < 2; ++m2) {
          const int m = mh * 2 + m2;
          const size_t row = (size_t)u.pm * 256 + ai * 128 + wr * 64 + m * 16 + fr;
          float ss = 0.f;
#pragma unroll
          for (int bj = 0; bj < 2; ++bj)
#pragma unroll
            for (int n = 0; n < 2; ++n) {
              const size_t idx = row * 1024 + u.pn * 256 + bj * 128 + wc * 32 + n * 16 + fq * 4;
              f32x4 v = xv[m2][bj][n] + acc[ai][bj][m][n] * scale;
              *(f32x4*)(xout + idx) = v;
              if (xb != nullptr) { uint2 o; o.x = pack2(v[0], v[1]); o.y = pack2(v[2], v[3]); *(uint2*)(xb + idx) = o; }
              ss += v[0] * v[0] + v[1] * v[1] + v[2] * v[2] + v[3] * v[3];
            }
          ss = sumq4(ss);
          if (fq == 0 && xb != nullptr) ssqo[row * 16 + u.pn * 4 + wc] = ss;
        }
      }
  }
};
struct Epi8InProj {
  static constexpr bool PERM = true;
  const float* ssq; bf16_t* Pbase; bf16_t* Cat; float* G; const float* mq_gain; const float* gate_bias;
  __device__ __forceinline__ void operator()(const Acc8& acc, const Unit& u, int ui, int wr, int wc, int fr, int fq) const {
    if (u.pn < 12) {
      const int arr = u.pn / 3, c0 = (u.pn - arr * 3) * 256;
      epi8_plain(acc, u, ui, wr, wc, fr, fq, ssq, Pbase + (size_t)arr * kT * 768, 768, c0);
    } else if (u.pn == 12) {
      epi8_headnorm(acc, u, ui, wr, wc, fr, fq, ssq, mq_gain, 0.125f, Cat, 1024, 768);
    } else if (wc == 0) {
      float rs8[2][4];
      rstd8(ui, wr, fr, rs8);
      if (fq == 0) {
#pragma unroll
        for (int ai = 0; ai < 2; ++ai)
#pragma unroll
          for (int m = 0; m < 4; ++m) {
            const size_t row = (size_t)u.pm * 256 + ai * 128 + wr * 64 + m * 16 + fr;
            *(f32x4*)(G + row * 8) = acc[ai][0][m][0] * rs8[ai][m];
            *(f32x4*)(G + row * 8 + 4) = acc[ai][0][m][1] * rs8[ai][m];
          }
      }
    }
  }
};
struct Epi8KvFfn {
  static constexpr bool PERM = true;
  const float* ssq; bf16_t* H; bf16_t* Ksh; bf16_t* Vtmp; const float* kgain;
  __device__ __forceinline__ void operator()(const Acc8& acc, const Unit& u, int ui, int wr, int wc, int fr, int fq) const {
    if (u.pn < 22) epi8_swiglu(acc, u, ui, wr, wc, fr, fq, ssq, H);
    else if (u.pn < 25) epi8_headnorm(acc, u, ui, wr, wc, fr, fq, ssq, kgain, 1.f, Ksh, 768, (u.pn - 22) * 256);
    else epi8_plain(acc, u, ui, wr, wc, fr, fq, ssq, Vtmp, 768, (u.pn - 25) * 256);
  }
};
struct Epi8QProj {
  static constexpr bool PERM = true;
  const float* ssq; bf16_t* Cat; const float* qgain; const float* mqgain;
  __device__ __forceinline__ void operator()(const Acc8& acc, const Unit& u, int ui, int wr, int wc, int fr, int fq) const {
    epi8_headnorm(acc, u, ui, wr, wc, fr, fq, ssq, (u.pn < 3) ? qgain : mqgain, 0.125f, Cat, 1024, u.pn * 256);
  }
};
struct Epi8MemKv {
  static constexpr bool PERM = true;
  const float* ssq; bf16_t* Kmem; bf16_t* Vtok; const float* kgain;
  __device__ __forceinline__ void operator()(const Acc8& acc, const Unit& u, int ui, int wr, int wc, int fr, int fq) const {
    if (u.pn == 0) epi8_headnorm(acc, u, ui, wr, wc, fr, fq, ssq, kgain, 1.f, Kmem, 256, 0);
    else epi8_plain(acc, u, ui, wr, wc, fr, fq, ssq, Vtok, 256, 0);
  }
};
__device__ __forceinline__ void memv_transpose(const bf16_t* Vtok, bf16_t* VmT) {
  for (int i = blockIdx.x * NTHR + threadIdx.x; i < 2 * 512 * 256; i += gridDim.x * NTHR) {
    const int mm = i & 255, e = (i >> 8) & 255, lb = i >> 16;
    VmT[i] = Vtok[((size_t)lb * 256 + mm) * 256 + e];
  }
}

__device__ __forceinline__ void phase_vtranspose(const bf16_t* Vtmp, bf16_t* VshT) {
  bf16_t* sT = (bf16_t*)smem;
  const int tid = threadIdx.x;
  for (int item = blockIdx.x; item < 256 * 12; item += gridDim.x) {
    const int head = item % 12, tt = item / 12, tokbase = tt * 128, b = tokbase / kS, pos0 = tokbase - b * kS;
    const int g = head >> 2, d = 1 << (2 * g);
    __syncthreads();
    for (int it = tid; it < 128 * 8; it += NTHR) {
      const int t = it >> 3, e8 = (it & 7) * 8;
      uint4 v = *(const uint4*)(Vtmp + (size_t)(tokbase + t) * 768 + head * 64 + e8);
      sT[(e8 + 0) * 136 + t] = (bf16_t)(v.x & 0xffff); sT[(e8 + 1) * 136 + t] = (bf16_t)(v.x >> 16);
      sT[(e8 + 2) * 136 + t] = (bf16_t)(v.y & 0xffff); sT[(e8 + 3) * 136 + t] = (bf16_t)(v.y >> 16);
      sT[(e8 + 4) * 136 + t] = (bf16_t)(v.z & 0xffff); sT[(e8 + 5) * 136 + t] = (bf16_t)(v.z >> 16);
      sT[(e8 + 6) * 136 + t] = (bf16_t)(v.w & 0xffff); sT[(e8 + 7) * 136 + t] = (bf16_t)(v.w >> 16);
    }
    __syncthreads();
    for (int pc = tid; pc < 64 * 16; pc += NTHR) {
      const int e = pc >> 4, piece = pc & 15;
      const int rr = (g == 0) ? 0 : (g == 1) ? (piece >> 2) : piece;
      const int s8 = (g == 0) ? piece : (g == 1) ? (piece & 3) : 0;
      const bf16_t* src = sT + e * 136 + rr;
      uint4 o;
      o.x = (uint32_t)src[(s8 * 8 + 0) * d] | ((uint32_t)src[(s8 * 8 + 1) * d] << 16);
      o.y = (uint32_t)src[(s8 * 8 + 2) * d] | ((uint32_t)src[(s8 * 8 + 3) * d] << 16);
      o.z = (uint32_t)src[(s8 * 8 + 4) * d] | ((uint32_t)src[(s8 * 8 + 5) * d] << 16);
      o.w = (uint32_t)src[(s8 * 8 + 6) * d] | ((uint32_t)src[(s8 * 8 + 7) * d] << 16);
      *(uint4*)(VshT + ((size_t)(b * 12 + head) * 64 + e) * kS + rr * (kS / d) + pos0 / d + s8 * 8) = o;
    }
  }
}

__device__ __forceinline__ bf16x8 u4_to_frag(uint4 v) { return __builtin_bit_cast(bf16x8, v); }
__device__ __forceinline__ uint4 mul_bf16x8(uint4 a, uint4 b) {
  uint4 o;
  o.x = pack2(bflo(a.x) * bflo(b.x), bfhi(a.x) * bfhi(b.x));
  o.y = pack2(bflo(a.y) * bflo(b.y), bfhi(a.y) * bfhi(b.y));
  o.z = pack2(bflo(a.z) * bflo(b.z), bfhi(a.z) * bfhi(b.z));
  o.w = pack2(bflo(a.w) * bflo(b.w), bfhi(a.w) * bfhi(b.w));
  return o;
}

__device__ __forceinline__ void phase_prep(const Params& P) {
  const bf16_t* Pk = (const bf16_t*)(P.ws + OFF_R1) + (size_t)kT * 768;
  const bf16_t* Pv = Pk + (size_t)kT * 768;
  bf16_t* kc = (bf16_t*)(P.ws + OFF_XB);
  bf16_t* kTt = (bf16_t*)(P.ws + OFF_R2);
  bf16_t* VT = kTt + (size_t)kT * 768;
  const float* G = (const float*)(P.ws + OFF_G);
  float* uArr = (float*)(P.ws + OFF_U);
  float* bArr = (float*)(P.ws + OFF_BC);
  bf16_t* eW = (bf16_t*)(P.ws + OFF_EW);
  float* umaxA = (float*)(P.ws + OFF_UMAX);
  float* blA = (float*)(P.ws + OFF_BL);
  bf16_t* sX = (bf16_t*)smem;
  float* sF = (float*)(smem + 51200);
  const int tid = threadIdx.x;
  const float kscale = 0.07216878364870322f;
  for (int item = blockIdx.x; item < 1024; item += gridDim.x) {
    const int bh = item >> 7, c = item & 127, b = bh >> 2, h = bh & 3;
    const size_t tok0 = (size_t)b * kS + (size_t)c * 128;
    __syncthreads();
    float ig = 0.f;
    if (tid < 128) {
      ig = G[(tok0 + tid) * 8 + h] + P.a_gate_bias[h];
      float fg = G[(tok0 + tid) * 8 + 4 + h] + P.a_gate_bias[4 + h];
      sF[tid] = fminf(fg, 0.f) - log1pf(__expf(-fabsf(fg)));
    }
    __syncthreads();
    float bt = 0.f;
    if (tid < 128) for (int s2 = 0; s2 <= tid; ++s2) bt += sF[s2];
    const float ut = ig - bt;
    __syncthreads();
    if (tid < 128) sF[tid] = ut;
    __syncthreads();
    float um = -3.0e38f;
    for (int s2 = 0; s2 < 128; ++s2) um = fmaxf(um, sF[s2]);
    if (tid < 128) {
      uArr[(size_t)item * 128 + tid] = ut;
      bArr[(size_t)item * 128 + tid] = bt;
      eW[(size_t)item * 128 + tid] = f2bf(__expf(ut - um));
      if (tid == 127) blA[item] = bt;
      if (tid == 0) umaxA[item] = um;
    }
    for (int it = tid; it < 128 * 24; it += NTHR) {
      const int t = it / 24, ch = (it - t * 24) * 8;
      const int spos = c * 128 + t;
      const bf16_t* src = Pk + (tok0 + t) * 768 + h * 192 + ch;
      uint4 xv[4];
      float4 w0[4], w1[4];
#pragma unroll
      for (int j = 0; j < 4; ++j) {
        xv[j] = make_uint4(0u, 0u, 0u, 0u);
        if (spos - 3 + j >= 0) xv[j] = *(const uint4*)(src - (ptrdiff_t)(3 - j) * 768);
        const float4* wp = (const float4*)(P.a_conv + j * 1536 + 768 + h * 192 + ch);
        w0[j] = wp[0]; w1[j] = wp[1];
      }
      VMWAIT();
      float a[8] = {0.f, 0.f, 0.f, 0.f, 0.f, 0.f, 0.f, 0.f};
#pragma unroll
      for (int j = 0; j < 4; ++j) {
        a[0] += w0[j].x * bflo(xv[j].x); a[1] += w0[j].y * bfhi(xv[j].x); a[2] += w0[j].z * bflo(xv[j].y); a[3] += w0[j].w * bfhi(xv[j].y);
        a[4] += w1[j].x * bflo(xv[j].z); a[5] += w1[j].y * bfhi(xv[j].z); a[6] += w1[j].z * bflo(xv[j].w); a[7] += w1[j].w * bfhi(xv[j].w);
      }
#pragma unroll
      for (int e = 0; e < 8; ++e) a[e] = a[e] / (1.f + __expf(-a[e])) * kscale;
      uint4 o; o.x = pack2(a[0], a[1]); o.y = pack2(a[2], a[3]); o.z = pack2(a[4], a[5]); o.w = pack2(a[6], a[7]);
      *(uint4*)(kc + (tok0 + t) * 768 + h * 192 + ch) = o;
      *(uint4*)(sX + t * 200 + ch) = o;
    }
    __syncthreads();
    for (int it = tid; it < 192 * 16; it += NTHR) {
      const int k = it >> 4, lg = it & 15;
      uint4 o;
      o.x = (uint32_t)sX[(lg * 8 + 0) * 200 + k] | ((uint32_t)sX[(lg * 8 + 1) * 200 + k] << 16);
      o.y = (uint32_t)sX[(lg * 8 + 2) * 200 + k] | ((uint32_t)sX[(lg * 8 + 3) * 200 + k] << 16);
      o.z = (uint32_t)sX[(lg * 8 + 4) * 200 + k] | ((uint32_t)sX[(lg * 8 + 5) * 200 + k] << 16);
      o.w = (uint32_t)sX[(lg * 8 + 6) * 200 + k] | ((uint32_t)sX[(lg * 8 + 7) * 200 + k] << 16);
      *(uint4*)(kTt + ((size_t)item * 192 + k) * 128 + lg * 8) = o;
    }
    __syncthreads();
    for (int it = tid; it < 128 * 24; it += NTHR) {
      const int t = it / 24, ch = (it - t * 24) * 8;
      uint4 v = *(const uint4*)(Pv + (tok0 + t) * 768 + h * 192 + ch);
      *(uint4*)(sX + t * 200 + ch) = v;
    }
    __syncthreads();
    for (int it = tid; it < 192 * 16; it += NTHR) {
      const int k = it >> 4, lg = it & 15;
      uint4 o;
      o.x = (uint32_t)sX[(lg * 8 + 0) * 200 + k] | ((uint32_t)sX[(lg * 8 + 1) * 200 + k] << 16);
      o.y = (uint32_t)sX[(lg * 8 + 2) * 200 + k] | ((uint32_t)sX[(lg * 8 + 3) * 200 + k] << 16);
      o.z = (uint32_t)sX[(lg * 8 + 4) * 200 + k] | ((uint32_t)sX[(lg * 8 + 5) * 200 + k] << 16);
      o.w = (uint32_t)sX[(lg * 8 + 6) * 200 + k] | ((uint32_t)sX[(lg * 8 + 7) * 200 + k] << 16);
      *(uint4*)(VT + ((size_t)item * 192 + k) * 128 + lg * 8) = o;
    }
  }
}

__device__ __forceinline__ void phase_scan(const Params& P) {
  const bf16_t* kTt = (const bf16_t*)(P.ws + OFF_R2);
  const bf16_t* VT = kTt + (size_t)kT * 768;
  const bf16_t* eW = (const bf16_t*)(P.ws + OFF_EW);
  const float* umaxA = (const float*)(P.ws + OFF_UMAX);
  const float* blA = (const float*)(P.ws + OFF_BL);
  float* m0A = (float*)(P.ws + OFF_M0);
  bf16_t* C0T = (bf16_t*)(P.ws + OFF_R1) + (size_t)kT * 768;
  const int lane = threadIdx.x & 63, wid = threadIdx.x >> 6, nw = gridDim.x * NWAVE;
  const int r = lane & 15, q = lane >> 4;
  for (int unit = wid * gridDim.x + blockIdx.x; unit < 416; unit += nw) {
    const int bh = unit / 52, rem = unit - bh * 52, mv = rem >> 2, nk = rem & 3;
    const bf16_t* vt_base = VT + ((size_t)bh * 128 * 192 + (mv < 12 ? mv : 0) * 16 + r) * 128 + q * 8;
    const bf16_t* kt_base = kTt + ((size_t)bh * 128 * 192 + nk * 48 + r) * 128 + q * 8;
    const bf16_t* ew_base = eW + (size_t)bh * 128 * 128 + q * 8;
    bf16_t* c0_base = C0T + ((size_t)bh * 128 * 208 + mv * 16 + q * 4) * 192 + nk * 48 + r;
    f32x4 acc[3];
#pragma unroll
    for (int n = 0; n < 3; ++n) acc[n] = (f32x4){0.f, 0.f, 0.f, 0.f};
    float m = 0.f;
    uint4 A[4], B[3][4], E[4];
    float bl, um;
#define SCAN_LOAD(A_, B_, E_, bl_, um_, cc)                                                            \
  do {                                                                                                 \
    _Pragma("unroll") for (int ks = 0; ks < 4; ++ks) {                                                 \
      A_[ks] = *(const uint4*)(vt_base + (size_t)(cc) * 192 * 128 + ks * 32);                          \
      E_[ks] = *(const uint4*)(ew_base + (size_t)(cc) * 128 + ks * 32);                                \
      _Pragma("unroll") for (int n = 0; n < 3; ++n)                                                    \
        B_[n][ks] = *(const uint4*)(kt_base + (size_t)(cc) * 192 * 128 + (size_t)n * 16 * 128 + ks * 32); \
    }                                                                                                  \
    bl_ = blA[bh * 128 + (cc)]; um_ = umaxA[bh * 128 + (cc)];                                          \
  } while (0)
    SCAN_LOAD(A, B, E, bl, um, 0);
    VMWAIT();
    for (int c = 0; c < 128; ++c) {
#pragma unroll
      for (int n = 0; n < 3; ++n)
#pragma unroll
        for (int j = 0; j < 4; ++j) c0_base[(size_t)c * 208 * 192 + j * 192 + n * 16] = f2bf(acc[n][j]);
      if (rem == 0 && lane == 0) m0A[bh * 128 + c] = m;
      uint4 nA[4], nB[3][4], nE[4];
      float nbl = 0.f, num = 0.f;
      const int cn = (c + 1 < 128) ? c + 1 : c;
      SCAN_LOAD(nA, nB, nE, nbl, num, cn);
      const float mn = fmaxf(bl + m, bl + um);
      const float decay = __expf(bl + m - mn), sc = __expf(um + bl - mn);
      m = mn;
      f32x4 U[3];
#pragma unroll
      for (int n = 0; n < 3; ++n) U[n] = (f32x4){0.f, 0.f, 0.f, 0.f};
#pragma unroll
      for (int ks = 0; ks < 4; ++ks) {
        uint4 af;
        if (mv < 12) af = mul_bf16x8(A[ks], E[ks]);
        else af = (r == 0) ? E[ks] : make_uint4(0u, 0u, 0u, 0u);
#pragma unroll
        for (int n = 0; n < 3; ++n)
          U[n] = __builtin_amdgcn_mfma_f32_16x16x32_bf16(u4_to_frag(af), u4_to_frag(B[n][ks]), U[n], 0, 0, 0);
      }
#pragma unroll
      for (int n = 0; n < 3; ++n)
#pragma unroll
        for (int j = 0; j < 4; ++j) acc[n][j] = acc[n][j] * decay + sc * U[n][j];
      VMWAIT();
#pragma unroll
      for (int ks = 0; ks < 4; ++ks) {
        A[ks] = nA[ks]; E[ks] = nE[ks];
#pragma unroll
        for (int n = 0; n < 3; ++n) B[n][ks] = nB[n][ks];
      }
      bl = nbl; um = num;
    }
#undef SCAN_LOAD
  }
}

__device__ __forceinline__ void phase_chunk(const Params& P) {
  const bf16_t* Pq = (const bf16_t*)(P.ws + OFF_R1);
  const bf16_t* Po = Pq + (size_t)3 * kT * 768;
  const bf16_t* C0T = Pq + (size_t)kT * 768;
  const bf16_t* kc = (const bf16_t*)(P.ws + OFF_XB);
  const bf16_t* VT = (const bf16_t*)(P.ws + OFF_R2) + (size_t)kT * 768;
  const float* uArr = (const float*)(P.ws + OFF_U);
  const float* bArr = (const float*)(P.ws + OFF_BC);
  const float* m0A = (const float*)(P.ws + OFF_M0);
  bf16_t* Cat = (bf16_t*)(P.ws + OFF_CAT);
  bf16_t* sQ = (bf16_t*)smem;
  float* sU = (float*)(smem + 51200);
  float* sMx = (float*)(smem + 51712);
  float* sBt = (float*)(smem + 52224);
  float* sCw = (float*)(smem + 52736);
  const int tid = threadIdx.x, lane = tid & 63, wid = tid >> 6, r = lane & 15, q = lane >> 4;
  bf16_t* sWw = (bf16_t*)(smem + 55808) + wid * (16 * 136);
  for (int item = blockIdx.x; item < 1024; item += gridDim.x) {
    const int bh = item >> 7, c = item & 127, b = bh >> 2, h = bh & 3;
    const size_t tok0 = (size_t)b * kS + (size_t)c * 128;
    __syncthreads();
    for (int i = tid; i < 768; i += NTHR) { int j = i / 192, ch = i - j * 192; sCw[i] = P.a_conv[j * 1536 + h * 192 + ch]; }
    if (tid < 128) { sU[tid] = uArr[(size_t)item * 128 + tid]; sBt[tid] = bArr[(size_t)item * 128 + tid]; }
    const float m0 = m0A[item];
    __syncthreads();
    if (tid < 128) {
      float mx = m0;
      for (int s2 = 0; s2 <= tid; ++s2) mx = fmaxf(mx, sU[s2]);
      sMx[tid] = mx;
    }
    for (int it = tid; it < 128 * 24; it += NTHR) {
      const int t = it / 24, ch = (it - t * 24) * 8;
      const int spos = c * 128 + t;
      const bf16_t* src = Pq + (tok0 + t) * 768 + h * 192 + ch;
      float a[8] = {0.f, 0.f, 0.f, 0.f, 0.f, 0.f, 0.f, 0.f};
#pragma unroll
      for (int j = 0; j < 4; ++j) {
        uint4 xv = make_uint4(0u, 0u, 0u, 0u);
        if (spos - 3 + j >= 0) xv = *(const uint4*)(src - (ptrdiff_t)(3 - j) * 768);
        const float* w = sCw + j * 192 + ch;
        a[0] += w[0] * bflo(xv.x); a[1] += w[1] * bfhi(xv.x); a[2] += w[2] * bflo(xv.y); a[3] += w[3] * bfhi(xv.y);
        a[4] += w[4] * bflo(xv.z); a[5] += w[5] * bfhi(xv.z); a[6] += w[6] * bflo(xv.w); a[7] += w[7] * bfhi(xv.w);
      }
#pragma unroll
      for (int e = 0; e < 8; ++e) a[e] = a[e] / (1.f + __expf(-a[e]));
      uint4 o; o.x = pack2(a[0], a[1]); o.y = pack2(a[2], a[3]); o.z = pack2(a[4], a[5]); o.w = pack2(a[6], a[7]);
      *(uint4*)(sQ + t * 200 + ch) = o;
    }
    __syncthreads();
    {
      const int t0 = wid * 16, nmax = t0 >> 4, ks2max = (t0 + 15) >> 5;
      {
        bf16x8 Qf[6];
#pragma unroll
        for (int ks = 0; ks < 6; ++ks) Qf[ks] = *(const bf16x8*)(sQ + (t0 + r) * 200 + ks * 32 + q * 8);
        float mxr[4];
#pragma unroll
        for (int j = 0; j < 4; ++j) mxr[j] = sMx[t0 + q * 4 + j];
#pragma unroll
        for (int n = 0; n < 8; ++n) {
          f32x4 sa = (f32x4){0.f, 0.f, 0.f, 0.f};
          if (n <= nmax) {
            uint4 Kf[6];
#pragma unroll
            for (int ks = 0; ks < 6; ++ks) Kf[ks] = *(const uint4*)(kc + (tok0 + n * 16 + r) * 768 + h * 192 + ks * 32 + q * 8);
#pragma unroll
            for (int ks = 0; ks < 6; ++ks) sa = __builtin_amdgcn_mfma_f32_16x16x32_bf16(Qf[ks], u4_to_frag(Kf[ks]), sa, 0, 0, 0);
          }
          const int scol = n * 16 + r;
          const float us = sU[scol];
#pragma unroll
          for (int j = 0; j < 4; ++j) {
            const int trow = t0 + q * 4 + j;
            float w = (n <= nmax && scol <= trow) ? __expf(us - mxr[j]) * sa[j] : 0.f;
            sWw[(q * 4 + j) * 136 + scol] = f2bf(w);
          }
        }
      }
      f32x4 acc[13];
#pragma unroll
      for (int nv = 0; nv < 13; ++nv) acc[nv] = (f32x4){0.f, 0.f, 0.f, 0.f};
      bf16_t* sB = (bf16_t*)(smem + 90624);
#pragma unroll 1
      for (int kp = 0; kp < 3; ++kp) {
        __syncthreads();
        for (int i = tid; i < 208 * 8; i += NTHR) {
          const int row = i >> 3, c8 = (i & 7) * 8;
          *(uint4*)(sB + row * 72 + c8) = *(const uint4*)(C0T + ((size_t)item * 208 + row) * 192 + kp * 64 + c8);
        }
        __syncthreads();
#pragma unroll
        for (int e = 0; e < 2; ++e) {
          const bf16x8 qf = *(const bf16x8*)(sQ + (t0 + r) * 200 + (kp * 2 + e) * 32 + q * 8);
#pragma unroll
          for (int nv = 0; nv < 13; ++nv)
            acc[nv] = __builtin_amdgcn_mfma_f32_16x16x32_bf16(qf, *(const bf16x8*)(sB + (nv * 16 + r) * 72 + e * 32 + q * 8), acc[nv], 0, 0, 0);
        }
      }
#pragma unroll
      for (int j = 0; j < 4; ++j) {
        const float inter = __expf(m0 - sMx[t0 + q * 4 + j]);
#pragma unroll
        for (int nv = 0; nv < 13; ++nv) acc[nv][j] *= inter;
      }
#pragma unroll 1
      for (int sp = 0; sp < 2; ++sp) {
        __syncthreads();
        for (int i = tid; i < 192 * 8; i += NTHR) {
          const int row = i >> 3, c8 = (i & 7) * 8;
          *(uint4*)(sB + row * 72 + c8) = *(const uint4*)(VT + ((size_t)item * 192 + row) * 128 + sp * 64 + c8);
        }
        __syncthreads();
        if (sp * 2 <= ks2max) {
          const uint32_t one2 = (r == 0) ? 0x3F803F80u : 0u;
          const bf16x8 onef = u4_to_frag(make_uint4(one2, one2, one2, one2));
#pragma unroll
          for (int e = 0; e < 2; ++e) {
            const bf16x8 wf = *(const bf16x8*)(sWw + r * 136 + (sp * 2 + e) * 32 + q * 8);
#pragma unroll
            for (int nv = 0; nv < 12; ++nv)
              acc[nv] = __builtin_amdgcn_mfma_f32_16x16x32_bf16(wf, *(const bf16x8*)(sB + (nv * 16 + r) * 72 + e * 32 + q * 8), acc[nv], 0, 0, 0);
            acc[12] = __builtin_amdgcn_mfma_f32_16x16x32_bf16(wf, onef, acc[12], 0, 0, 0);
          }
        }
      }
      float hg[12];
#pragma unroll
      for (int nv = 0; nv < 12; ++nv) hg[nv] = P.a_h_norm[h * 192 + nv * 16 + r];
#pragma unroll 1
      for (int j = 0; j < 4; ++j) {
        const int trow = t0 + q * 4 + j;
        const size_t tok = tok0 + trow;
        float og[12];
#pragma unroll
        for (int nv = 0; nv < 12; ++nv) og[nv] = bf2f(Po[tok * 768 + h * 192 + nv * 16 + r]);
        float accj[13];
#pragma unroll
        for (int nv = 0; nv < 13; ++nv) accj[nv] = (j == 0) ? acc[nv][0] : (j == 1) ? acc[nv][1] : (j == 2) ? acc[nv][2] : acc[nv][3];
        const float den = __shfl(accj[12], lane & 48);
        const float mt = sBt[trow] + sMx[trow];
        const float inv = 1.f / fmaxf(fabsf(den), __expf(-mt));
        float ss = 0.f;
#pragma unroll
        for (int nv = 0; nv < 12; ++nv) { accj[nv] *= inv; ss += accj[nv] * accj[nv]; }
        ss = sum16(ss);
        const float rstd = rsqrtf(ss * (1.f / 192.f) + EPS);
        VMWAIT();
#pragma unroll
        for (int nv = 0; nv < 12; ++nv)
          Cat[tok * 1024 + h * 192 + nv * 16 + r] = f2bf(accj[nv] * rstd * hg[nv] * sigmoidf_(og[nv]));
      }
    }
  }
}

__device__ __forceinline__ float t5_bias(const float* rel_bias, int dist, int head) {
  int bucket;
  if (dist < 16) bucket = dist;
  else {
    int large = 16 + (int)(logf((float)dist / 16.f) / 4.852030263919617f * 16.f);
    bucket = large < 31 ? large : 31;
  }
  return rel_bias[bucket * 12 + head];
}

__device__ __forceinline__ void memattn_mfma(const Params& P, int layer, int gw, int nw) {
  bf16_t* Cat = (bf16_t*)(P.ws + OFF_CAT);
  const bf16_t* Kmem = (const bf16_t*)(P.ws + OFF_KMEM) + (size_t)layer * 512 * 256;
  const bf16_t* VmT = (const bf16_t*)(P.ws + OFF_VMEM) + (size_t)layer * 512 * 256;
  const int lane = threadIdx.x & 63, wid = threadIdx.x >> 6, r = lane & 15, q = lane >> 4;
  bf16_t* sP = (bf16_t*)smem + wid * (16 * 264);
  if (gw < 0) return;
  for (int item = gw; item < (kT / 16) * 4; item += nw) {
    const int head = item & 3;
    const size_t tok0 = (size_t)(item >> 2) * 16;
    const int b = (int)(tok0 / kS);
    bf16_t* qbase = Cat + tok0 * 1024 + 768 + head * 64;
    const uint4 qf0 = *(const uint4*)(qbase + (size_t)r * 1024 + q * 8);
    const uint4 qf1 = *(const uint4*)(qbase + (size_t)r * 1024 + 32 + q * 8);
    const bf16_t* Kb = Kmem + (size_t)b * 256 * 256 + head * 64 + q * 8;
    f32x4 sa[16];
#pragma unroll
    for (int n = 0; n < 16; ++n) {
      const uint4 k0 = *(const uint4*)(Kb + (size_t)(n * 16 + r) * 256);
      const uint4 k1 = *(const uint4*)(Kb + (size_t)(n * 16 + r) * 256 + 32);
      sa[n] = __builtin_amdgcn_mfma_f32_16x16x32_bf16(u4_to_frag(qf0), u4_to_frag(k0), (f32x4){0.f, 0.f, 0.f, 0.f}, 0, 0, 0);
      sa[n] = __builtin_amdgcn_mfma_f32_16x16x32_bf16(u4_to_frag(qf1), u4_to_frag(k1), sa[n], 0, 0, 0);
      if ((n & 3) == 3) __builtin_amdgcn_sched_barrier(0);
    }
    float inv[4];
#pragma unroll
    for (int j = 0; j < 4; ++j) {
      float mx = sa[0][j];
#pragma unroll
      for (int n = 1; n < 16; ++n) mx = fmaxf(mx, sa[n][j]);
      mx = max16(mx);
      float sum = 0.f;
#pragma unroll
      for (int n = 0; n < 16; ++n) {
        float p = __expf(sa[n][j] - mx);
        sum += p;
        sP[(q * 4 + j) * 264 + n * 16 + r] = f2bf(p);
      }
      inv[j] = 1.f / sum16(sum);
    }
    f32x4 o[4];
#pragma unroll
    for (int ne = 0; ne < 4; ++ne) o[ne] = (f32x4){0.f, 0.f, 0.f, 0.f};
    const bf16_t* Vb = VmT + (size_t)(b * 4 + head) * 64 * 256 + q * 8;
#pragma unroll
    for (int ks = 0; ks < 8; ++ks) {
      const bf16x8 pf = *(const bf16x8*)(sP + r * 264 + ks * 32 + q * 8);
#pragma unroll
      for (int ne = 0; ne < 4; ++ne) {
        const uint4 vf = *(const uint4*)(Vb + (size_t)(ne * 16 + r) * 256 + ks * 32);
        o[ne] = __builtin_amdgcn_mfma_f32_16x16x32_bf16(pf, u4_to_frag(vf), o[ne], 0, 0, 0);
      }
      if (ks & 1) __builtin_amdgcn_sched_barrier(0);
    }
    VMWAIT();
#pragma unroll
    for (int ne = 0; ne < 4; ++ne)
#pragma unroll
      for (int j = 0; j < 4; ++j) qbase[(size_t)(q * 4 + j) * 1024 + ne * 16 + r] = f2bf(o[ne][j] * inv[j]);
  }
}

__device__ __forceinline__ void memattn_block(const Params& P, int layer) {
  bf16_t* Cat = (bf16_t*)(P.ws + OFF_CAT);
  const bf16_t* Kmem = (const bf16_t*)(P.ws + OFF_KMEM) + (size_t)layer * 512 * 256;
  const bf16_t* VmT = (const bf16_t*)(P.ws + OFF_VMEM) + (size_t)layer * 512 * 256;
  const int tid = threadIdx.x, lane = tid & 63, wid = tid >> 6, r = lane & 15, q = lane >> 4;
  bf16_t* sK = (bf16_t*)smem;
  bf16_t* sV = (bf16_t*)(smem + 36864);
  bf16_t* sP = (bf16_t*)(smem + 70656) + wid * (16 * 264);
  const int combo = blockIdx.x & 7, b = combo >> 2, head = combo & 3;
  const int rank = blockIdx.x >> 3, nrank = gridDim.x >> 3;
  __syncthreads();
  for (int i = tid; i < 256 * 8; i += NTHR) {
    const int m = i >> 3, c8 = (i & 7) * 8;
    *(uint4*)(sK + m * 72 + c8) = *(const uint4*)(Kmem + ((size_t)b * 256 + m) * 256 + head * 64 + c8);
  }
  for (int i = tid; i < 64 * 32; i += NTHR) {
    const int e = i >> 5, c8 = (i & 31) * 8;
    *(uint4*)(sV + e * 264 + c8) = *(const uint4*)(VmT + ((size_t)(b * 4 + head) * 64 + e) * 256 + c8);
  }
  __syncthreads();
  for (int ts = rank * NWAVE + wid; ts < kS / 16; ts += nrank * NWAVE) {
    const size_t tok0 = (size_t)b * kS + (size_t)ts * 16;
    bf16_t* qbase = Cat + tok0 * 1024 + 768 + head * 64;
    const uint4 qf0 = *(const uint4*)(qbase + (size_t)r * 1024 + q * 8);
    const uint4 qf1 = *(const uint4*)(qbase + (size_t)r * 1024 + 32 + q * 8);
    f32x4 sa[16];
#pragma unroll
    for (int n = 0; n < 16; ++n) {
      sa[n] = __builtin_amdgcn_mfma_f32_16x16x32_bf16(u4_to_frag(qf0), *(const bf16x8*)(sK + (n * 16 + r) * 72 + q * 8), (f32x4){0.f, 0.f, 0.f, 0.f}, 0, 0, 0);
      sa[n] = __builtin_amdgcn_mfma_f32_16x16x32_bf16(u4_to_frag(qf1), *(const bf16x8*)(sK + (n * 16 + r) * 72 + 32 + q * 8), sa[n], 0, 0, 0);
    }
    float inv[4];
#pragma unroll
    for (int j = 0; j < 4; ++j) {
      float mx = sa[0][j];
#pragma unroll
      for (int n = 1; n < 16; ++n) mx = fmaxf(mx, sa[n][j]);
      mx = max16(mx);
      float sum = 0.f;
#pragma unroll
      for (int n = 0; n < 16; ++n) {
        float p = __expf(sa[n][j] - mx);
        sum += p;
        sP[(q * 4 + j) * 264 + n * 16 + r] = f2bf(p);
      }
      inv[j] = __builtin_amdgcn_rcpf(sum16(sum));
    }
    f32x4 o[4];
#pragma unroll
    for (int ne = 0; ne < 4; ++ne) o[ne] = (f32x4){0.f, 0.f, 0.f, 0.f};
#pragma unroll
    for (int ks = 0; ks < 8; ++ks) {
      const bf16x8 pf = *(const bf16x8*)(sP + r * 264 + ks * 32 + q * 8);
#pragma unroll
      for (int ne = 0; ne < 4; ++ne)
        o[ne] = __builtin_amdgcn_mfma_f32_16x16x32_bf16(pf, *(const bf16x8*)(sV + (ne * 16 + r) * 264 + ks * 32 + q * 8), o[ne], 0, 0, 0);
    }
    VMWAIT();
#pragma unroll
    for (int ne = 0; ne < 4; ++ne)
#pragma unroll
      for (int j = 0; j < 4; ++j) qbase[(size_t)(q * 4 + j) * 1024 + ne * 16 + r] = f2bf(o[ne][j] * inv[j]);
  }
}

__device__ __forceinline__ void dilated_slab(const Params& P, int pass, int sidx, int b, int p0, int hg, const float* sBias,
                                             float* sLse, bf16_t* sP) {
  bf16_t* Cat = (bf16_t*)(P.ws + OFF_CAT);
  const bf16_t* Ksh = (const bf16_t*)(P.ws + OFF_R2);
  const bf16_t* VshT = Ksh + (size_t)kT * 768;
  const int lane = threadIdx.x & 63, r = lane & 15, q = lane >> 4;
  const int g = sidx >> 4, i = sidx & 15, d = 1 << (2 * g), head = g * 4 + hg;
  const int r_res = (g == 0) ? 0 : (g == 1) ? (i >> 2) : i;
  const int sig0 = (g == 0) ? (p0 + 16 * i) : (g == 1) ? ((p0 >> 2) + 16 * (i & 3)) : (p0 >> 4);
  const size_t tokq = (size_t)b * kS + (size_t)(sig0 + r) * d + r_res;
  const uint4 qf0 = *(const uint4*)(Cat + tokq * 1024 + head * 64 + q * 8);
  const uint4 qf1 = *(const uint4*)(Cat + tokq * 1024 + head * 64 + 32 + q * 8);
  f32x4 sa[10];
  sa[0] = (f32x4){0.f, 0.f, 0.f, 0.f};
#pragma unroll
  for (int n = 1; n < 10; ++n) {
    int sigk = sig0 - 144 + n * 16 + r;
    sigk = sigk < 0 ? 0 : sigk;
    const bf16_t* kp = Ksh + ((size_t)b * kS + (size_t)sigk * d + r_res) * 768 + head * 64 + q * 8;
    const uint4 k0 = *(const uint4*)kp;
    const uint4 k1 = *(const uint4*)(kp + 32);
    sa[n] = __builtin_amdgcn_mfma_f32_16x16x32_bf16(u4_to_frag(qf0), u4_to_frag(k0), (f32x4){0.f, 0.f, 0.f, 0.f}, 0, 0, 0);
    sa[n] = __builtin_amdgcn_mfma_f32_16x16x32_bf16(u4_to_frag(qf1), u4_to_frag(k1), sa[n], 0, 0, 0);
  }
  float scl[4];
#pragma unroll
  for (int j = 0; j < 4; ++j) {
    float mx = -1e30f;
#pragma unroll
    for (int n = 1; n < 10; ++n) {
      const int mo = 144 + q * 4 + j - n * 16 - r;
      const int sigk = sig0 - 144 + n * 16 + r;
      const bool ok = (mo >= 0) && (mo <= 128) && (sigk >= 0);
      const float sv = ok ? (sa[n][j] + sBias[g * 132 + (ok ? mo : 0)]) : -1e30f;
      sa[n][j] = sv;
      mx = fmaxf(mx, sv);
    }
    mx = max16(mx);
    float sum = 0.f;
#pragma unroll
    for (int n = 1; n < 10; ++n) {
      const float p = (sa[n][j] > -1e29f) ? __expf(sa[n][j] - mx) : 0.f;
      sa[n][j] = p;
      sum += p;
    }
    sum = sum16(sum);
    const float lse = mx + __logf(sum);
    const int pw = (sig0 + q * 4 + j) * d + r_res - p0;
    if (pass == 0) {
      if (r == 0) sLse[g * 256 + pw] = lse;
      scl[j] = 0.f;
    } else {
      const float l0 = sLse[pw], l1 = sLse[256 + pw], l2 = sLse[512 + pw];
      const float L = fmaxf(fmaxf(l0, l1), l2);
      const float den = __expf(l0 - L) + __expf(l1 - L) + __expf(l2 - L);
      scl[j] = __expf(lse - L) / (den * sum);
    }
  }
  if (pass == 0) return;
#pragma unroll
  for (int j = 0; j < 4; ++j) {
#pragma unroll
    for (int n = 0; n < 10; ++n) sP[(q * 4 + j) * 168 + n * 16 + r] = f2bf(sa[n][j]);
  }
  f32x4 o[4];
#pragma unroll
  for (int ne = 0; ne < 4; ++ne) o[ne] = (f32x4){0.f, 0.f, 0.f, 0.f};
  const bf16_t* Vb = VshT + ((size_t)(b * 12 + head) * 64 + r) * kS + (size_t)r_res * (kS / d);
#pragma unroll
  for (int ks = 0; ks < 5; ++ks) {
    const bf16x8 pf = *(const bf16x8*)(sP + r * 168 + ks * 32 + q * 8);
    int sk0 = sig0 - 144 + ks * 32 + q * 8;
    sk0 = sk0 < 0 ? 0 : sk0;
#pragma unroll
    for (int ne = 0; ne < 4; ++ne) {
      const uint4 vf = *(const uint4*)(Vb + (size_t)ne * 16 * kS + sk0);
      o[ne] = __builtin_amdgcn_mfma_f32_16x16x32_bf16(pf, u4_to_frag(vf), o[ne], 0, 0, 0);
    }
  }
  VMWAIT();
#pragma unroll
  for (int ne = 0; ne < 4; ++ne)
#pragma unroll
    for (int j = 0; j < 4; ++j) {
      const size_t tok = (size_t)b * kS + (size_t)(sig0 + q * 4 + j) * d + r_res;
      Cat[tok * 1024 + head * 64 + ne * 16 + r] = f2bf(o[ne][j] * scl[j]);
    }
}

__device__ __forceinline__ void phase_dilated_mfma(const Params& P) {
  float* sBias = (float*)smem;
  float* sLse = (float*)(smem + 1584);
  const int tid = threadIdx.x, wid = tid >> 6;
  bf16_t* sP = (bf16_t*)(smem + 4656) + wid * (16 * 168);
  for (int item = blockIdx.x; item < 512; item += gridDim.x) {
    const int hg = item & 3, win = item >> 2, b = win >> 6, p0 = (win & 63) * 256;
    __syncthreads();
    for (int i = tid; i < 3 * 129; i += NTHR) {
      const int g = i / 129, mo = i - g * 129;
      sBias[g * 132 + mo] = t5_bias(P.rel_bias, mo << (2 * g), g * 4 + hg);
    }
    __syncthreads();
#pragma unroll 1
    for (int pass = 0; pass < 2; ++pass) {
#pragma unroll 1
      for (int sidx = wid; sidx < 48; sidx += NWAVE) dilated_slab(P, pass, sidx, b, p0, hg, sBias, sLse, sP);
      VMWAIT();
      __syncthreads();
    }
  }
}

#define XB_TMO      128
#define XB_XCNT(j)  (256  + 64 * (j))
#define XB_XSUB(j)  (1280 + 64 * (j))
#define XB_XGEN(j)  (2304 + 64 * (j))
#define XB_TOP      3328
#define XB_TOPGEN   3392
#define XCD_BAR_WORDS 3456
#define XB_SPIN_CAP (1u << 23)
__device__ __forceinline__ unsigned xb_ld(unsigned* p) { return __hip_atomic_load(p, __ATOMIC_RELAXED, __HIP_MEMORY_SCOPE_AGENT); }
__device__ __forceinline__ unsigned xb_add(unsigned* p, unsigned v) { return __hip_atomic_fetch_add(p, v, __ATOMIC_RELAXED, __HIP_MEMORY_SCOPE_AGENT); }
__device__ __forceinline__ unsigned xb_xcc_id() { return (unsigned)__builtin_amdgcn_s_getreg((3 << 11) | 20) & 0xFu; }
#define XB_SPIN(cond, bar) do { unsigned _sp = 0; while (cond) { __builtin_amdgcn_s_sleep(1); \
    if ((++_sp & 255u) == 0u) { if (xb_ld(&(bar)[XB_TMO])) break; if (_sp > XB_SPIN_CAP) { atomicAdd(&(bar)[XB_TMO], 1u); break; } } } } while (0)
struct XcdBarrier { unsigned* bar; unsigned x; volatile LAS unsigned* st; };
__device__ __forceinline__ XcdBarrier xcd_barrier_post(unsigned* bar, volatile LAS unsigned* st) {
  XcdBarrier b; b.bar = bar; b.x = xb_xcc_id(); b.st = st;
  if (threadIdx.x == 0) (void)xb_add(&bar[XB_XCNT(b.x)], 1u);
  return b;
}
__device__ __forceinline__ void xcd_barrier_complete(unsigned* bar, unsigned x, unsigned& nloc, unsigned& nx) {
  const unsigned Gr = gridDim.x * gridDim.y * gridDim.z;
  unsigned sum, cnt, mine, sp = 0u;
  for (;;) {
    sum = 0u; cnt = 0u; mine = 0u;
#pragma unroll
    for (unsigned j = 0; j < 16; ++j) { const unsigned c = xb_ld(&bar[XB_XCNT(j)]); sum += c; cnt += (c > 0u) ? 1u : 0u; mine = (j == x) ? c : mine; }
    if (sum == Gr) break;
    __builtin_amdgcn_s_sleep(1);
    if ((++sp & 255u) == 0u) { if (xb_ld(&bar[XB_TMO])) break; if (sp > XB_SPIN_CAP) { atomicAdd(&bar[XB_TMO], 1u); break; } }
  }
  nloc = mine > 0u ? mine : 1u; nx = cnt > 0u ? cnt : 1u;
}
__device__ __forceinline__ void xcd_barrier(const XcdBarrier& b) {
  asm volatile("s_waitcnt vmcnt(0)" ::: "memory");
  __syncthreads();
  if (threadIdx.x == 0) {
    unsigned* bar = b.bar;
    __builtin_amdgcn_s_waitcnt(0);
    unsigned nloc = b.st[0], nx = b.st[1];
    if (nloc == 0u) { xcd_barrier_complete(bar, b.x, nloc, nx); b.st[0] = nloc; b.st[1] = nx; }
    const unsigned old = xb_add(&bar[XB_XSUB(b.x)], 1u);
    const unsigned gen = old / nloc;
    if (old + 1u == (gen + 1u) * nloc) {
      __builtin_amdgcn_fence(__ATOMIC_RELEASE, "agent");
      asm volatile("s_waitcnt vmcnt(0)" ::: "memory");
      const unsigned og = xb_add(&bar[XB_TOP], 1u);
      const unsigned tg = og / nx;
      if (og + 1u == (tg + 1u) * nx) xb_add(&bar[XB_TOPGEN], 1u);
      else XB_SPIN(xb_ld(&bar[XB_TOPGEN]) == tg, bar);
      __builtin_amdgcn_fence(__ATOMIC_ACQUIRE, "agent");
      xb_add(&bar[XB_XGEN(b.x)], 1u);
      asm volatile("s_waitcnt vmcnt(0)" ::: "memory");
    } else {
      XB_SPIN(xb_ld(&bar[XB_XGEN(b.x)]) == gen, bar);
      __builtin_amdgcn_fence(__ATOMIC_ACQUIRE, "agent");
      asm volatile("s_waitcnt vmcnt(0)" ::: "memory");
    }
  }
  __syncthreads();
}
#define grid_barrier() xcd_barrier(xbar_)

constexpr int NPHASE = 17;
#ifndef ONLY_PHASE
#define ONLY_PHASE -1
#endif
#ifndef SKIP12
#define SKIP12 0
#endif
#ifndef SKIP14
#define SKIP14 0
#endif
#define PH(n) (ONLY_PHASE < 0 || ONLY_PHASE == (n))

__device__ __forceinline__ char* launder(char* p) { asm volatile("" : "+s"(p)); return p; }
__global__ void __launch_bounds__(512, 2) fwd_megakernel(Params P, int pb, int pe) {
#define W ((bf16_t*)(wsl + OFF_W))
#define xb ((bf16_t*)(wsl + OFF_XB))
#define H ((bf16_t*)(wsl + OFF_R1))
#define Pbase ((bf16_t*)(wsl + OFF_R1))
#define Ksh ((bf16_t*)(wsl + OFF_R2))
#define Vsh (Ksh + (size_t)kT * 768)
#define Cat ((bf16_t*)(wsl + OFF_CAT))
#define ssq ((float*)(wsl + OFF_SSQ))
#define G ((float*)(wsl + OFF_G))
#define memb ((bf16_t*)(wsl + OFF_MEMB))
#define ssqm ((float*)(wsl + OFF_SSQM))
#define Kmem ((bf16_t*)(wsl + OFF_KMEM))
#define Vmem ((bf16_t*)(wsl + OFF_VMEM))
  if (pe < -12345) cg::this_grid().sync();
  volatile LAS unsigned* xst_ = (volatile LAS unsigned*)(smem + 146432);
  if (threadIdx.x == 0) { xst_[0] = 0u; xst_[1] = 0u; }
  __syncthreads();
  XcdBarrier xbar_;
  xbar_.bar = (unsigned*)(P.ws + OFF_BAR); xbar_.x = 0; xbar_.st = xst_;
  if (pe - pb > 1) xbar_ = xcd_barrier_post((unsigned*)(P.ws + OFF_BAR), xst_);
  if (pb == 100) {
    char* wsl = P.ws;
    for (size_t i = (size_t)blockIdx.x * NTHR + threadIdx.x; i < (size_t)kT * 1024; i += (size_t)gridDim.x * NTHR) P.out[i] = bf2f(Cat[i]);
    return;
  }
  {
    if (pb <= 0 && 0 < pe && PH(0)) { char* wsl = launder(P.ws); Params Q = P; Q.ws = wsl; (void)Q; phase_convert(Q); }
    if (pb <= 0 && 0 + 1 < pe) grid_barrier();
    if (pb <= 1 && 1 < pe && PH(1)) { char* wsl = launder(P.ws); Params Q = P; Q.ws = wsl; (void)Q; gemm8(xb, W + W_GU0, kT, 5632, 1024, Epi8Swiglu{ssq, H}); }
    if (pb <= 1 && 1 + 1 < pe) grid_barrier();
    if (pb <= 2 && 2 < pe && PH(2)) { char* wsl = launder(P.ws); Params Q = P; Q.ws = wsl; (void)Q; { gemm8(H, W + W_DN0, kT, 1024, 2816, Epi8Resid{P.x, P.out, xb, ssq, 0.5f});
      gemm8(memb, W + W_MKV0, 512, 512, 1024, Epi8MemKv{ssqm, Kmem, (bf16_t*)(wsl + OFF_VTOK), P.mem_k_norm}, 64);
      gemm8(memb, W + W_MKV1, 512, 512, 1024, Epi8MemKv{ssqm, Kmem + 512 * 256, (bf16_t*)(wsl + OFF_VTOK) + 512 * 256, P.mem_k_norm + 64}, 192);
    } }
    if (pb <= 2 && 2 + 1 < pe) grid_barrier();
    if (pb <= 3 && 3 < pe && PH(3)) { char* wsl = launder(P.ws); Params Q = P; Q.ws = wsl; (void)Q; {
      gemm8(xb, W + W_IN, kT, 3584, 1024, Epi8InProj{ssq, Pbase, Cat, G, P.mem_q_norm, P.a_gate_bias});
      memv_transpose((const bf16_t*)(wsl + OFF_VTOK), Vmem);
    } }
    if (pb <= 3 && 3 + 1 < pe) grid_barrier();
    if (pb <= 4 && 4 < pe && PH(4)) { char* wsl = launder(P.ws); Params Q = P; Q.ws = wsl; (void)Q; { phase_prep(Q); if ((gridDim.x & 7) == 0) memattn_block(Q, 0); } }
    if (pb <= 4 && 4 + 1 < pe) grid_barrier();
    if (pb <= 5 && 5 < pe && PH(5)) { char* wsl = launder(P.ws); Params Q = P; Q.ws = wsl; (void)Q; phase_scan(Q); { const int wv = (int)(threadIdx.x >> 6) * (int)gridDim.x + (int)blockIdx.x, tot = (int)gridDim.x * NWAVE; if (tot > 416 + 64) { if ((gridDim.x & 7) != 0) memattn_mfma(Q, 0, wv - 416, tot - 416); if (wv >= 416) wave_convert(Q, wv - 416, tot - 416, false); } else { if ((gridDim.x & 7) != 0) memattn_mfma(Q, 0, wv, tot); wave_convert(Q, wv, tot, false); } } }
    if (pb <= 5 && 5 + 1 < pe) grid_barrier();
    if (pb <= 6 && 6 < pe && PH(6)) { char* wsl = launder(P.ws); Params Q = P; Q.ws = wsl; (void)Q; phase_chunk(Q); }
    if (pb <= 6 && 6 + 1 < pe) grid_barrier();
    if (pb <= 7 && 7 < pe && PH(7)) { char* wsl = launder(P.ws); Params Q = P; Q.ws = wsl; (void)Q; gemm8(Cat, W + W_AOUT, kT, 1024, 1024, Epi8Resid{P.out, P.out, xb, ssq, 1.f}); }
    if (pb <= 7 && 7 + 1 < pe) grid_barrier();
    if (pb <= 8 && 8 < pe && PH(8)) { char* wsl = launder(P.ws); Params Q = P; Q.ws = wsl; (void)Q; gemm8(xb, W + W_GU1, kT, 5632, 1024, Epi8Swiglu{ssq, H}); }
    if (pb <= 8 && 8 + 1 < pe) grid_barrier();
    if (pb <= 9 && 9 < pe && PH(9)) { char* wsl = launder(P.ws); Params Q = P; Q.ws = wsl; (void)Q; gemm8(H, W + W_DN1, kT, 1024, 2816, Epi8Resid{P.out, P.out, xb, ssq, 0.5f}); }
    if (pb <= 9 && 9 + 1 < pe) grid_barrier();
    if (pb <= 10 && 10 < pe && PH(10)) { char* wsl = launder(P.ws); Params Q = P; Q.ws = wsl; (void)Q; gemm8(xb, W + W_GU2, kT, 7168, 1024, Epi8KvFfn{ssq, H, Ksh, Cat, P.kv_k_norm}); }
    if (pb <= 10 && 10 + 1 < pe) grid_barrier();
    if (pb <= 11 && 11 < pe && PH(11)) { char* wsl = launder(P.ws); Params Q = P; Q.ws = wsl; (void)Q; { gemm8(H, W + W_DN2, kT, 1024, 2816, Epi8Resid{P.out, P.out, xb, ssq, 0.5f}); phase_vtranspose(Cat, Vsh); } }
    if (pb <= 11 && 11 + 1 < pe) grid_barrier();
    if (pb <= 12 && 12 < pe && PH(12) && !SKIP12) { char* wsl = launder(P.ws); Params Q = P; Q.ws = wsl; (void)Q; gemm8(xb, W + W_BQ, kT, 1024, 1024, Epi8QProj{ssq, Cat, P.b_q_norm, P.mem_q_norm + 64}); }
    if (pb <= 12 && 12 + 1 < pe) grid_barrier();
    if (pb <= 13 && 13 < pe && PH(13)) { char* wsl = launder(P.ws); Params Q = P; Q.ws = wsl; (void)Q; { phase_dilated_mfma(Q); if ((gridDim.x & 7) == 0) memattn_block(Q, 1); else memattn_mfma(Q, 1, (int)blockIdx.x * NWAVE + (int)(threadIdx.x >> 6), (int)gridDim.x * NWAVE); } }
    if (pb <= 13 && 13 + 1 < pe) grid_barrier();
    if (pb <= 14 && 14 < pe && PH(14) && !SKIP14) { char* wsl = launder(P.ws); Params Q = P; Q.ws = wsl; (void)Q; gemm8(Cat, W + W_BOUT, kT, 1024, 1024, Epi8Resid{P.out, P.out, xb, ssq, 1.f}); }
    if (pb <= 14 && 14 + 1 < pe) grid_barrier();
    if (pb <= 15 && 15 < pe && PH(15)) { char* wsl = launder(P.ws); Params Q = P; Q.ws = wsl; (void)Q; gemm8(xb, W + W_GU3, kT, 5632, 1024, Epi8Swiglu{ssq, H}); }
    if (pb <= 15 && 15 + 1 < pe) grid_barrier();
    if (pb <= 16 && 16 < pe && PH(16)) { char* wsl = launder(P.ws); Params Q = P; Q.ws = wsl; (void)Q; gemm8(H, W + W_DN3, kT, 1024, 2816, Epi8Resid{P.out, P.out, nullptr, ssq, 0.5f}); }
  }
}
#undef W
#undef xb
#undef H
#undef Pbase
#undef Ksh
#undef Vsh
#undef Cat
#undef ssq
#undef G
#undef memb
#undef ssqm
#undef Kmem
#undef Vmem

extern "C" void kernel_launch(void* const* d_in, const int* in_sizes, int n_in, void* d_out, int out_size, void* d_ws,
                              size_t ws_size, hipStream_t stream) {
  (void)in_sizes; (void)n_in; (void)out_size;
  static int grid_blocks = 0;
  if (!grid_blocks) {
    int dev = 0, cus = 0, per_cu = 0;
    hipGetDevice(&dev);
    hipDeviceGetAttribute(&cus, hipDeviceAttributeMultiprocessorCount, dev);
    hipOccupancyMaxActiveBlocksPerMultiprocessor(&per_cu, fwd_megakernel, NTHR, 0);
    if (per_cu > 1) per_cu = 1;
    grid_blocks = cus * per_cu;
    if (ws_size < OFF_END) fprintf(stderr, "workspace too small: %zu < %zu\n", ws_size, (size_t)OFF_END);
  }
  Params p{};
  const float** pf = (const float**)&p;
  for (int i = 0; i < 27; ++i) pf[i] = (const float*)d_in[i];
  p.out = (float*)d_out;
  p.ws = (char*)d_ws;
#ifndef RUN_PE
#define RUN_PE NPHASE
#endif
#ifdef MULTI_LAUNCH
  hipError_t e = hipSuccess;
  for (int ph = 0; ph < RUN_PE; ++ph) {
    int pb = ph, pe = ph + 1;
    hipLaunchKernelGGL(fwd_megakernel, dim3(grid_blocks), dim3(NTHR), 0, stream, p, pb, pe);
  }
#else
  hipMemsetAsync((char*)d_ws + OFF_BAR, 0, 16384, stream);
  int pb = 0, pe = RUN_PE;
  void* args[] = {&p, &pb, &pe};
  hipError_t e = hipLaunchCooperativeKernel((void*)fwd_megakernel, dim3(grid_blocks), dim3(NTHR), args, 0, stream);
#endif
  if (e != hipSuccess) fprintf(stderr, "cooperative launch failed: %s (grid %d)\n", hipGetErrorString(e), grid_blocks);
}
```
